# Optimizing an MI355X kernel written in HIP

```python
import math
import jax, jax.numpy as jnp
from jax import lax
import numpy as np


D_MODEL = 1024
BATCH = 8
SEQ = 2048
DEPTH = 1

PLE_DIM = 256
SSD_WIDTH = D_MODEL // 2
ATT_WIDTH = D_MODEL - SSD_WIDTH
MIX_WIDTH = SSD_WIDTH + ATT_WIDTH
SSD_HEAD_DIM = 64
SSD_HEADS = SSD_WIDTH // SSD_HEAD_DIM
SSD_GROUPS = 2
SSD_STATE = 128
SSD_CONV = 4
SSD_CHUNK = 128
SSD_CONV_CH = SSD_WIDTH + 2 * SSD_GROUPS * SSD_STATE
SSD_NORM_EPS = 1e-5
ATT_HEAD_DIM = 64
ATT_HEADS = ATT_WIDTH // (2 * ATT_HEAD_DIM)
Q_BLOCK = 128
SUBLN_EPS = 1e-5
OFF_Z = 0
OFF_XBC = OFF_Z + SSD_WIDTH
OFF_DT = OFF_XBC + SSD_CONV_CH
OFF_Q = OFF_DT + SSD_HEADS
OFF_K = OFF_Q + ATT_WIDTH
OFF_V = OFF_K + ATT_WIDTH
IN_PROJ = OFF_V + ATT_WIDTH
N_EXPERTS = 32
TOP_K = 4
D_EXPERT = D_MODEL
SWIGLU_LIMIT = 7.0
SWIGLU_ALPHA = 1.702
EXPERT_BLOCK = 128
NORM_EPS = 1e-6

kernel_name = 'hybrid_ssd_diffattn_moe_ple'


def rms_norm(x, w, eps):
    xf = x.astype(jnp.float32)
    y = xf * lax.rsqrt(jnp.mean(xf * xf, axis=-1, keepdims=True) + eps)
    return (y * w.astype(jnp.float32)).astype(x.dtype)


def causal_depthwise_conv(u, w, b):
    k = w.shape[0]
    c = u.shape[-1]
    out = lax.conv_general_dilated(u, w[:, None, :].astype(u.dtype), window_strides=(1,),
                                   padding=((k - 1, 0),), dimension_numbers=('NWC', 'WIO', 'NWC'),
                                   feature_group_count=c)
    return out + b


def ssd_chunked(xdt, a_dt, b_mat, c_mat):
    bsz, seq, nh, hp = xdt.shape
    ng, ns = b_mat.shape[2], b_mat.shape[3]
    r = nh // ng
    nc = seq // SSD_CHUNK
    X = xdt.reshape(bsz, nc, SSD_CHUNK, ng, r, hp)
    A = a_dt.reshape(bsz, nc, SSD_CHUNK, ng, r).transpose(0, 3, 4, 1, 2)
    Bm = b_mat.reshape(bsz, nc, SSD_CHUNK, ng, ns)
    Cm = c_mat.reshape(bsz, nc, SSD_CHUNK, ng, ns)
    A_cum = jnp.cumsum(A, axis=-1)
    causal = jnp.tril(jnp.ones((SSD_CHUNK, SSD_CHUNK), dtype=bool))
    seg = A_cum[..., :, None] - A_cum[..., None, :]
    Lmat = jnp.where(causal, jnp.exp(jnp.where(causal, seg, 0.0)), 0.0)
    CB = jnp.einsum('bclgn,bcsgn->bgcls', Cm, Bm)
    y_diag = jnp.einsum('bgcls,bgrcls,bcsgrp->bclgrp', CB, Lmat, X)
    decay_states = jnp.exp(A_cum[..., -1:] - A_cum)
    states = jnp.einsum('bclgn,bgrcl,bclgrp->bcgrpn', Bm, decay_states, X)
    chunk_decay = jnp.exp(A_cum[..., -1])

    def step(h, inp):
        st, dec = inp
        return h * dec[..., None, None] + st, h

    init = jnp.zeros((bsz, ng, r, hp, ns), xdt.dtype)
    _, prev = lax.scan(step, init, (states.transpose(1, 0, 2, 3, 4, 5), chunk_decay.transpose(3, 0, 1, 2)))
    prev = prev.transpose(1, 0, 2, 3, 4, 5)
    y_off = jnp.einsum('bclgn,bcgrpn,bgrcl->bclgrp', Cm, prev, jnp.exp(A_cum))
    return (y_diag + y_off).reshape(bsz, seq, nh, hp)


def ssd_mixer(z, xbc, dt_raw, conv_w, conv_b, dt_bias, a_log, d_skip, norm_w):
    bsz, seq = z.shape[:2]
    xbc = jax.nn.silu(causal_depthwise_conv(xbc, conv_w, conv_b))
    xs = xbc[..., :SSD_WIDTH].reshape(bsz, seq, SSD_HEADS, SSD_HEAD_DIM).astype(jnp.float32)
    bm = xbc[..., SSD_WIDTH:SSD_WIDTH + SSD_GROUPS * SSD_STATE].reshape(bsz, seq, SSD_GROUPS, SSD_STATE).astype(jnp.float32)
    cm = xbc[..., SSD_WIDTH + SSD_GROUPS * SSD_STATE:].reshape(bsz, seq, SSD_GROUPS, SSD_STATE).astype(jnp.float32)
    dt = jax.nn.softplus(dt_raw.astype(jnp.float32) + dt_bias.astype(jnp.float32))
    a = -jnp.exp(a_log.astype(jnp.float32))
    y = ssd_chunked(xs * dt[..., None], a * dt, bm, cm)
    y = y + d_skip.astype(jnp.float32)[:, None] * xs
    y = y.reshape(bsz, seq, SSD_WIDTH) * jax.nn.silu(z.astype(jnp.float32))
    y = y.reshape(bsz, seq, SSD_GROUPS, SSD_WIDTH // SSD_GROUPS)
    y = y * lax.rsqrt(jnp.mean(y * y, axis=-1, keepdims=True) + SSD_NORM_EPS)
    y = y.reshape(bsz, seq, SSD_WIDTH) * norm_w.astype(jnp.float32)
    return y.astype(z.dtype)


def diff_attention(q, k, v, lam):
    seq = q.shape[1]
    scale = ATT_HEAD_DIM ** -0.5
    outs = []
    for blk in range(seq // Q_BLOCK):
        q0 = blk * Q_BLOCK
        q1 = q0 + Q_BLOCK
        s = jnp.einsum('bqhjd,bkhjd->bhjqk', q[:, q0:q1], k[:, :q1]).astype(jnp.float32) * scale
        qpos = q0 + jnp.arange(Q_BLOCK)[:, None]
        kpos = jnp.arange(q1)[None, :]
        s = jnp.where(kpos <= qpos, s, -jnp.inf)
        a = jax.nn.softmax(s, axis=-1)
        w = a[:, :, 0] - lam * a[:, :, 1]
        outs.append(jnp.einsum('bhqk,bkhe->bqhe', w.astype(v.dtype), v[:, :q1]))
    return jnp.concatenate(outs, axis=1)


def diff_attn_mixer(q, k, v, lam_q1, lam_k1, lam_q2, lam_k2, subln_w, lam_init):
    bsz, seq = q.shape[:2]
    q = q.reshape(bsz, seq, ATT_HEADS, 2, ATT_HEAD_DIM)
    k = k.reshape(bsz, seq, ATT_HEADS, 2, ATT_HEAD_DIM)
    v = v.reshape(bsz, seq, ATT_HEADS, 2 * ATT_HEAD_DIM)
    f32 = jnp.float32
    lam = (jnp.exp(jnp.sum(lam_q1.astype(f32) * lam_k1.astype(f32)))
           - jnp.exp(jnp.sum(lam_q2.astype(f32) * lam_k2.astype(f32))) + lam_init)
    o = diff_attention(q, k, v, lam)
    o = rms_norm(o, subln_w, SUBLN_EPS) * (1.0 - lam_init)
    return o.reshape(bsz, seq, ATT_WIDTH)


def moe_ffn(h, w_router, b_router, w_up, b_up, w_down, b_down):
    bsz, seq, d = h.shape
    t = h.reshape(-1, d)
    n_tok = t.shape[0]
    logits = (t @ w_router + b_router).astype(jnp.float32)
    top_val, top_idx = lax.top_k(logits, TOP_K)
    gates = jax.nn.softmax(top_val, axis=-1)
    n_assign = n_tok * TOP_K
    flat_e = top_idx.reshape(-1).astype(jnp.int32)
    flat_tok = jnp.repeat(jnp.arange(n_tok, dtype=jnp.int32), TOP_K)
    flat_g = gates.reshape(-1)
    order = jnp.argsort(flat_e, stable=True)
    se = flat_e[order]
    counts = jnp.bincount(flat_e, length=N_EXPERTS).astype(jnp.int32)
    padded = (counts + EXPERT_BLOCK - 1) // EXPERT_BLOCK * EXPERT_BLOCK
    start = jnp.cumsum(counts) - counts
    pend = jnp.cumsum(padded)
    pstart = pend - padded
    dest = pstart[se] + jnp.arange(n_assign, dtype=jnp.int32) - start[se]
    n_blocks = -(-n_assign // EXPERT_BLOCK) + N_EXPERTS
    n_rows = n_blocks * EXPERT_BLOCK
    row_tok = jnp.zeros((n_rows,), jnp.int32).at[dest].set(flat_tok[order])
    row_gate = jnp.zeros((n_rows,), jnp.float32).at[dest].set(flat_g[order])
    block_e = jnp.minimum(jnp.searchsorted(pend, jnp.arange(n_blocks, dtype=jnp.int32) * EXPERT_BLOCK, side='right'),
                          N_EXPERTS - 1).astype(jnp.int32)
    xs = t[row_tok].reshape(n_blocks, EXPERT_BLOCK, d)

    def expert_block(args):
        xb, e = args
        hu = xb @ w_up[e] + b_up[e]
        gate = jnp.minimum(hu[..., ::2], SWIGLU_LIMIT)
        up = jnp.clip(hu[..., 1::2], -SWIGLU_LIMIT, SWIGLU_LIMIT)
        act = (up + 1.0) * gate * jax.nn.sigmoid(SWIGLU_ALPHA * gate)
        return act @ w_down[e] + b_down[e]

    ys = lax.map(expert_block, (xs, block_e)).reshape(n_rows, d)
    out = jnp.zeros((n_tok, d), jnp.float32).at[row_tok].add(ys.astype(jnp.float32) * row_gate[:, None])
    return out.astype(h.dtype).reshape(bsz, seq, d)


def setup_inputs(seed: int = 0) -> dict:
    key = jax.random.key(seed)
    ks = jax.random.split(key, 32)
    f32 = jnp.float32
    nrm = lambda k, shape, s: jax.random.normal(k, shape, f32) * s
    gain = lambda k, shape: 1.0 + 0.02 * jax.random.normal(k, shape, f32)
    dt = jnp.exp(jax.random.uniform(ks[5], (DEPTH, SSD_HEADS), f32, math.log(1e-3), math.log(1e-1)))
    return {
        'x': nrm(ks[0], (BATCH, SEQ, D_MODEL), 1.0),
        'p': nrm(ks[1], (DEPTH, BATCH, SEQ, PLE_DIM), 1.0),
        'g_mix': gain(ks[2], (DEPTH, D_MODEL)),
        'w_in': nrm(ks[3], (DEPTH, D_MODEL, IN_PROJ), D_MODEL ** -0.5),
        'conv_w': nrm(ks[4], (DEPTH, SSD_CONV, SSD_CONV_CH), SSD_CONV ** -0.5),
        'conv_b': nrm(ks[6], (DEPTH, SSD_CONV_CH), 0.02),
        'dt_bias': dt + jnp.log(-jnp.expm1(-dt)),
        'a_log': jnp.log(jax.random.uniform(ks[7], (DEPTH, SSD_HEADS), f32, 1.0, 16.0)),
        'd_skip': gain(ks[8], (DEPTH, SSD_HEADS)),
        'ssd_norm_w': gain(ks[9], (DEPTH, SSD_WIDTH)),
        'lam_q1': nrm(ks[10], (DEPTH, ATT_HEAD_DIM), 0.1),
        'lam_k1': nrm(ks[11], (DEPTH, ATT_HEAD_DIM), 0.1),
        'lam_q2': nrm(ks[12], (DEPTH, ATT_HEAD_DIM), 0.1),
        'lam_k2': nrm(ks[13], (DEPTH, ATT_HEAD_DIM), 0.1),
        'subln_w': gain(ks[14], (DEPTH, 2 * ATT_HEAD_DIM)),
        'w_out': nrm(ks[15], (DEPTH, MIX_WIDTH, D_MODEL), MIX_WIDTH ** -0.5),
        'g_ffn': gain(ks[16], (DEPTH, D_MODEL)),
        'w_router': nrm(ks[17], (DEPTH, D_MODEL, N_EXPERTS), D_MODEL ** -0.5),
        'b_router': nrm(ks[18], (DEPTH, N_EXPERTS), 0.01),
        'w_up': nrm(ks[19], (DEPTH, N_EXPERTS, D_MODEL, 2 * D_EXPERT), D_MODEL ** -0.5),
        'b_up': nrm(ks[20], (DEPTH, N_EXPERTS, 2 * D_EXPERT), 0.02),
        'w_down': nrm(ks[21], (DEPTH, N_EXPERTS, D_EXPERT, D_MODEL), D_EXPERT ** -0.5),
        'b_down': nrm(ks[22], (DEPTH, N_EXPERTS, D_MODEL), 0.02),
        'g_ple': gain(ks[23], (DEPTH, D_MODEL)),
        'w_ple_gate': nrm(ks[24], (DEPTH, D_MODEL, D_MODEL), D_MODEL ** -0.5),
        'w_ple_proj': nrm(ks[25], (DEPTH, PLE_DIM, D_MODEL), PLE_DIM ** -0.5),
        'g_final': gain(ks[26], (D_MODEL,)),
    }


def reference(x, p, g_mix, w_in, conv_w, conv_b, dt_bias, a_log, d_skip, ssd_norm_w,
              lam_q1, lam_k1, lam_q2, lam_k2, subln_w, w_out, g_ffn, w_router, b_router,
              w_up, b_up, w_down, b_down, g_ple, w_ple_gate, w_ple_proj, g_final):
    for i in range(DEPTH):
        lam_init = 0.8 - 0.6 * math.exp(-0.3 * i)
        h = rms_norm(x, g_mix[i], NORM_EPS)
        proj = h @ w_in[i]
        y_ssd = ssd_mixer(proj[..., OFF_Z:OFF_XBC], proj[..., OFF_XBC:OFF_DT], proj[..., OFF_DT:OFF_Q],
                          conv_w[i], conv_b[i], dt_bias[i], a_log[i], d_skip[i], ssd_norm_w[i])
        y_att = diff_attn_mixer(proj[..., OFF_Q:OFF_K], proj[..., OFF_K:OFF_V], proj[..., OFF_V:IN_PROJ],
                                lam_q1[i], lam_k1[i], lam_q2[i], lam_k2[i], subln_w[i], lam_init)
        x = x + jnp.concatenate([y_ssd, y_att], axis=-1) @ w_out[i]
        x = x + moe_ffn(rms_norm(x, g_ffn[i], NORM_EPS), w_router[i], b_router[i],
                        w_up[i], b_up[i], w_down[i], b_down[i])
        gate = jax.nn.sigmoid(rms_norm(x, g_ple[i], NORM_EPS) @ w_ple_gate[i])
        x = x + (p[i] @ w_ple_proj[i]) * gate
    return rms_norm(x, g_final, NORM_EPS)
```

```cpp
#include <hip/hip_runtime.h>
#include <stdint.h>

namespace nv {
constexpr int Bsz = 8, S = 2048, D = 1024, T = Bsz * S;
constexpr int INP = 3080, OFF_Z = 0, OFF_XBC = 512, OFF_DT = 1536, OFF_Q = 1544, OFF_K = 2056, OFF_V = 2568;
constexpr int NE = 32, TOPK = 4, CAP = T, PLE = 256;
constexpr float LAM_INIT = 0.2f;

__device__ __forceinline__ float wave_sum(float v) {
#pragma unroll
    for (int o = 32; o > 0; o >>= 1) v += __shfl_xor(v, o);
    return v;
}
__device__ __forceinline__ float wave_max(float v) {
#pragma unroll
    for (int o = 32; o > 0; o >>= 1) v = fmaxf(v, __shfl_xor(v, o));
    return v;
}
__device__ __forceinline__ float siluf(float v) { return v / (1.f + expf(-v)); }
__device__ __forceinline__ float sigmf(float v) { return 1.f / (1.f + expf(-v)); }

__global__ void __launch_bounds__(256) rmsnorm_k(const float* __restrict__ x, const float* __restrict__ g, float* __restrict__ out, float eps) {
    const int row = blockIdx.x * 4 + (threadIdx.x >> 6), lane = threadIdx.x & 63;
    const float4* xr = (const float4*)(x + (size_t)row * D);
    float4 v[4]; float s = 0.f;
#pragma unroll
    for (int j = 0; j < 4; ++j) { v[j] = xr[lane + 64 * j]; s += v[j].x * v[j].x + v[j].y * v[j].y + v[j].z * v[j].z + v[j].w * v[j].w; }
    s = wave_sum(s);
    const float r = rsqrtf(s * (1.f / D) + eps);
    float4* o = (float4*)(out + (size_t)row * D);
#pragma unroll
    for (int j = 0; j < 4; ++j) { const float4 gg = ((const float4*)g)[lane + 64 * j]; o[lane + 64 * j] = make_float4(v[j].x * r * gg.x, v[j].y * r * gg.y, v[j].z * r * gg.z, v[j].w * r * gg.w); }
}

template <class P> __global__ void __launch_bounds__(256) gemm_k(P p) {
    __shared__ float As[16][68];
    __shared__ float Bs[16][64];
    const int bz = blockIdx.z, m0 = blockIdx.y * 64, n0 = blockIdx.x * 64;
    const int M = p.M(bz);
    if (m0 >= M) return;
    const float* Bp = p.B(bz);
    const int tid = threadIdx.x, tx = tid & 15, ty = tid >> 4;
    float acc[4][4];
#pragma unroll
    for (int i = 0; i < 4; ++i)
#pragma unroll
        for (int j = 0; j < 4; ++j) acc[i][j] = 0.f;
    const int ar = tid >> 2, ak = (tid & 3) * 4;
    const float* arow = (m0 + ar < M) ? p.Arow(bz, m0 + ar) : nullptr;
    const int bk = tid >> 4, bn = (tid & 15) * 4;
    const bool bok = (n0 + bn) < p.N;
    for (int k0 = 0; k0 < p.K; k0 += 16) {
        float4 av = arow ? *(const float4*)(arow + k0 + ak) : make_float4(0.f, 0.f, 0.f, 0.f);
        float4 bv = bok ? *(const float4*)(Bp + (size_t)(k0 + bk) * p.N + n0 + bn) : make_float4(0.f, 0.f, 0.f, 0.f);
        As[ak + 0][ar] = av.x; As[ak + 1][ar] = av.y; As[ak + 2][ar] = av.z; As[ak + 3][ar] = av.w;
        *(float4*)&Bs[bk][bn] = bv;
        __syncthreads();
#pragma unroll
        for (int kk = 0; kk < 16; ++kk) {
            const float4 a = *(const float4*)&As[kk][ty * 4];
            const float4 b = *(const float4*)&Bs[kk][tx * 4];
            acc[0][0] += a.x * b.x; acc[0][1] += a.x * b.y; acc[0][2] += a.x * b.z; acc[0][3] += a.x * b.w;
            acc[1][0] += a.y * b.x; acc[1][1] += a.y * b.y; acc[1][2] += a.y * b.z; acc[1][3] += a.y * b.w;
            acc[2][0] += a.z * b.x; acc[2][1] += a.z * b.y; acc[2][2] += a.z * b.z; acc[2][3] += a.z * b.w;
            acc[3][0] += a.w * b.x; acc[3][1] += a.w * b.y; acc[3][2] += a.w * b.z; acc[3][3] += a.w * b.w;
        }
        __syncthreads();
    }
    const int n = n0 + tx * 4;
    if (n < p.N) {
#pragma unroll
        for (int i = 0; i < 4; ++i) { const int m = m0 + ty * 4 + i; if (m < M) p.store4(bz, m, n, acc[i][0], acc[i][1], acc[i][2], acc[i][3]); }
    }
}

struct PPlain {
    const float* A; const float* Bm; float* C; int Mv, N, K, pad;
    __device__ int M(int) const { return Mv; }
    __device__ const float* B(int) const { return Bm; }
    __device__ const float* Arow(int, int m) const { return A + (size_t)m * K; }
    __device__ void store4(int, int m, int n, float a, float b, float c, float d) const { *(float4*)(C + (size_t)m * N + n) = make_float4(a, b, c, d); }
};
struct PResid {
    const float* A; const float* Bm; const float* R; float* C; int Mv, N, K, pad;
    __device__ int M(int) const { return Mv; }
    __device__ const float* B(int) const { return Bm; }
    __device__ const float* Arow(int, int m) const { return A + (size_t)m * K; }
    __device__ void store4(int, int m, int n, float a, float b, float c, float d) const {
        const float4 r = *(const float4*)(R + (size_t)m * N + n); *(float4*)(C + (size_t)m * N + n) = make_float4(r.x + a, r.y + b, r.z + c, r.w + d); }
};
struct PSigm {
    const float* A; const float* Bm; float* C; int Mv, N, K, pad;
    __device__ int M(int) const { return Mv; }
    __device__ const float* B(int) const { return Bm; }
    __device__ const float* Arow(int, int m) const { return A + (size_t)m * K; }
    __device__ void store4(int, int m, int n, float a, float b, float c, float d) const { *(float4*)(C + (size_t)m * N + n) = make_float4(sigmf(a), sigmf(b), sigmf(c), sigmf(d)); }
};
struct PPleOut {
    const float* A; const float* Bm; const float* R; const float* G; float* C; int Mv, N, K, pad;
    __device__ int M(int) const { return Mv; }
    __device__ const float* B(int) const { return Bm; }
    __device__ const float* Arow(int, int m) const { return A + (size_t)m * K; }
    __device__ void store4(int, int m, int n, float a, float b, float c, float d) const {
        const float4 r = *(const float4*)(R + (size_t)m * N + n); const float4 g = *(const float4*)(G + (size_t)m * N + n);
        *(float4*)(C + (size_t)m * N + n) = make_float4(r.x + a * g.x, r.y + b * g.y, r.z + c * g.z, r.w + d * g.w); }
};
struct PMoeUp {
    const float* H; const float* W; const float* Bias; const int* cnt; const int* row_tok; float* act; int N, K;
    __device__ int M(int e) const { return cnt[e]; }
    __device__ int off(int e) const { int o = 0; for (int i = 0; i < e; ++i) o += cnt[i]; return o; }
    __device__ const float* B(int e) const { return W + (size_t)e * K * N; }
    __device__ const float* Arow(int e, int m) const { return H + (size_t)row_tok[e * CAP + m] * K; }
    __device__ void store4(int e, int m, int n, float a, float b, float c, float d) const {
        const float4 bb = *(const float4*)(Bias + (size_t)e * N + n);
        const float g0 = fminf(a + bb.x, 7.f), u0 = fminf(fmaxf(b + bb.y, -7.f), 7.f), g1 = fminf(c + bb.z, 7.f), u1 = fminf(fmaxf(d + bb.w, -7.f), 7.f);
        float* o = act + (size_t)(off(e) + m) * (N / 2) + n / 2;
        o[0] = (u0 + 1.f) * g0 * sigmf(1.702f * g0); o[1] = (u1 + 1.f) * g1 * sigmf(1.702f * g1); }
};
struct PMoeDown {
    const float* Act; const float* W; const float* Bias; const int* cnt; const float* row_gate; float* ys; int N, K;
    __device__ int M(int e) const { return cnt[e]; }
    __device__ int off(int e) const { int o = 0; for (int i = 0; i < e; ++i) o += cnt[i]; return o; }
    __device__ const float* B(int e) const { return W + (size_t)e * K * N; }
    __device__ const float* Arow(int e, int m) const { return Act + (size_t)(off(e) + m) * K; }
    __device__ void store4(int e, int m, int n, float a, float b, float c, float d) const {
        const float4 bb = *(const float4*)(Bias + (size_t)e * N + n); const float g = row_gate[e * CAP + m];
        *(float4*)(ys + (size_t)(off(e) + m) * N + n) = make_float4((a + bb.x) * g, (b + bb.y) * g, (c + bb.z) * g, (d + bb.w) * g); }
};

__global__ void __launch_bounds__(256) conv_k(const float* __restrict__ proj, const float* __restrict__ cw, const float* __restrict__ cb, float* __restrict__ xbc) {
    const int idx = blockIdx.x * 256 + threadIdx.x; const int t = idx >> 10, c = idx & 1023; const int s = t & (S - 1);
    float a = cb[c];
#pragma unroll
    for (int j = 0; j < 4; ++j) { const int ss = s - 3 + j; if (ss >= 0) a += cw[j * 1024 + c] * proj[(size_t)(t - 3 + j) * INP + OFF_XBC + c]; }
    xbc[idx] = siluf(a);
}

__global__ void __launch_bounds__(256) ssd_k(const float* __restrict__ proj, const float* __restrict__ xbc, const float* __restrict__ dt_bias, const float* __restrict__ a_log,
                                            const float* __restrict__ d_skip, float* __restrict__ yraw) {
    const int b = blockIdx.x >> 3, h = blockIdx.x & 7, g = h >> 2; const int tid = threadIdx.x, p = tid >> 2, nq = tid & 3;
    const float a = -expf(a_log[h]), dtb = dt_bias[h], dsk = d_skip[h];
    float st[32];
#pragma unroll
    for (int i = 0; i < 32; ++i) st[i] = 0.f;
    for (int s = 0; s < S; ++s) {
        const size_t t = (size_t)b * S + s;
        const float raw = proj[t * INP + OFF_DT + h] + dtb;
        const float dtv = raw > 20.f ? raw : log1pf(expf(raw));
        const float dec = expf(a * dtv);
        const float xv = xbc[t * 1024 + h * 64 + p], xd = xv * dtv;
        const float4* Bv = (const float4*)(xbc + t * 1024 + 512 + g * 128 + nq * 32);
        const float4* Cv = (const float4*)(xbc + t * 1024 + 768 + g * 128 + nq * 32);
        float y = 0.f;
#pragma unroll
        for (int i = 0; i < 8; ++i) {
            const float4 bb = Bv[i], cc = Cv[i];
            st[4 * i + 0] = st[4 * i + 0] * dec + xd * bb.x; y += cc.x * st[4 * i + 0];
            st[4 * i + 1] = st[4 * i + 1] * dec + xd * bb.y; y += cc.y * st[4 * i + 1];
            st[4 * i + 2] = st[4 * i + 2] * dec + xd * bb.z; y += cc.z * st[4 * i + 2];
            st[4 * i + 3] = st[4 * i + 3] * dec + xd * bb.w; y += cc.w * st[4 * i + 3];
        }
        y += __shfl_xor(y, 1); y += __shfl_xor(y, 2);
        if (nq == 0) yraw[t * 512 + h * 64 + p] = y + dsk * xv;
    }
}

__global__ void __launch_bounds__(256) ssdnorm_k(const float* __restrict__ yraw, const float* __restrict__ proj, const float* __restrict__ nw, float* __restrict__ ycat) {
    const int w = blockIdx.x * 4 + (threadIdx.x >> 6), lane = threadIdx.x & 63; const int t = w >> 1, g = w & 1;
    float v[4]; float s = 0.f;
#pragma unroll
    for (int j = 0; j < 4; ++j) { const int c = g * 256 + lane + 64 * j; const float z = proj[(size_t)t * INP + OFF_Z + c]; v[j] = yraw[(size_t)t * 512 + c] * siluf(z); s += v[j] * v[j]; }
    s = wave_sum(s);
    const float r = rsqrtf(s * (1.f / 256.f) + 1e-5f);
#pragma unroll
    for (int j = 0; j < 4; ++j) { const int c = g * 256 + lane + 64 * j; ycat[(size_t)t * 1024 + c] = v[j] * r * nw[c]; }
}

__global__ void __launch_bounds__(256) attn_k(const float* __restrict__ proj, const float* __restrict__ lq1, const float* __restrict__ lk1, const float* __restrict__ lq2, const float* __restrict__ lk2,
                                             const float* __restrict__ subw, float* __restrict__ ycat) {
    __shared__ float s0[S], s1[S], qs[128], red[8], ob[256];
    const int q = blockIdx.x & (S - 1), h = (blockIdx.x >> 11) & 3, b = blockIdx.x >> 13; const int tid = threadIdx.x, lane = tid & 63, wv = tid >> 6;
    const size_t trow = (size_t)b * S;
    if (tid < 128) qs[tid] = proj[(trow + q) * INP + OFF_Q + h * 128 + tid] * 0.125f;
    float l1 = 0.f, l2 = 0.f;
    if (tid < 64) { l1 = lq1[tid] * lk1[tid]; l2 = lq2[tid] * lk2[tid]; }
    if (wv == 0) { l1 = wave_sum(l1); l2 = wave_sum(l2); if (lane == 0) { red[6] = expf(l1) - expf(l2) + LAM_INIT; } }
    __syncthreads();
    const float lam = red[6];
    const int nk = q + 1;
    float m0 = -INFINITY, m1 = -INFINITY;
    for (int k = tid; k < nk; k += 256) {
        const float4* kr = (const float4*)(proj + (trow + k) * INP + OFF_K + h * 128);
        float a0 = 0.f, a1 = 0.f;
#pragma unroll
        for (int i = 0; i < 16; ++i) { const float4 kv = kr[i]; a0 += kv.x * qs[4 * i] + kv.y * qs[4 * i + 1] + kv.z * qs[4 * i + 2] + kv.w * qs[4 * i + 3]; }
#pragma unroll
        for (int i = 0; i < 16; ++i) { const float4 kv = kr[16 + i]; a1 += kv.x * qs[64 + 4 * i] + kv.y * qs[64 + 4 * i + 1] + kv.z * qs[64 + 4 * i + 2] + kv.w * qs[64 + 4 * i + 3]; }
        s0[k] = a0; s1[k] = a1; m0 = fmaxf(m0, a0); m1 = fmaxf(m1, a1);
    }
    m0 = wave_max(m0); m1 = wave_max(m1);
    if (lane == 0) { red[wv] = m0; ob[wv] = m1; }
    __syncthreads();
    m0 = fmaxf(fmaxf(red[0], red[1]), fmaxf(red[2], red[3])); m1 = fmaxf(fmaxf(ob[0], ob[1]), fmaxf(ob[2], ob[3]));
    __syncthreads();
    float e0 = 0.f, e1 = 0.f;
    for (int k = tid; k < nk; k += 256) { const float a = expf(s0[k] - m0), c = expf(s1[k] - m1); s0[k] = a; s1[k] = c; e0 += a; e1 += c; }
    e0 = wave_sum(e0); e1 = wave_sum(e1);
    if (lane == 0) { red[wv] = e0; ob[wv] = e1; }
    __syncthreads();
    e0 = red[0] + red[1] + red[2] + red[3]; e1 = ob[0] + ob[1] + ob[2] + ob[3];
    __syncthreads();
    const float i0 = 1.f / e0, i1 = lam / e1;
    for (int k = tid; k < nk; k += 256) s0[k] = s0[k] * i0 - s1[k] * i1;
    __syncthreads();
    const int e = tid & 127, half = tid >> 7;
    float o = 0.f;
    for (int k = half; k < nk; k += 2) o += s0[k] * proj[(trow + k) * INP + OFF_V + h * 128 + e];
    ob[tid] = o;
    __syncthreads();
    if (tid < 128) {
        o = ob[tid] + ob[tid + 128];
        float ss = wave_sum(o * o);
        if (lane == 0) red[wv] = ss;
    }
    __syncthreads();
    if (tid < 128) {
        const float r = rsqrtf((red[0] + red[1]) * (1.f / 128.f) + 1e-5f);
        ycat[(trow + q) * 1024 + 512 + h * 128 + tid] = o * r * subw[tid] * (1.f - LAM_INIT);
    }
}

__global__ void __launch_bounds__(256) router_k(const float* __restrict__ h2, const float* __restrict__ wr, const float* __restrict__ br, int* __restrict__ cnt, int* __restrict__ row_tok,
                                               float* __restrict__ row_gate, int* __restrict__ slot_e, int* __restrict__ slot_p) {
    const int t = blockIdx.x * 8 + (threadIdx.x >> 5), e = threadIdx.x & 31;
    const float* hr = h2 + (size_t)t * D;
    float acc = 0.f;
    for (int k = 0; k < D; k += 4) { const float4 hv = *(const float4*)(hr + k);
        acc += hv.x * wr[(k + 0) * NE + e]; acc += hv.y * wr[(k + 1) * NE + e]; acc += hv.z * wr[(k + 2) * NE + e]; acc += hv.w * wr[(k + 3) * NE + e]; }
    acc += br[e];
    float v = acc; float tv[4]; int ti[4];
#pragma unroll
    for (int r = 0; r < 4; ++r) {
        float bv = v; int bi = e;
#pragma unroll
        for (int o = 16; o > 0; o >>= 1) { const float ov = __shfl_xor(bv, o); const int oi = __shfl_xor(bi, o); if (ov > bv || (ov == bv && oi < bi)) { bv = ov; bi = oi; } }
        tv[r] = bv; ti[r] = bi; if (e == bi) v = -INFINITY;
    }
    if (e == 0) {
        const float mx = tv[0]; float ex[4], sm = 0.f;
#pragma unroll
        for (int r = 0; r < 4; ++r) { ex[r] = expf(tv[r] - mx); sm += ex[r]; }
#pragma unroll
        for (int r = 0; r < 4; ++r) { const int pos = atomicAdd(&cnt[ti[r]], 1); row_tok[ti[r] * CAP + pos] = t; row_gate[ti[r] * CAP + pos] = ex[r] / sm; slot_e[t * 4 + r] = ti[r]; slot_p[t * 4 + r] = pos; }
    }
}

__global__ void __launch_bounds__(256) combine_k(const float* __restrict__ x1, const float* __restrict__ ys, const int* __restrict__ cnt, const int* __restrict__ slot_e, const int* __restrict__ slot_p,
                                                const float* __restrict__ g, float* __restrict__ x2, float* __restrict__ h3) {
    const int t = blockIdx.x * 4 + (threadIdx.x >> 6), lane = threadIdx.x & 63;
    float4 v[4];
#pragma unroll
    for (int j = 0; j < 4; ++j) v[j] = ((const float4*)(x1 + (size_t)t * D))[lane + 64 * j];
#pragma unroll
    for (int r = 0; r < 4; ++r) {
        const int e = slot_e[t * 4 + r], pos = slot_p[t * 4 + r]; int off = 0; for (int i = 0; i < e; ++i) off += cnt[i];
        const float4* yr = (const float4*)(ys + (size_t)(off + pos) * D);
#pragma unroll
        for (int j = 0; j < 4; ++j) { const float4 y = yr[lane + 64 * j]; v[j].x += y.x; v[j].y += y.y; v[j].z += y.z; v[j].w += y.w; }
    }
    float s = 0.f;
#pragma unroll
    for (int j = 0; j < 4; ++j) { ((float4*)(x2 + (size_t)t * D))[lane + 64 * j] = v[j]; s += v[j].x * v[j].x + v[j].y * v[j].y + v[j].z * v[j].z + v[j].w * v[j].w; }
    s = wave_sum(s);
    const float r = rsqrtf(s * (1.f / D) + 1e-6f);
#pragma unroll
    for (int j = 0; j < 4; ++j) { const float4 gg = ((const float4*)g)[lane + 64 * j]; ((float4*)(h3 + (size_t)t * D))[lane + 64 * j] = make_float4(v[j].x * r * gg.x, v[j].y * r * gg.y, v[j].z * r * gg.z, v[j].w * r * gg.w); }
}
}

extern "C" void kernel_launch(void* const* d_in, const int* in_sizes, int n_in, void* d_out, int out_size, void* d_ws, size_t ws_size, hipStream_t stream) {
    using namespace nv;
    const float* x = (const float*)d_in[0]; const float* p = (const float*)d_in[1]; const float* g_mix = (const float*)d_in[2]; const float* w_in = (const float*)d_in[3];
    const float* conv_w = (const float*)d_in[4]; const float* conv_b = (const float*)d_in[5]; const float* dt_bias = (const float*)d_in[6]; const float* a_log = (const float*)d_in[7];
    const float* d_skip = (const float*)d_in[8]; const float* ssd_norm_w = (const float*)d_in[9]; const float* lq1 = (const float*)d_in[10]; const float* lk1 = (const float*)d_in[11];
    const float* lq2 = (const float*)d_in[12]; const float* lk2 = (const float*)d_in[13]; const float* subln_w = (const float*)d_in[14]; const float* w_out = (const float*)d_in[15];
    const float* g_ffn = (const float*)d_in[16]; const float* w_router = (const float*)d_in[17]; const float* b_router = (const float*)d_in[18]; const float* w_up = (const float*)d_in[19];
    const float* b_up = (const float*)d_in[20]; const float* w_down = (const float*)d_in[21]; const float* b_down = (const float*)d_in[22]; const float* g_ple = (const float*)d_in[23];
    const float* w_ple_gate = (const float*)d_in[24]; const float* w_ple_proj = (const float*)d_in[25]; const float* g_final = (const float*)d_in[26];
    float* out = (float*)d_out;
    char* ws = (char*)d_ws; const size_t MB = 1u << 20;
    int* cnt = (int*)(ws); int* row_tok = (int*)(ws + 1 * MB); float* row_gate = (float*)(ws + 4 * MB); int* slot_e = (int*)(ws + 7 * MB); int* slot_p = (int*)(ws + 8 * MB);
    float* hbuf = (float*)(ws + 16 * MB);
    float* x1 = (float*)(ws + 80 * MB);
    float* x2 = (float*)(ws + 144 * MB);
    float* proj = (float*)(ws + 208 * MB);
    float* xbc = (float*)(ws + 402 * MB);
    float* ycat = (float*)(ws + 466 * MB);
    float* yraw = (float*)(ws + 530 * MB);
    float* act = (float*)(ws + 208 * MB);
    float* ys = (float*)(ws + 466 * MB);
    float* gbuf = (float*)(ws + 208 * MB);

    (void)hipMemsetAsync(cnt, 0, 4096, stream);
    rmsnorm_k<<<T / 4, 256, 0, stream>>>(x, g_mix, hbuf, 1e-6f);
    { PPlain P{hbuf, w_in, proj, T, INP, D, 0}; gemm_k<PPlain><<<dim3((INP + 63) / 64, T / 64, 1), 256, 0, stream>>>(P); }
    conv_k<<<T * 1024 / 256, 256, 0, stream>>>(proj, conv_w, conv_b, xbc);
    ssd_k<<<64, 256, 0, stream>>>(proj, xbc, dt_bias, a_log, d_skip, yraw);
    ssdnorm_k<<<T * 2 / 4, 256, 0, stream>>>(yraw, proj, ssd_norm_w, ycat);
    attn_k<<<Bsz * 4 * S, 256, 0, stream>>>(proj, lq1, lk1, lq2, lk2, subln_w, ycat);
    { PResid P{ycat, w_out, x, x1, T, D, D, 0}; gemm_k<PResid><<<dim3(D / 64, T / 64, 1), 256, 0, stream>>>(P); }
    rmsnorm_k<<<T / 4, 256, 0, stream>>>(x1, g_ffn, hbuf, 1e-6f);
    router_k<<<T / 8, 256, 0, stream>>>(hbuf, w_router, b_router, cnt, row_tok, row_gate, slot_e, slot_p);
    { PMoeUp P{hbuf, w_up, b_up, cnt, row_tok, act, 2 * D, D}; gemm_k<PMoeUp><<<dim3(2 * D / 64, CAP / 64, NE), 256, 0, stream>>>(P); }
    { PMoeDown P{act, w_down, b_down, cnt, row_gate, ys, D, D}; gemm_k<PMoeDown><<<dim3(D / 64, CAP / 64, NE), 256, 0, stream>>>(P); }
    combine_k<<<T / 4, 256, 0, stream>>>(x1, ys, cnt, slot_e, slot_p, g_ple, x2, hbuf);
    { PSigm P{hbuf, w_ple_gate, gbuf, T, D, D, 0}; gemm_k<PSigm><<<dim3(D / 64, T / 64, 1), 256, 0, stream>>>(P); }
    { PPleOut P{p, w_ple_proj, x2, gbuf, x2, T, D, PLE, 0}; gemm_k<PPleOut><<<dim3(D / 64, T / 64, 1), 256, 0, stream>>>(P); }
    rmsnorm_k<<<T / 4, 256, 0, stream>>>(x2, g_final, out, 1e-6f);
}
```

```cpp
#include <hip/hip_runtime.h>
#include <cstdio>
#include <cstdint>
namespace pg8 {
#define PG8_LAS __attribute__((address_space(3)))
typedef unsigned short bf16_t;
typedef short bf16x8 __attribute__((ext_vector_type(8)));
typedef float f32x4 __attribute__((ext_vector_type(4)));
typedef unsigned u32x4 __attribute__((ext_vector_type(4)));
constexpr int BM = 256, BK = 64, HALF = 128, HTB = HALF * BK * 2  , STAGE_BYTES = 8 * HTB, NXCD = 8, WGM = 8;

__host__ __device__ __forceinline__ int lds_byte(int r, int c) { const int st = (r >> 4) * 2 + (c >> 5), rr = r & 15, cc = c & 31, ob = rr * 64 + cc * 2; return st * 1024 + (ob ^ (((ob >> 9) & 1) << 5)); }
__host__ __device__ __forceinline__ void stage_rc(int b, int& R, int& C) { const int st = b / 1024, sb = b % 1024, swz = sb ^ (((sb >> 9) & 1) << 5); R = (st >> 1) * 16 + swz / 64; C = (st & 1) * 32 + (swz % 64) / 2; }
__host__ __device__ __forceinline__ int perm32(int rho) { const int n = rho >> 4, i = rho & 15; return 8 * (i >> 2) + 4 * n + (i & 3); }


struct Unit { int pm, pn, e, r0; };
__device__ __forceinline__ unsigned cvt_pk_bf16(float lo, float hi) { unsigned r; asm volatile("v_cvt_pk_bf16_f32 %0, %1, %2" : "=v"(r) : "v"(lo), "v"(hi)); return r; }

struct DenseOrder {
    const char* A; const char* Bt; size_t tstep; int nM, nN, nwg, G, c;
    __device__ __forceinline__ void init(const void* A_, const void* Bt_, int M, int N, int K, int G_, int c_) { A = (const char*)A_; Bt = (const char*)Bt_; tstep = (size_t)BM * K * 2; nM = M / BM; nN = N / BM; nwg = nM * nN; G = G_; c = c_; }
    __device__ __forceinline__ bool next(int i, Unit& u) const {
        const long L = (long)i * G + c; if (L >= nwg) return false;
        int wgid = (int)L; { const int q = nwg / NXCD, r = nwg % NXCD, xcd = wgid % NXCD, off = wgid / NXCD; wgid = (xcd < r ? xcd * (q + 1) : r * (q + 1) + (xcd - r) * q) + off; }
        const int nig = WGM * nN, gid = wgid / nig, fm = gid * WGM, gsz = (nM - fm) < WGM ? (nM - fm) : WGM;
        u.pm = fm + ((wgid % nig) % gsz); u.pn = (wgid % nig) / gsz; u.e = 0; u.r0 = 0; return true;
    }
    __device__ __forceinline__ const char* a_ptr(const Unit& u) const { return A + (size_t)u.pm * tstep; }
    __device__ __forceinline__ const char* b_ptr(const Unit& u) const { return Bt + (size_t)u.pn * tstep; }
    __device__ __forceinline__ void a_ready(const Unit&) const {}
    __device__ __forceinline__ void done(const Unit&) const {}
};
struct MoeOrder {
    const PG8_LAS int* mts; const char* A; const char* Bt; size_t tstep, bexp; int NN, u0, u1, gather;
    __device__ __forceinline__ bool next(int i, Unit& u) const {
        const int idx = u0 + i; if (idx >= u1) return false;
        const int mt = idx / NN; u.pn = idx - mt * NN; u.pm = mt;
        int e = 0;
        for (int k = 1; k < 32; ++k) e += (__builtin_amdgcn_readfirstlane(mts[k]) <= mt) ? 1 : 0;
        u.e = e; u.r0 = (mt - __builtin_amdgcn_readfirstlane(mts[e])) * BM; return true;
    }
    __device__ __forceinline__ const char* a_ptr(const Unit& u) const { return gather ? A : A + (size_t)u.pm * tstep; }
    __device__ __forceinline__ const char* b_ptr(const Unit& u) const { return Bt + (size_t)u.e * bexp + (size_t)u.pn * tstep; }
    __device__ __forceinline__ void a_ready(const Unit&) const {}
    __device__ __forceinline__ void done(const Unit&) const {}
};

struct EpiBf16S {
    static constexpr bool PERM = true, AFTER_DRAIN = false;
    bf16_t* O; int ldc; int st0, st1; float scale;
    __device__ __forceinline__ void operator()(const f32x4 (&acc)[2][2][4][2], const Unit& u, int wr, int wc, int fr, int fq) const {
        const int row0 = u.pm * BM + wr * 64 + fr, col0 = u.pn * BM + wc * 32 + 8 * fq;
        const float sc = (u.pn >= st0 && u.pn < st1) ? scale : 1.f;
#pragma unroll
        for (int ai = 0; ai < 2; ++ai)
#pragma unroll
            for (int m = 0; m < 4; ++m) { bf16_t* rowp = O + (size_t)(row0 + ai * HALF + m * 16) * ldc + col0;
#pragma unroll
                for (int bj = 0; bj < 2; ++bj) { const f32x4 v0 = acc[ai][bj][m][0] * sc, v1 = acc[ai][bj][m][1] * sc;
                    u32x4 w; w.x = cvt_pk_bf16(v0[0], v0[1]); w.y = cvt_pk_bf16(v0[2], v0[3]); w.z = cvt_pk_bf16(v1[0], v1[1]); w.w = cvt_pk_bf16(v1[2], v1[3]);
                    *(u32x4*)(rowp + bj * HALF) = w; } }
    }
};
struct EpiResF32 {
    static constexpr bool PERM = false, AFTER_DRAIN = false;
    const float* base; float* out; int ldc;
    __device__ __forceinline__ void operator()(const f32x4 (&acc)[2][2][4][2], const Unit& u, int wr, int wc, int fr, int fq) const {
        const int row0 = u.pm * BM + wr * 64 + fr, col0 = u.pn * BM + wc * 32 + 4 * fq;
#pragma unroll
        for (int ai = 0; ai < 2; ++ai)
#pragma unroll
            for (int m = 0; m < 4; ++m) { const size_t off = (size_t)(row0 + ai * HALF + m * 16) * ldc + col0;
#pragma unroll
                for (int bj = 0; bj < 2; ++bj)
#pragma unroll
                    for (int n = 0; n < 2; ++n) { const f32x4 b = *(const f32x4*)(base + off + bj * HALF + n * 16); *(f32x4*)(out + off + bj * HALF + n * 16) = b + acc[ai][bj][m][n]; } }
    }
};
__device__ __forceinline__ float sigm_fast(float v) { return __builtin_amdgcn_rcpf(1.f + __builtin_amdgcn_exp2f(-1.4426950408889634f * v)); }
struct EpiPle {
    static constexpr bool PERM = false, AFTER_DRAIN = false;
    const float* base; const bf16_t* pp; float* out; int ldc;
    __device__ __forceinline__ void operator()(const f32x4 (&acc)[2][2][4][2], const Unit& u, int wr, int wc, int fr, int fq) const {
        typedef unsigned u32x2 __attribute__((ext_vector_type(2)));
        const int row0 = u.pm * BM + wr * 64 + fr, col0 = u.pn * BM + wc * 32 + 4 * fq;
#pragma unroll
        for (int ai = 0; ai < 2; ++ai)
#pragma unroll
            for (int m = 0; m < 4; ++m) { const size_t off = (size_t)(row0 + ai * HALF + m * 16) * ldc + col0;
#pragma unroll
                for (int bj = 0; bj < 2; ++bj)
#pragma unroll
                    for (int n = 0; n < 2; ++n) { const size_t o2 = off + bj * HALF + n * 16; const f32x4 b = *(const f32x4*)(base + o2); const u32x2 pw = *(const u32x2*)(pp + o2); const f32x4 a = acc[ai][bj][m][n];
                        f32x4 r; r[0] = b[0] + __uint_as_float(pw.x << 16) * sigm_fast(a[0]); r[1] = b[1] + __uint_as_float(pw.x & 0xffff0000u) * sigm_fast(a[1]);
                        r[2] = b[2] + __uint_as_float(pw.y << 16) * sigm_fast(a[2]); r[3] = b[3] + __uint_as_float(pw.y & 0xffff0000u) * sigm_fast(a[3]);
                        *(f32x4*)(out + o2) = r; } }
    }
};
struct EpiMoeUp {
    static constexpr bool PERM = true, AFTER_DRAIN = false;
    bf16_t* act; const float* bias;
    __device__ __forceinline__ void operator()(const f32x4 (&acc)[2][2][4][2], const Unit& u, int wr, int wc, int fr, int fq) const {
        typedef unsigned u32x2 __attribute__((ext_vector_type(2)));
        const int row0 = u.pm * BM + wr * 64 + fr, col0 = u.pn * BM + wc * 32 + 8 * fq;
        const float* bp = bias + (size_t)u.e * 2048 + col0;
        f32x4 bv[2][2];
#pragma unroll
        for (int bj = 0; bj < 2; ++bj)
#pragma unroll
            for (int n = 0; n < 2; ++n) bv[bj][n] = *(const f32x4*)(bp + bj * HALF + 4 * n);
#pragma unroll
        for (int ai = 0; ai < 2; ++ai)
#pragma unroll
            for (int m = 0; m < 4; ++m) { bf16_t* rowp = act + (size_t)(row0 + ai * HALF + m * 16) * 1024 + (col0 >> 1);
#pragma unroll
                for (int bj = 0; bj < 2; ++bj) { const f32x4 v0 = acc[ai][bj][m][0] + bv[bj][0], v1 = acc[ai][bj][m][1] + bv[bj][1];
                    float o[4];
#pragma unroll
                    for (int q = 0; q < 4; ++q) { const float g = fminf(q < 2 ? v0[2 * q] : v1[2 * q - 4], 7.f); const float up = fminf(fmaxf(q < 2 ? v0[2 * q + 1] : v1[2 * q - 3], -7.f), 7.f);
                        o[q] = (up + 1.f) * g * sigm_fast(1.702f * g); }
                    u32x2 w; w.x = cvt_pk_bf16(o[0], o[1]); w.y = cvt_pk_bf16(o[2], o[3]);
                    *(u32x2*)(rowp + bj * (HALF / 2)) = w; } }
    }
};
struct EpiMoeDown {
    static constexpr bool PERM = true, AFTER_DRAIN = false;
    bf16_t* ys; const float* bias; const float* row_gate;
    __device__ __forceinline__ void operator()(const f32x4 (&acc)[2][2][4][2], const Unit& u, int wr, int wc, int fr, int fq) const {
        const int lrow0 = wr * 64 + fr, col0 = u.pn * BM + wc * 32 + 8 * fq;
        const float* bp = bias + (size_t)u.e * 1024 + col0; const float* gp = row_gate + (size_t)u.e * 16384 + u.r0;
        f32x4 bv[2][2];
#pragma unroll
        for (int bj = 0; bj < 2; ++bj)
#pragma unroll
            for (int n = 0; n < 2; ++n) bv[bj][n] = *(const f32x4*)(bp + bj * HALF + 4 * n);
#pragma unroll
        for (int ai = 0; ai < 2; ++ai)
#pragma unroll
            for (int m = 0; m < 4; ++m) { const int lr = lrow0 + ai * HALF + m * 16; const float g = gp[lr]; bf16_t* rowp = ys + (size_t)(u.pm * BM + lr) * 1024 + col0;
#pragma unroll
                for (int bj = 0; bj < 2; ++bj) { const f32x4 v0 = (acc[ai][bj][m][0] + bv[bj][0]) * g, v1 = (acc[ai][bj][m][1] + bv[bj][1]) * g;
                    u32x4 w; w.x = cvt_pk_bf16(v0[0], v0[1]); w.y = cvt_pk_bf16(v0[2], v0[3]); w.z = cvt_pk_bf16(v1[0], v1[1]); w.w = cvt_pk_bf16(v1[2], v1[3]);
                    *(u32x4*)(rowp + bj * HALF) = w; } }
    }
};

template <class Epi, class Sched, bool GATHER = false, bool ALIGN_EPI = false, bool SP2 = false>
__device__ __forceinline__ void gemm_phase(PG8_LAS unsigned char* lds, const int K, const Sched& S, const Epi& E, const PG8_LAS unsigned* gtab) {
    const int tid = threadIdx.x, wid = __builtin_amdgcn_readfirstlane(tid >> 6), lane = tid & 63, wr = wid >> 2, wc = wid & 3, fr = lane & 15, fq = lane >> 4;
    const int nt = K / BK;
    unsigned voffA[2][2], voffB[2];
#pragma unroll
    for (int i = 0; i < 2; ++i) { int R, C; stage_rc(tid * 16 + i * 8192, R, C); const int Rb = Epi::PERM ? ((R & ~31) + perm32(R & 31)) : R;
        voffA[0][i] = (unsigned)(R * K + C) * 2u; voffA[1][i] = (unsigned)((R + HALF) * K + C) * 2u; voffB[i] = (unsigned)(Rb * K + C) * 2u; }
#define PG8_GLOAD(UI) do { _Pragma("unroll") for (int _i = 0; _i < 2; ++_i) { int R_, C_; stage_rc(tid * 16 + _i * 8192, R_, C_); \
        voffA[0][_i] = gtab[(UI) * 256 + R_] + (unsigned)C_ * 2u; voffA[1][_i] = gtab[(UI) * 256 + HALF + R_] + (unsigned)C_ * 2u; } } while (0)
    const size_t kstep = (size_t)(BK * 2);
    const size_t hstep = (size_t)HALF * K * 2;
    const size_t tstep = 2 * hstep;
    const unsigned ldsw = (unsigned)wid * 1024u;
    const int aoff = lds_byte(wr * 64 + fr, fq * 8), boff = lds_byte(wc * 32 + fr, fq * 8);
#define PG8_SA(b, h) (((b) * 2 + (h)) * HTB)
#define PG8_SB(b, h) ((4 + (b) * 2 + (h)) * HTB)
#define PG8_STAGE(bufoff, gbase, voff) do { _Pragma("unroll") for (int _i = 0; _i < 2; ++_i) \
        __builtin_amdgcn_global_load_lds((const unsigned*)((const char*)(gbase) + (voff)[_i]), (PG8_LAS unsigned*)(lds + (bufoff) + ldsw + _i * 8192), 16, 0, 0); } while (0)
#define PG8_LDA(dst, b, h) do { _Pragma("unroll") for (int m = 0; m < 4; ++m) _Pragma("unroll") for (int k = 0; k < 2; ++k) dst[m][k] = *(const PG8_LAS bf16x8*)(lds + PG8_SA(b, h) + aoff + m * 2048 + k * 1024); } while (0)
#define PG8_LDB(dst, b, h) do { _Pragma("unroll") for (int n = 0; n < 2; ++n) _Pragma("unroll") for (int k = 0; k < 2; ++k) dst[n][k] = *(const PG8_LAS bf16x8*)(lds + PG8_SB(b, h) + boff + n * 2048 + k * 1024); } while (0)
#define PG8_MMA(ai, bj, At, Bt) do { __builtin_amdgcn_s_setprio(1); _Pragma("unroll") for (int m = 0; m < 4; ++m) _Pragma("unroll") for (int n = 0; n < 2; ++n) _Pragma("unroll") for (int k = 0; k < 2; ++k) \
        acc[ai][bj][m][n] = __builtin_amdgcn_mfma_f32_16x16x32_bf16(Bt[n][k], At[m][k], acc[ai][bj][m][n], 0, 0, 0); __builtin_amdgcn_s_setprio(0); } while (0)
#define PG8_WAIT_V(n) asm volatile("s_waitcnt vmcnt(" #n ")" ::: "memory")
#define PG8_WAIT_L(n) asm volatile("s_waitcnt lgkmcnt(" #n ")" ::: "memory")
#define PG8_BAR __builtin_amdgcn_s_barrier()
#define PG8_SCHED __builtin_amdgcn_sched_barrier(0)
    Unit cur, nxt; int ui = 0;
    if (!S.next(0, cur)) return;
    f32x4 acc[2][2][4][2];
#pragma unroll
    for (int a = 0; a < 2; ++a)
#pragma unroll
        for (int b = 0; b < 2; ++b)
#pragma unroll
            for (int m = 0; m < 4; ++m)
#pragma unroll
                for (int n = 0; n < 2; ++n) acc[a][b][m][n] = (f32x4){0.f, 0.f, 0.f, 0.f};
    bf16x8 At[4][2], B0[2][2], B1[2][2];
    const char* cA = S.a_ptr(cur); const char* cB = S.b_ptr(cur);
    if constexpr (GATHER) PG8_GLOAD(0);
    S.a_ready(cur);
    if constexpr (SP2) {
        PG8_STAGE(PG8_SB(0, 0), cB, voffB); PG8_STAGE(PG8_SB(0, 1), cB + hstep, voffB); PG8_STAGE(PG8_SA(0, 0), cA, voffA[0]); PG8_STAGE(PG8_SA(0, 1), cA, voffA[1]);
        if (wr == 1) PG8_BAR;
        PG8_WAIT_V(2); PG8_BAR;
        PG8_STAGE(PG8_SB(1, 0), cB + kstep, voffB); PG8_STAGE(PG8_SA(1, 0), cA + kstep, voffA[0]); PG8_STAGE(PG8_SB(1, 1), cB + hstep + kstep, voffB);
        PG8_WAIT_V(6); PG8_BAR;
    } else {
        PG8_STAGE(PG8_SB(0, 0), cB, voffB); PG8_STAGE(PG8_SA(0, 0), cA, voffA[0]); PG8_STAGE(PG8_SB(0, 1), cB + hstep, voffB); PG8_STAGE(PG8_SA(0, 1), cA, voffA[1]);
        if (wr == 1) PG8_BAR;
        PG8_WAIT_V(4); PG8_BAR;
        PG8_STAGE(PG8_SB(1, 0), cB + kstep, voffB); PG8_STAGE(PG8_SA(1, 0), cA + kstep, voffA[0]); PG8_STAGE(PG8_SB(1, 1), cB + hstep + kstep, voffB);
        PG8_WAIT_V(6); PG8_BAR;
    }
    for (;;) {
        const bool has_next = S.next(ui + 1, nxt);
        const char* nA = has_next ? S.a_ptr(nxt) : cA; const char* nB = has_next ? S.b_ptr(nxt) : cB;
        for (int t = 0; t < nt; t += 2) {
            const bool last = (t == nt - 2);
            const char* a1 = cA + (size_t)(t + 1) * kstep;
            const char* a2 = last ? nA : cA + (size_t)(t + 2) * kstep; const char* b2 = last ? nB : cB + (size_t)(t + 2) * kstep;
            const char* a3 = a2 + kstep; const char* b3 = b2 + kstep;
            if (last && has_next) S.a_ready(nxt);
            if constexpr (SP2) {
            PG8_LDB(B0, 0, 0); PG8_LDB(B1, 0, 1); PG8_SCHED; PG8_LDA(At, 0, 0); PG8_STAGE(PG8_SA(1, 1), a1, voffA[1]); if constexpr (GATHER) { if (last && has_next) PG8_GLOAD(ui + 1); }
            PG8_WAIT_V(8); PG8_WAIT_L(0); PG8_BAR; PG8_MMA(0, 0, At, B0); PG8_MMA(0, 1, At, B1); PG8_BAR; PG8_SCHED;
            PG8_LDA(At, 0, 1); PG8_STAGE(PG8_SB(0, 0), b2, voffB); PG8_STAGE(PG8_SB(0, 1), b2 + hstep, voffB); PG8_STAGE(PG8_SA(0, 0), a2, voffA[0]);
            PG8_WAIT_V(8); PG8_WAIT_L(0); PG8_BAR; PG8_MMA(1, 0, At, B0); PG8_MMA(1, 1, At, B1); PG8_BAR; PG8_SCHED;
            PG8_LDB(B0, 1, 0); PG8_LDB(B1, 1, 1); PG8_SCHED; PG8_LDA(At, 1, 0); PG8_STAGE(PG8_SA(0, 1), a2, voffA[1]);
            PG8_WAIT_V(8); PG8_WAIT_L(0); PG8_BAR; PG8_MMA(0, 0, At, B0); PG8_MMA(0, 1, At, B1); PG8_BAR; PG8_SCHED;
            PG8_LDA(At, 1, 1); PG8_STAGE(PG8_SB(1, 0), b3, voffB); PG8_STAGE(PG8_SB(1, 1), b3 + hstep, voffB); PG8_STAGE(PG8_SA(1, 0), a3, voffA[0]);
            PG8_WAIT_V(8); PG8_WAIT_L(0); PG8_BAR; PG8_MMA(1, 0, At, B0); PG8_MMA(1, 1, At, B1); PG8_BAR; PG8_SCHED;
            } else {
            PG8_LDB(B0, 0, 0); PG8_SCHED; PG8_LDA(At, 0, 0); PG8_STAGE(PG8_SA(1, 1), a1, voffA[1]); if constexpr (GATHER) { if (last && has_next) PG8_GLOAD(ui + 1); }
            PG8_WAIT_L(8); PG8_BAR; PG8_WAIT_L(0); PG8_MMA(0, 0, At, B0); PG8_BAR; PG8_SCHED;
            PG8_LDB(B1, 0, 1); PG8_STAGE(PG8_SB(0, 0), b2, voffB);
            PG8_BAR; PG8_WAIT_L(0); PG8_MMA(0, 1, At, B1); PG8_BAR;
            PG8_LDA(At, 0, 1); PG8_STAGE(PG8_SA(0, 0), a2, voffA[0]);
            PG8_BAR; PG8_WAIT_L(0); PG8_MMA(1, 0, At, B0); PG8_BAR; PG8_SCHED;
            PG8_STAGE(PG8_SB(0, 1), b2 + hstep, voffB);
            PG8_WAIT_V(6); PG8_BAR; PG8_MMA(1, 1, At, B1); PG8_BAR;
            PG8_LDB(B0, 1, 0); PG8_SCHED; PG8_LDA(At, 1, 0); PG8_STAGE(PG8_SA(0, 1), a2, voffA[1]);
            PG8_WAIT_L(8); PG8_BAR; PG8_WAIT_L(0); PG8_MMA(0, 0, At, B0); PG8_BAR; PG8_SCHED;
            PG8_LDB(B1, 1, 1); PG8_STAGE(PG8_SB(1, 0), b3, voffB);
            PG8_BAR; PG8_WAIT_L(0); PG8_MMA(0, 1, At, B1); PG8_BAR;
            PG8_LDA(At, 1, 1); PG8_STAGE(PG8_SA(1, 0), a3, voffA[0]);
            PG8_BAR; PG8_WAIT_L(0); PG8_MMA(1, 0, At, B0); PG8_BAR; PG8_SCHED;
            PG8_STAGE(PG8_SB(1, 1), b3 + hstep, voffB);
            PG8_WAIT_V(6); PG8_BAR; PG8_MMA(1, 1, At, B1); PG8_BAR;
            }
        }
        if constexpr (ALIGN_EPI) { if (wr == 0) PG8_BAR; }
        if constexpr (!Epi::AFTER_DRAIN) { E(acc, cur, wr, wc, fr, fq); S.done(cur); }
        if (!has_next) break;
#pragma unroll
        for (int a = 0; a < 2; ++a)
#pragma unroll
            for (int b = 0; b < 2; ++b)
#pragma unroll
                for (int m = 0; m < 4; ++m)
#pragma unroll
                    for (int n = 0; n < 2; ++n) acc[a][b][m][n] = (f32x4){0.f, 0.f, 0.f, 0.f};
        cur = nxt; cA = nA; cB = nB; ++ui;
        if constexpr (ALIGN_EPI) { if (wr == 1) PG8_BAR; }
    }
    PG8_WAIT_V(0);
    if constexpr (!ALIGN_EPI) { if (wr == 0) PG8_BAR; }
    PG8_BAR;
    if constexpr (Epi::AFTER_DRAIN) { E.fused(acc, cur, wr, wc, fr, fq, lds, wid, lane); S.done(cur); }
#undef PG8_SA
#undef PG8_SB
#undef PG8_STAGE
#undef PG8_LDA
#undef PG8_LDB
#undef PG8_MMA
#undef PG8_WAIT_V
#undef PG8_WAIT_L
#undef PG8_BAR
#undef PG8_SCHED
#undef PG8_GLOAD
}
}
#include <hip/hip_bf16.h>
#include <cmath>
namespace attn_body {
using bf16=__hip_bfloat16;
using bf16x8=__attribute__((ext_vector_type(8)))short;
using s16x4=__attribute__((ext_vector_type(4)))short;
using f32x16=__attribute__((ext_vector_type(16)))float;
using u32x4=__attribute__((ext_vector_type(4)))unsigned;
constexpr int BATCH=8,NHEAD=16,SEQ=2048,D=64,DMI=3072,DMO=1024;
constexpr int NW=8,QBLK=32,QB=QBLK*NW,KVBLK=64,NQB=SEQ/QB;
constexpr int ATTN_UNIT_ROWS=QB;
__device__ __forceinline__ int crow(int r,int hi){return (r&3)+8*(r>>2)+4*hi;}
#define SBAR() __builtin_amdgcn_sched_barrier(0)
__device__ __forceinline__ void cmask(f32x16&p0,f32x16&p1,int jb,int qrel,int hi){
  const float NEG=-INFINITY; int kb=64*jb+4*hi;
  #pragma unroll
  for(int r=0;r<16;++r){int kv=kb+(r&3)+8*(r>>2); if(kv>qrel)p0[r]=NEG; if(kv+32>qrel)p1[r]=NEG;}
}

constexpr int NSLOT=3, SLOTB=8192;
constexpr int LDS_K=0, LDS_V=NSLOT*SLOTB, LDS_WS=2*NSLOT*SLOTB, LDS_OST=LDS_WS+NW*64*4, LDS_BYTES=LDS_OST+NW*4096;
constexpr float C2=0.125f*1.4426950408889634f;
__device__ __forceinline__ void glds16(const void*gsrc,unsigned lds_dst){unsigned keep;
  asm volatile("s_mov_b32 %0, m0\n\ts_mov_b32 m0, %2\n\ts_nop 0\n\tglobal_load_lds_dwordx4 %1, off\n\ts_mov_b32 m0, %0":"=&s"(keep):"v"(gsrc),"s"(lds_dst):"memory");}
__device__ __forceinline__ float max3f(float a,float b,float c){float r;asm("v_max3_f32 %0, %1, %2, %3":"=v"(r):"v"(a),"v"(b),"v"(c));return r;}
__device__ __forceinline__ float max2f(float a,float b){float r;asm("v_max_f32_e32 %0, %1, %2":"=v"(r):"v"(a),"v"(b));return r;}
__device__ __forceinline__ float fadd_s(float a,float b){float r;asm("v_add_f32_e32 %0, %1, %2":"=v"(r):"v"(a),"v"(b));return r;}
__device__ __forceinline__ float fsub_s(float a,float b){float r;asm("v_sub_f32_e32 %0, %1, %2":"=v"(r):"v"(a),"v"(b));return r;}
typedef float f32x2_t __attribute__((ext_vector_type(2))); typedef __bf16 bf16x2_t __attribute__((ext_vector_type(2)));
__device__ __forceinline__ unsigned cvtpk_s(float lo,float hi){f32x2_t v={lo,hi};bf16x2_t b=__builtin_convertvector(v,bf16x2_t);return __builtin_bit_cast(unsigned,b);}
#define WAIT_BAR(N) asm volatile("s_waitcnt vmcnt(" #N ") lgkmcnt(0)\n\ts_barrier":::"memory")

__device__ __forceinline__ void qkt(f32x16&p0,f32x16&p1,const char*Kslot,const bf16x8*qr,const f32x16&negm,int r32,int hi){
  const char*kb=Kslot+hi*1024+r32*16;
  #pragma unroll
  for(int d0=0;d0<4;++d0){
    const bf16x8 b0=*reinterpret_cast<const bf16x8*>(kb+d0*2048);
    const bf16x8 b1=*reinterpret_cast<const bf16x8*>(kb+d0*2048+512);
    if(d0==0){p0=__builtin_amdgcn_mfma_f32_32x32x16_bf16(b0,qr[0],negm,0,0,0);p1=__builtin_amdgcn_mfma_f32_32x32x16_bf16(b1,qr[0],negm,0,0,0);}
    else{p0=__builtin_amdgcn_mfma_f32_32x32x16_bf16(b0,qr[d0],p0,0,0,0);p1=__builtin_amdgcn_mfma_f32_32x32x16_bf16(b1,qr[d0],p1,0,0,0);}}
}
typedef __attribute__((address_space(3))) const char* lds_cptr;
typedef short v4i16_t __attribute__((ext_vector_type(4)));
__device__ __forceinline__ void kload8(bf16x8*kf,lds_cptr kp){
  kf[0]=*(const __attribute__((address_space(3))) bf16x8*)(kp);      kf[1]=*(const __attribute__((address_space(3))) bf16x8*)(kp+512);
  kf[2]=*(const __attribute__((address_space(3))) bf16x8*)(kp+2048); kf[3]=*(const __attribute__((address_space(3))) bf16x8*)(kp+2560);
  kf[4]=*(const __attribute__((address_space(3))) bf16x8*)(kp+4096); kf[5]=*(const __attribute__((address_space(3))) bf16x8*)(kp+4608);
  kf[6]=*(const __attribute__((address_space(3))) bf16x8*)(kp+6144); kf[7]=*(const __attribute__((address_space(3))) bf16x8*)(kp+6656);
}
__device__ __forceinline__ void kload2(bf16x8*kf,lds_cptr kp,int j){ kf[2*j]=*(const __attribute__((address_space(3))) bf16x8*)(kp+j*2048); kf[2*j+1]=*(const __attribute__((address_space(3))) bf16x8*)(kp+j*2048+512); }
__device__ __forceinline__ s16x4 vtr(lds_cptr p){ return __builtin_bit_cast(s16x4,__builtin_amdgcn_ds_read_tr16_b64_v4i16((__attribute__((address_space(3))) v4i16_t*)p)); }
__device__ __forceinline__ float rowmax(const f32x16&p0,const f32x16&p1){
  float a=max3f(p0[0],p0[1],p1[0]),b=max3f(p0[2],p0[3],p1[1]);a=max3f(a,p1[2],p1[3]);
  #pragma unroll
  for(int r=4;r<16;r+=4){a=max3f(a,p0[r],p0[r+1]);b=max3f(b,p0[r+2],p0[r+3]);a=max3f(a,p1[r],p1[r+1]);b=max3f(b,p1[r+2],p1[r+3]);}
  const float m=max2f(a,b);
  auto rr=__builtin_amdgcn_permlane32_swap(__float_as_uint(m),__float_as_uint(m),false,false);
  return max2f(__uint_as_float(rr[0]),__uint_as_float(rr[1]));
}
__device__ __forceinline__ void pv(f32x16*o,int vb,bf16x8 pa0,bf16x8 pa1,bf16x8 pa2,bf16x8 pa3){
  #pragma unroll
  for(int d0=0;d0<2;++d0){s16x4 lo[4],hi[4];
    #pragma unroll
    for(int ks=0;ks<4;++ks){
      asm volatile("ds_read_b64_tr_b16 %0,%1 offset:%c2":"=&v"(lo[ks]):"v"(vb),"i"(d0*4096+ks*1024):"memory");
      asm volatile("ds_read_b64_tr_b16 %0,%1 offset:%c2":"=&v"(hi[ks]):"v"(vb),"i"(d0*4096+ks*1024+512):"memory");}
    asm volatile("s_waitcnt lgkmcnt(0)":::"memory");SBAR();
    #define PK(k) (bf16x8){lo[k][0],lo[k][1],lo[k][2],lo[k][3],hi[k][0],hi[k][1],hi[k][2],hi[k][3]}
    o[d0]=__builtin_amdgcn_mfma_f32_32x32x16_bf16(pa0,PK(0),o[d0],0,0,0);
    o[d0]=__builtin_amdgcn_mfma_f32_32x32x16_bf16(pa1,PK(1),o[d0],0,0,0);
    o[d0]=__builtin_amdgcn_mfma_f32_32x32x16_bf16(pa2,PK(2),o[d0],0,0,0);
    o[d0]=__builtin_amdgcn_mfma_f32_32x32x16_bf16(pa3,PK(3),o[d0],0,0,0);
    #undef PK
  }
}

#ifndef ATTN_STORE16
#define ATTN_STORE16(p,v) (*(u32x4*)(p)=(v))
#endif
template<int THRL> __device__ __forceinline__ void attn_unit(int b,int qb,const bf16*Q,const bf16*__restrict__ K,const bf16*__restrict__ V,bf16*O,char*shm){
  const int tid=threadIdx.x,lane=tid&63,r32=lane&31,hi=lane>>5; const int wid=__builtin_amdgcn_readfirstlane(tid>>6);
  const long rowbase=(long)b*SEQ; const int q0=qb*QB;
  const bf16*Qw=Q+(rowbase+q0+wid*QBLK)*DMI;
  const bf16*Kh=K+rowbase*DMI,*Vh=V+rowbase*DMI;
  const unsigned lds0=(unsigned)(uintptr_t)shm;
  float*wsf=(float*)(shm+LDS_WS)+wid*64;
  const bf16*ksrc=Kh+(long)lane*DMI+wid*8;
  const bf16*vsrc=Vh+(long)(16*(wid&3)+(lane>>2))*DMI+(wid>>2)*32+(lane&3)*8;
  const unsigned kdst=lds0+LDS_K+wid*1024, vdst=lds0+LDS_V+wid*1024;
  #define DMA_K(t,slot) glds16(ksrc+(long)(t)*KVBLK*DMI,(unsigned)__builtin_amdgcn_readfirstlane(kdst+(slot)))
  #define DMA_V(t,slot) glds16(vsrc+(long)(t)*KVBLK*DMI,(unsigned)__builtin_amdgcn_readfirstlane(vdst+(slot)))
  const int vb0=(int)(lds0+LDS_V)+((lane>>4)&1)*32+(lane&3)*8+(4*hi+((lane&15)>>2))*64;
  const char*Kbase=shm+LDS_K; bf16x8 kf[8];
  const lds_cptr shm3=(lds_cptr)shm; const lds_cptr kp0=shm3+LDS_K+hi*1024+r32*16; const lds_cptr vp0=shm3+LDS_V+((lane>>4)&1)*32+(lane&3)*8+(4*hi+((lane&15)>>2))*64;
  const int NT=(q0+QB)/KVBLK;
  DMA_K(0,0);DMA_V(0,0);DMA_K(1,SLOTB);
  bf16x8 qr[4];
  #pragma unroll
  for(int d0=0;d0<4;++d0)qr[d0]=*reinterpret_cast<const bf16x8*>(&Qw[(long)r32*DMI+d0*16+hi*8]);
  float mhat=0.f,l_reg=0.f;f32x16 o[2];o[0]=f32x16{};o[1]=f32x16{};f32x16 negm=f32x16{};asm volatile("":"+v"(negm));
  const int qrel=wid*QBLK+r32;
  #define CMASK(P0,P1,t) do{int jb_=(t)-(NT-4); if(jb_>=0)cmask(P0,P1,jb_,qrel,hi);}while(0)
  bool resc=false;
  #define START(P0,P1) do{ const float rm=rowmax(P0,P1); resc=false; \
    { const float dl=rm; mhat=fadd_s(mhat,dl); \
      _Pragma("unroll") for(int r=0;r<16;++r){P0[r]=fsub_s(P0[r],dl);P1[r]=fsub_s(P1[r],dl);} \
      _Pragma("unroll") for(int r=0;r<16;++r)negm[r]=-mhat; asm volatile("":"+v"(negm)); } \
    _Pragma("unroll") for(int r=0;r<16;++r)P0[r]=__builtin_amdgcn_exp2f(P0[r]); }while(0)
  #define RESC() do{ if(resc){ asm volatile("s_waitcnt lgkmcnt(0)":::"memory"); \
      _Pragma("unroll") for(int d_=0;d_<2;++d_) _Pragma("unroll") for(int r=0;r<16;++r)o[d_][r]*=wsf[crow(r,hi)]; } }while(0)
  f32x16 pA0,pA1,pB0,pB1;
  int sl_prev=0,sl_cur=0,sl_next=SLOTB;
  #define ROT() do{sl_prev=sl_cur;sl_cur=sl_next;sl_next=(sl_next==(NSLOT-1)*SLOTB)?0:sl_next+SLOTB;}while(0)
  DMA_K(2,2*SLOTB);
  WAIT_BAR(3);
  qkt(pA0,pA1,Kbase,qr,negm,r32,hi);asm volatile("s_nop 15\n\ts_nop 7":"+v"(pA0),"+v"(pA1));CMASK(pA0,pA1,0);
  START(pA0,pA1);
  _Pragma("unroll") for(int r=0;r<16;++r)pA1[r]=__builtin_amdgcn_exp2f(pA1[r]);
  WAIT_BAR(0);
  DMA_K(3,0);DMA_V(1,SLOTB);
  ROT();
  kload8(kf,kp0+sl_cur);
  WAIT_BAR(2);
  s16x4 vlo[8],vhi[8]; u32x4 pw0,pw1,pw2,pw3;
  #define PKW(P,B) cvtpk_s(P[B],P[B+1])
  #define PAF(k) __builtin_bit_cast(bf16x8,pw##k)
  #define VFR(i) (bf16x8){vlo[i][0],vlo[i][1],vlo[i][2],vlo[i][3],vhi[i][0],vhi[i][1],vhi[i][2],vhi[i][3]}
  #define PIN(x) asm volatile("":"+v"(x))
  #define MX3(a,b,c) __builtin_fmaxf(__builtin_fmaxf((a),(b)),(c))
  #define GAPA(MF,A0,A1,A2,A3,W0,W1,PW) do{ MF; sacc+=A0; sacc+=A1; sacc+=A2; sacc+=A3; PIN(sacc); W0; W1; PIN(PW); SBAR(); }while(0)
  #define EX(v) __builtin_amdgcn_exp2f(v)
  #define GAPB(MF,X,B) do{ MF; X[B]=EX(X[B]); X[B+1]=EX(X[B+1]); X[B+2]=EX(X[B+2]); X[B+3]=EX(X[B+3]); PIN(X); SBAR(); }while(0)
  #define VRD(i) do{ vlo[i]=vtr(vp_+(((i)>>2)*4096+((i)&3)*1024)); vhi[i]=vtr(vp_+(((i)>>2)*4096+((i)&3)*1024+512)); }while(0)
  #define KRD(G,j) do{ if(G){ kload2(kf,kp0+sl_next,j); SBAR(); } }while(0)
  #define STEP(C0,C1,P0,P1,t,GK,GV,GL) do{ SBAR(); \
    const lds_cptr vp_=vp0+sl_prev; \
    VRD(0); SBAR(); float sacc=(P0[0]+P0[1]); \
    GAPA(C0=__builtin_amdgcn_mfma_f32_32x32x16_bf16(kf[0],qr[0],negm,0,0,0), P0[2],P0[3],P0[4],P0[5],     pw0[0]=PKW(P0,0), pw0[1]=PKW(P0,2), pw0); \
    VRD(4); SBAR(); GAPA(C1=__builtin_amdgcn_mfma_f32_32x32x16_bf16(kf[1],qr[0],negm,0,0,0), P0[6],P0[7],P0[8],P0[9],     pw0[2]=PKW(P0,4), pw0[3]=PKW(P0,6), pw0); \
    VRD(1); SBAR(); GAPA(C0=__builtin_amdgcn_mfma_f32_32x32x16_bf16(kf[2],qr[1],C0,0,0,0),   P0[10],P0[11],P0[12],P0[13], pw1[0]=PKW(P0,8), pw1[1]=PKW(P0,10), pw1); \
    VRD(5); SBAR(); GAPA(C1=__builtin_amdgcn_mfma_f32_32x32x16_bf16(kf[3],qr[1],C1,0,0,0),   P0[14],P0[15],P1[0],P1[1],   pw1[2]=PKW(P0,12),pw1[3]=PKW(P0,14), pw1); \
    VRD(2); SBAR(); GAPA(C0=__builtin_amdgcn_mfma_f32_32x32x16_bf16(kf[4],qr[2],C0,0,0,0),   P1[2],P1[3],P1[4],P1[5],     pw2[0]=PKW(P1,0), pw2[1]=PKW(P1,2), pw2); \
    VRD(6); SBAR(); GAPA(C1=__builtin_amdgcn_mfma_f32_32x32x16_bf16(kf[5],qr[2],C1,0,0,0),   P1[6],P1[7],P1[8],P1[9],     pw2[2]=PKW(P1,4), pw2[3]=PKW(P1,6), pw2); \
    VRD(3); SBAR(); GAPA(C0=__builtin_amdgcn_mfma_f32_32x32x16_bf16(kf[6],qr[3],C0,0,0,0),   P1[10],P1[11],P1[12],P1[13], pw3[0]=PKW(P1,8), pw3[1]=PKW(P1,10), pw3); \
    VRD(7); SBAR(); GAPA(C1=__builtin_amdgcn_mfma_f32_32x32x16_bf16(kf[7],qr[3],C1,0,0,0),   P1[14],P1[15],0.f,0.f,       pw3[2]=PKW(P1,12),pw3[3]=PKW(P1,14), pw3); \
    l_reg+=sacc; \
    if(GK){DMA_K((t)+3,sl_cur);} if(GV){DMA_V((t)+1,sl_next);} \
    CMASK(C0,C1,t); \
    { float a=MX3(C0[0],C0[1],C1[0]),b=MX3(C0[2],C0[3],C1[1]); a=MX3(a,C1[2],C1[3]); \
      _Pragma("unroll") for(int r=4;r<16;r+=4){a=MX3(a,C0[r],C0[r+1]);b=MX3(b,C0[r+2],C0[r+3]);a=MX3(a,C1[r],C1[r+1]);b=MX3(b,C1[r+2],C1[r+3]);} \
      float rm=__builtin_fmaxf(a,b); { auto rr=__builtin_amdgcn_permlane32_swap(__float_as_uint(rm),__float_as_uint(rm),false,false); rm=__builtin_fmaxf(__uint_as_float(rr[0]),__uint_as_float(rr[1])); } \
      resc=false; \
      if(__builtin_expect(__any(rm>(float)THRL),0)){ const float dl=__builtin_fmaxf(rm,0.f); mhat+=dl; \
        _Pragma("unroll") for(int r=0;r<16;++r){C0[r]-=dl;C1[r]-=dl;} \
        _Pragma("unroll") for(int r=0;r<16;++r)negm[r]=-mhat; asm volatile("":"+v"(negm)); \
        const float f=__builtin_amdgcn_exp2f(-dl); l_reg*=f; if(hi==0)wsf[r32]=f; resc=true; } } \
    SBAR(); \
    GAPB(o[0]=__builtin_amdgcn_mfma_f32_32x32x16_bf16(PAF(0),VFR(0),o[0],0,0,0), C0,0); \
    GAPB(o[1]=__builtin_amdgcn_mfma_f32_32x32x16_bf16(PAF(0),VFR(4),o[1],0,0,0), C0,4); \
    KRD(GL,0); GAPB(o[0]=__builtin_amdgcn_mfma_f32_32x32x16_bf16(PAF(1),VFR(1),o[0],0,0,0), C0,8); \
    KRD(GL,1); GAPB(o[1]=__builtin_amdgcn_mfma_f32_32x32x16_bf16(PAF(1),VFR(5),o[1],0,0,0), C0,12); \
    KRD(GL,2); GAPB(o[0]=__builtin_amdgcn_mfma_f32_32x32x16_bf16(PAF(2),VFR(2),o[0],0,0,0), C1,0); \
    KRD(GL,3); GAPB(o[1]=__builtin_amdgcn_mfma_f32_32x32x16_bf16(PAF(2),VFR(6),o[1],0,0,0), C1,4); \
    GAPB(o[0]=__builtin_amdgcn_mfma_f32_32x32x16_bf16(PAF(3),VFR(3),o[0],0,0,0), C1,8); \
    GAPB(o[1]=__builtin_amdgcn_mfma_f32_32x32x16_bf16(PAF(3),VFR(7),o[1],0,0,0), C1,12); \
    }while(0)
  int t=1;
  #undef CMASK
  #define CMASK(P0,P1,t) do{}while(0)
  for(;t+5<NT;t+=2){
    STEP(pB0,pB1,pA0,pA1,t,true,true,true);     WAIT_BAR(2); RESC(); ROT();
    STEP(pA0,pA1,pB0,pB1,t+1,true,true,true);   WAIT_BAR(2); RESC(); ROT();
  }
  #undef CMASK
  #define CMASK(P0,P1,t) do{int jb_=(t)-(NT-4); if(jb_>=0)cmask(P0,P1,jb_,qrel,hi);}while(0)
  #define ENDW(tt) do{ if((tt)+3<NT){WAIT_BAR(2);} else if((tt)+2<NT){WAIT_BAR(1);} else {WAIT_BAR(0);} }while(0)
  for(;t+1<NT;t+=2){
    STEP(pB0,pB1,pA0,pA1,t,(t+3<NT),(t+1<NT),(t+1<NT));       ENDW(t);   RESC(); ROT();
    STEP(pA0,pA1,pB0,pB1,t+1,(t+4<NT),(t+2<NT),(t+2<NT));     ENDW(t+1); RESC(); ROT();
  }
  STEP(pB0,pB1,pA0,pA1,NT-1,false,false,false); RESC();
  { float sacc=pB0[0]+pB0[1]; _Pragma("unroll") for(int r=2;r<16;++r)sacc+=pB0[r]; _Pragma("unroll") for(int r=0;r<16;++r)sacc+=pB1[r]; l_reg+=sacc;
    pw0=(u32x4){PKW(pB0,0),PKW(pB0,2),PKW(pB0,4),PKW(pB0,6)};pw1=(u32x4){PKW(pB0,8),PKW(pB0,10),PKW(pB0,12),PKW(pB0,14)};pw2=(u32x4){PKW(pB1,0),PKW(pB1,2),PKW(pB1,4),PKW(pB1,6)};pw3=(u32x4){PKW(pB1,8),PKW(pB1,10),PKW(pB1,12),PKW(pB1,14)};
    SBAR(); pv(o,vb0+sl_cur,PAF(0),PAF(1),PAF(2),PAF(3)); }
  #undef PKW
  #undef PAF
  #undef VFR
  #undef PIN
  #undef MX3
  #undef GAPA
  #undef GAPB
  #undef EX
  #undef VRD
  #undef KRD
  #undef STEP
  #undef ENDW
  {auto rr=__builtin_amdgcn_permlane32_swap(__float_as_uint(l_reg),__float_as_uint(l_reg),false,false);l_reg=__uint_as_float(rr[0])+__uint_as_float(rr[1]);}
  if(hi==0)wsf[32+r32]=l_reg;asm volatile("s_waitcnt lgkmcnt(0)":::"memory");
  float rli[16];
  #pragma unroll
  for(int r=0;r<16;++r)rli[r]=__builtin_amdgcn_rcpf(wsf[32+crow(r,hi)]);
  bf16*Ow=O+(rowbase+q0+wid*QBLK)*DMO;
  { bf16*stg=(bf16*)(shm+LDS_OST)+wid*2048;
    #pragma unroll
    for(int r=0;r<16;++r){const int orow=crow(r,hi);
      #pragma unroll
      for(int d0=0;d0<2;++d0)stg[orow*64+d0*32+r32]=__float2bfloat16(o[d0][r]*rli[r]);}
    asm volatile("s_waitcnt lgkmcnt(0)":::"memory");
    #pragma unroll
    for(int i=0;i<4;++i){const int row=i*8+(lane>>3),ch=lane&7; const u32x4 v=*(const u32x4*)(stg+row*64+ch*8); ATTN_STORE16(Ow+(long)row*DMO+ch*8,v);} }
  asm volatile("s_waitcnt lgkmcnt(0)\n\ts_barrier":::"memory");
  #undef DMA_K
  #undef DMA_V
  #undef CMASK
  #undef START
  #undef RESC
  #undef ROT
}
constexpr int ATTN_LDS_BYTES=LDS_BYTES;
struct AttnTensors { const bf16* PJ; bf16* O; };
struct AttnUnit { int bh; int qb; };
constexpr int QCOL=1536, KCOL=2048, VCOL=2560;
struct StaticOrder {
  int vcu;
  __device__ __forceinline__ explicit StaticOrder(int v):vcu(v){}
  __device__ __forceinline__ bool next(int i,AttnUnit&u)const{ if(i>=4||vcu>=256)return false; const int s=2*(vcu&1)+(i>>1); u.bh=vcu>>1; u.qb=(i&1)?7-s:s; return true; }
  __device__ __forceinline__ void a_ready(const AttnUnit&)const{}
  __device__ __forceinline__ void done(const AttnUnit&)const{}
};
template<class Sched,int THRL=8> __device__ __forceinline__ void attn_phase(char*lds,const AttnTensors&T,const Sched&S){
  AttnUnit u;
  for(int i=0;S.next(i,u);++i){ S.a_ready(u);
    const int b=u.bh>>4, vh=u.bh&15, hd=vh>>2, j=(vh>>1)&1, half=vh&1;
    attn_unit<THRL>(b,u.qb,T.PJ+QCOL+hd*128+j*64,T.PJ+KCOL+hd*128+j*64,T.PJ+VCOL+hd*128+half*64,T.O+vh*64,lds); S.done(u); }
}
#undef SBAR
#undef WAIT_BAR
}
#define GAS __attribute__((address_space(1)))
#define LAS __attribute__((address_space(3)))
typedef unsigned short bf16;
typedef unsigned v4u __attribute__((ext_vector_type(4)));
typedef float f32x4 __attribute__((ext_vector_type(4)));
typedef short bf16x8 __attribute__((ext_vector_type(8)));
typedef GAS unsigned gu32;
typedef GAS unsigned long long gu64;
#define RLX_AGENT __ATOMIC_RELAXED, __HIP_MEMORY_SCOPE_AGENT
#define LDS_WAIT() asm volatile("s_waitcnt lgkmcnt(0)" ::: "memory")
#define VM_WAIT() asm volatile("s_waitcnt vmcnt(0)" ::: "memory")
__device__ __forceinline__ unsigned long long rt() { return __builtin_amdgcn_s_memrealtime(); }
__device__ __forceinline__ unsigned f2bf(float f) { unsigned u = __builtin_bit_cast(unsigned, f); return (u + 0x7fffu + ((u >> 16) & 1u)) >> 16; }
__device__ __forceinline__ unsigned pk2(float lo, float hi) { return f2bf(lo) | (f2bf(hi) << 16); }

#define XB_TMO      128
#define XB_XCNT(j)  (256  + 64 * (j))
#define XB_XSUB(j)  (1280 + 64 * (j))
#define XB_XGEN(j)  (2304 + 64 * (j))
#define XB_TOP      3328
#define XB_TOPGEN   3392
#define XCD_BAR_WORDS 3456
#define XB_SPIN_CAP (1u << 18)

__device__ __forceinline__ unsigned xb_ld(unsigned* p)              { return __hip_atomic_load(p, __ATOMIC_RELAXED, __HIP_MEMORY_SCOPE_AGENT); }
__device__ __forceinline__ unsigned xb_add(unsigned* p, unsigned v) { return __hip_atomic_fetch_add(p, v, __ATOMIC_RELAXED, __HIP_MEMORY_SCOPE_AGENT); }
__device__ __forceinline__ unsigned xb_xcc_id() { return (unsigned)__builtin_amdgcn_s_getreg((3 << 11) | 20) & 0xFu; }
#define XB_SPIN(cond, bar) do { unsigned _sp = 0; while (cond) { __builtin_amdgcn_s_sleep(1); \
    if ((++_sp & 255u) == 0u) { if (xb_ld(&(bar)[XB_TMO])) break; if (_sp > XB_SPIN_CAP) { atomicAdd(&(bar)[XB_TMO], 1u); break; } } } } while (0)

struct XcdBarrier {
    unsigned* bar; unsigned x;
    volatile LAS unsigned* st;
};

__device__ __forceinline__ XcdBarrier xcd_barrier_post(unsigned* bar, volatile LAS unsigned* st) {
    XcdBarrier b; b.bar = bar; b.x = xb_xcc_id(); b.st = st;
    if (threadIdx.x == 0) (void)xb_add(&bar[XB_XCNT(b.x)], 1u);
    return b;
}
__device__ __forceinline__ void xcd_barrier_complete(unsigned* bar, unsigned x, unsigned& nloc, unsigned& nx) {
    const unsigned G = gridDim.x * gridDim.y * gridDim.z;
    unsigned sum, cnt, mine, sp = 0u;
    for (;;) {
        sum = 0u; cnt = 0u; mine = 0u;
#pragma unroll
        for (unsigned j = 0; j < 16; ++j) { const unsigned c = xb_ld(&bar[XB_XCNT(j)]); sum += c; cnt += (c > 0u) ? 1u : 0u; mine = (j == x) ? c : mine; }
        if (sum == G) break;
        __builtin_amdgcn_s_sleep(1);
        if ((++sp & 255u) == 0u) { if (xb_ld(&bar[XB_TMO])) break; if (sp > XB_SPIN_CAP) { atomicAdd(&bar[XB_TMO], 1u); break; } }
    }
    nloc = mine > 0u ? mine : 1u; nx = cnt > 0u ? cnt : 1u;
}

__device__ __forceinline__ void xcd_barrier(const XcdBarrier& b) {
    asm volatile("s_waitcnt vmcnt(0)" ::: "memory");
    __syncthreads();
    if (threadIdx.x == 0) {
        unsigned* bar = b.bar;
        __builtin_amdgcn_s_waitcnt(0);
        unsigned nloc = b.st[0], nx = b.st[1];
        if (nloc == 0u) { xcd_barrier_complete(bar, b.x, nloc, nx); b.st[0] = nloc; b.st[1] = nx; }
        const unsigned old = xb_add(&bar[XB_XSUB(b.x)], 1u);
        const unsigned gen = old / nloc;
        if (old + 1u == (gen + 1u) * nloc) {
            __builtin_amdgcn_fence(__ATOMIC_RELEASE, "agent");
            asm volatile("s_waitcnt vmcnt(0)" ::: "memory");
            const unsigned og = xb_add(&bar[XB_TOP], 1u);
            const unsigned tg = og / nx;
            if (og + 1u == (tg + 1u) * nx) xb_add(&bar[XB_TOPGEN], 1u);
            else XB_SPIN(xb_ld(&bar[XB_TOPGEN]) == tg, bar);
            __builtin_amdgcn_fence(__ATOMIC_ACQUIRE, "agent");
            xb_add(&bar[XB_XGEN(b.x)], 1u);
            asm volatile("s_waitcnt vmcnt(0)" ::: "memory");
        } else {
            XB_SPIN(xb_ld(&bar[XB_XGEN(b.x)]) == gen, bar);
            __builtin_amdgcn_fence(__ATOMIC_ACQUIRE, "agent");
            asm volatile("s_waitcnt vmcnt(0)" ::: "memory");
        }
    }
    __syncthreads();
}
constexpr int NWAVES = 8;
constexpr int Bsz = 8, SEQ = 2048, D = 1024, T = Bsz * SEQ;
constexpr int INP = 3080, NPJ = 3072, OFF_DT = 1536, OFF_Q2 = 1544;
constexpr int NE = 32, CAP = T, PLE = 256, FF2 = 2048;
constexpr int PADROWS = 4 * T + NE * 256;
constexpr float LAM_INIT = 0.2f, EPS = 1e-6f;
constexpr size_t MiB = 1u << 20;
constexpr size_t WS_CTL = 0, CTL_ZERO_BYTES = 1 * MiB;
constexpr size_t WS_ROWTOK = 1 * MiB, WS_ROWGATE = 3 * MiB, WS_SLOT = 5 * MiB, WS_DT = 6 * MiB, WS_WR = 7 * MiB;
constexpr size_t WS_WIN = 8 * MiB, WS_WOUT = 14 * MiB, WS_WG = 16 * MiB, WS_WP = 18 * MiB, WS_WUP = 20 * MiB, WS_WDN = 148 * MiB;
constexpr size_t WS_H = 212 * MiB, WS_PJ = 244 * MiB, WS_O = 340 * MiB, WS_YC = 372 * MiB, WS_X1 = 404 * MiB, WS_X2 = 468 * MiB, WS_PP = 532 * MiB, WS_P16 = 564 * MiB;
constexpr size_t WS_ACT = 572 * MiB, WS_YS = 716 * MiB, WS_TMP = 860 * MiB, WS_END = 960 * MiB;
static_assert(WS_ACT + (size_t)PADROWS * 1024 * 2 <= WS_YS && WS_YS + (size_t)PADROWS * 1024 * 2 <= WS_TMP, "d_ws map");
constexpr int CW_TMO = 0, CW_CODE = 1, CW_CNT = 64  , CW_BAR = 4096;
constexpr int RING_OFF = 0, RING_BYTES = 131072, LDSCTL_OFF = RING_BYTES, MISC_OFF = LDSCTL_OFF + 320, MTS_OFF = LDSCTL_OFF + 512, GTAB_OFF = LDSCTL_OFF + 1024, GTAB_UNITS = 10;
constexpr int LDS_BYTES = 147456;
static_assert(GTAB_OFF + GTAB_UNITS * 1024 <= LDS_BYTES, "LDS map");
__device__ __forceinline__ float wave_sum(float v) {
#pragma unroll
    for (int o = 1; o < 64; o <<= 1) v += __shfl_xor(v, o);
    return v;
}
__device__ __forceinline__ float bf2f(bf16 u) { return __uint_as_float((unsigned)u << 16); }
typedef unsigned u32x2 __attribute__((ext_vector_type(2)));

struct Args {
    const float *x, *p, *g_mix, *w_in, *conv_w, *conv_b, *dt_bias, *a_log, *d_skip, *ssd_norm_w, *lq1, *lk1, *lq2, *lk2, *subln_w, *w_out, *g_ffn, *w_router, *b_router,
                *w_up, *b_up, *w_down, *b_down, *g_ple, *w_ple_gate, *w_ple_proj, *g_final;
    float* out; unsigned char* ws; int ph_lo, ph_hi, use_bar, pad;
};

__device__ __forceinline__ void tr_item(const float* W, int ldw, int K, bf16* WT, int n0, int k0, int nrow0, LAS unsigned* scr, int lane) {
    const int n4 = (lane & 15) * 4, kr = lane >> 4;
    const float* src = W + (size_t)(k0 + kr * 2) * ldw + n0 + n4;
#pragma unroll
    for (int it = 0; it < 8; ++it) {
        const f32x4 a = *(const GAS f32x4*)(src + (size_t)(it * 8) * ldw);
        const f32x4 b = *(const GAS f32x4*)(src + (size_t)(it * 8 + 1) * ldw);
        const int kp = it * 4 + kr;
        scr[(n4 + 0) * 33 + kp] = pk2(a.x, b.x); scr[(n4 + 1) * 33 + kp] = pk2(a.y, b.y); scr[(n4 + 2) * 33 + kp] = pk2(a.z, b.z); scr[(n4 + 3) * 33 + kp] = pk2(a.w, b.w);
    }
    LDS_WAIT(); asm volatile("" ::: "memory");
    const int c = lane & 7;
#pragma unroll
    for (int it = 0; it < 8; ++it) { const int n = (lane >> 3) + 8 * it; const LAS unsigned* s = scr + n * 33 + c * 4;
        v4u o; o.x = s[0]; o.y = s[1]; o.z = s[2]; o.w = s[3];
        *(GAS v4u*)(WT + (size_t)(nrow0 + n) * K + k0 + 8 * c) = o; }
    LDS_WAIT(); asm volatile("" ::: "memory");
}
__device__ __forceinline__ void p0_prologue(const Args& a, LAS unsigned char* lds, int vcu, int G, int wave, int lane, int tid) {
    unsigned char* ws = a.ws;
    bf16* Win_t = (bf16*)(ws + WS_WIN); bf16* Wout_t = (bf16*)(ws + WS_WOUT); bf16* Wg_t = (bf16*)(ws + WS_WG); bf16* Wp_t = (bf16*)(ws + WS_WP); bf16* Wup_t = (bf16*)(ws + WS_WUP); bf16* Wdn_t = (bf16*)(ws + WS_WDN);
    LAS unsigned* scr = (LAS unsigned*)(lds + RING_OFF + wave * 8704);
    const int gw = vcu * NWAVES + wave, NGW = G * NWAVES;
    constexpr int I_IN = 16 * 24, I_SQ = 16 * 16, I_PP = 4 * 16, I_UP = 32 * 16 * 32, I_DN = 32 * 16 * 16;
    constexpr int NITEMS = 2 * I_IN + 2 * I_SQ + I_PP + I_UP + I_DN;
    for (int it = gw; it < NITEMS; it += NGW) {
        int r = it;
        if (r < I_UP) { const int e = r >> 9, q = r & 511; tr_item(a.w_up + (size_t)e * D * FF2, FF2, D, Wup_t + (size_t)e * FF2 * D, (q & 31) * 64, (q >> 5) * 64, (q & 31) * 64, scr, lane); continue; } r -= I_UP;
        if (r < I_DN) { const int e = r >> 8, q = r & 255; tr_item(a.w_down + (size_t)e * D * D, D, D, Wdn_t + (size_t)e * D * D, (q & 15) * 64, (q >> 4) * 64, (q & 15) * 64, scr, lane); continue; } r -= I_DN;
        if (r < I_IN) { tr_item(a.w_in, INP, D, Win_t, (r % 24) * 64, (r / 24) * 64, (r % 24) * 64, scr, lane); continue; } r -= I_IN;
        if (r < I_IN) { tr_item(a.w_in + OFF_Q2, INP, D, Win_t, (r % 24) * 64, (r / 24) * 64, 1536 + (r % 24) * 64, scr, lane); continue; } r -= I_IN;
        if (r < I_SQ) { tr_item(a.w_out, D, D, Wout_t, (r & 15) * 64, (r >> 4) * 64, (r & 15) * 64, scr, lane); continue; } r -= I_SQ;
        if (r < I_SQ) { tr_item(a.w_ple_gate, D, D, Wg_t, (r & 15) * 64, (r >> 4) * 64, (r & 15) * 64, scr, lane); continue; } r -= I_SQ;
        tr_item(a.w_ple_proj, D, PLE, Wp_t, (r & 15) * 64, (r >> 4) * 64, (r & 15) * 64, scr, lane);
    }
    { bf16* Wr_t = (bf16*)(ws + WS_WR); const int gt = vcu * (NWAVES * 64) + tid, NT_ = G * NWAVES * 64;
      for (int i = gt; i < NE * D; i += NT_) { const int n = i >> 10, k = i & 1023; Wr_t[i] = (bf16)f2bf(a.w_router[k * NE + n]); } }
    bf16* H = (bf16*)(ws + WS_H); float* DT = (float*)(ws + WS_DT);
    for (int m = gw; m < T; m += NGW) {
        const GAS f32x4* xr = (const GAS f32x4*)(a.x + (size_t)m * D) + lane;
        f32x4 v[4]; float s = 0.f;
#pragma unroll
        for (int j = 0; j < 4; ++j) { v[j] = xr[64 * j]; s += (v[j].x * v[j].x + v[j].y * v[j].y) + (v[j].z * v[j].z + v[j].w * v[j].w); }
        const float rs = 1.f / sqrtf(wave_sum(s) * (1.f / D) + EPS);
        GAS u32x2* o8 = (GAS u32x2*)(H + (size_t)m * D) + lane;
        float d[8];
#pragma unroll
        for (int h = 0; h < 8; ++h) d[h] = 0.f;
#pragma unroll
        for (int j = 0; j < 4; ++j) { const f32x4 gg = ((const GAS f32x4*)a.g_mix)[lane + 64 * j]; v[j] = v[j] * rs * gg;
            u32x2 w; w.x = pk2(v[j].x, v[j].y); w.y = pk2(v[j].z, v[j].w); o8[64 * j] = w;
#pragma unroll
            for (int i = 0; i < 4; ++i) { const float* wr = a.w_in + (size_t)(4 * lane + 256 * j + i) * INP + OFF_DT; const f32x4 w0 = *(const GAS f32x4*)wr, w1 = *(const GAS f32x4*)(wr + 4); const float hv = v[j][i];
                d[0] += hv * w0.x; d[1] += hv * w0.y; d[2] += hv * w0.z; d[3] += hv * w0.w; d[4] += hv * w1.x; d[5] += hv * w1.y; d[6] += hv * w1.z; d[7] += hv * w1.w; } }
#pragma unroll
        for (int h = 0; h < 8; ++h) d[h] = wave_sum(d[h]);
        if (lane < 8) { float mine = d[0];
#pragma unroll
            for (int h = 1; h < 8; ++h) mine = (lane == h) ? d[h] : mine;
            const float raw = mine + a.dt_bias[lane]; DT[(size_t)m * 8 + lane] = raw > 20.f ? raw : log1pf(expf(raw)); }
    }
    { bf16* P16 = (bf16*)(ws + WS_P16); const int gt = vcu * (NWAVES * 64) + tid, NT_ = G * NWAVES * 64;
      for (int i = gt; i < T * PLE / 8; i += NT_) { const f32x4 v0 = ((const GAS f32x4*)a.p)[2 * i], v1 = ((const GAS f32x4*)a.p)[2 * i + 1];
          v4u o; o.x = pk2(v0.x, v0.y); o.y = pk2(v0.z, v0.w); o.z = pk2(v1.x, v1.y); o.w = pk2(v1.z, v1.w); ((GAS v4u*)P16)[i] = o; } }
}

__device__ __forceinline__ void p5_router(const Args& a, LAS unsigned char* lds, int vcu, int G, int wave, int lane, int tid) {
    typedef float f32x16 __attribute__((ext_vector_type(16)));
    unsigned char* ws = a.ws;
    const float* X1 = (const float*)(ws + WS_X1); bf16* H = (bf16*)(ws + WS_H); const bf16* Wr_t = (const bf16*)(ws + WS_WR);
    int* cnt = (int*)(ws + WS_CTL) + CW_CNT; int* row_tok = (int*)(ws + WS_ROWTOK); float* row_gate = (float*)(ws + WS_ROWGATE); int* slot = (int*)(ws + WS_SLOT);
    for (int tile = vcu; tile < T / 64; tile += G) {
        for (int tt = 0; tt < 8; ++tt) {
            const int lr = wave * 8 + tt, m = tile * 64 + lr;
            const GAS f32x4* xr = (const GAS f32x4*)(X1 + (size_t)m * D) + lane;
            f32x4 v[4]; float s = 0.f;
#pragma unroll
            for (int j = 0; j < 4; ++j) { v[j] = xr[64 * j]; s += (v[j].x * v[j].x + v[j].y * v[j].y) + (v[j].z * v[j].z + v[j].w * v[j].w); }
            const float rs = 1.f / sqrtf(wave_sum(s) * (1.f / D) + EPS);
            GAS u32x2* o8 = (GAS u32x2*)(H + (size_t)m * D) + lane;
#pragma unroll
            for (int j = 0; j < 4; ++j) { const f32x4 gg = ((const GAS f32x4*)a.g_ffn)[lane + 64 * j]; const f32x4 hv = v[j] * rs * gg;
                u32x2 w; w.x = pk2(hv.x, hv.y); w.y = pk2(hv.z, hv.w); o8[64 * j] = w;
                const int chunk = (lane >> 1) + 32 * j;
                *(LAS u32x2*)(lds + lr * 2048 + ((chunk ^ (lr & 7)) << 4) + (lane & 1) * 8) = w; }
        }
        __syncthreads();
        const int r32 = lane & 31, hi = lane >> 5, mh = wave & 1, kq = wave >> 1;
        f32x16 acc = {};
#pragma unroll 4
        for (int st = 0; st < 16; ++st) { const int row = 32 * mh + r32, chunk = 2 * (kq * 16 + st) + hi;
            const bf16x8 af = *(const LAS bf16x8*)(lds + row * 2048 + ((chunk ^ (row & 7)) << 4));
            const bf16x8 bfr = *(const GAS bf16x8*)(Wr_t + (size_t)r32 * D + chunk * 8);
            acc = __builtin_amdgcn_mfma_f32_32x32x16_bf16(af, bfr, acc, 0, 0, 0); }
        __syncthreads();
        LAS float* part = (LAS float*)lds;
#pragma unroll
        for (int r = 0; r < 16; ++r) { const int row = (r & 3) + 8 * (r >> 2) + 4 * hi; part[(wave * 32 + row) * 33 + r32] = acc[r]; }
        __syncthreads();
        for (int rd = 0; rd < 4; ++rd) {
            const int lt = rd * 16 + (tid >> 5), e = tid & 31, mh2 = lt >> 5, lrow = lt & 31;
            float v = a.b_router[e];
#pragma unroll
            for (int q = 0; q < 4; ++q) v += part[((q * 2 + mh2) * 32 + lrow) * 33 + e];
            float tv[4]; int ti[4];
#pragma unroll
            for (int r = 0; r < 4; ++r) { float bv = v; int bi = e;
#pragma unroll
                for (int o = 16; o > 0; o >>= 1) { const float ov = __shfl_xor(bv, o); const int oi = __shfl_xor(bi, o); if (ov > bv || (ov == bv && oi < bi)) { bv = ov; bi = oi; } }
                tv[r] = bv; ti[r] = bi; if (e == bi) v = -INFINITY; }
            if (e == 0) { const int m = tile * 64 + lt; float ex[4], sm = 0.f;
#pragma unroll
                for (int r = 0; r < 4; ++r) { ex[r] = expf(tv[r] - tv[0]); sm += ex[r]; }
#pragma unroll
                for (int r = 0; r < 4; ++r) { const int pos = atomicAdd(&cnt[ti[r]], 1); row_tok[ti[r] * CAP + pos] = m; row_gate[ti[r] * CAP + pos] = ex[r] / sm; slot[(m * 4 + r) * 2] = ti[r]; slot[(m * 4 + r) * 2 + 1] = pos; } }
        }
        __syncthreads();
    }
}

__device__ __forceinline__ void moe_setup(const Args& a, LAS unsigned char* lds, int tid) {
    LAS int* mts = (LAS int*)(lds + MTS_OFF); const int* cnt = (const int*)(a.ws + WS_CTL) + CW_CNT;
    if (tid == 0) { int s = 0; for (int e = 0; e < NE; ++e) { mts[e] = s; s += (cnt[e] + 255) >> 8; } mts[NE] = s; }
    __syncthreads();
}
__device__ __forceinline__ void moe_gtab(const Args& a, LAS unsigned char* lds, int tid, int u0, int u1, int NN) {
    LAS int* mts = (LAS int*)(lds + MTS_OFF); LAS unsigned* gtab = (LAS unsigned*)(lds + GTAB_OFF);
    const int* cnt = (const int*)(a.ws + WS_CTL) + CW_CNT; const int* row_tok = (const int*)(a.ws + WS_ROWTOK);
    for (int i = 0; i < u1 - u0 && i < GTAB_UNITS; ++i) {
        const int mt = (u0 + i) / NN; int e = 0;
        for (int k = 1; k < 32; ++k) e += (mts[k] <= mt) ? 1 : 0;
        const int r0 = (mt - mts[e]) * 256, c = cnt[e];
        if (tid < 256) { const int r = r0 + tid; const int tok = (r < c) ? row_tok[e * CAP + r] : 0; gtab[i * 256 + tid] = (unsigned)tok * (unsigned)(D * 2); }
    }
    __syncthreads();
}

__device__ __forceinline__ void p8_combine(const Args& a, LAS unsigned char* lds, int vcu, int G, int wave, int lane) {
    unsigned char* ws = a.ws; LAS int* mts = (LAS int*)(lds + MTS_OFF);
    const float* X1 = (const float*)(ws + WS_X1); float* X2 = (float*)(ws + WS_X2); bf16* H = (bf16*)(ws + WS_H); const bf16* YS = (const bf16*)(ws + WS_YS); const int* slot = (const int*)(ws + WS_SLOT);
    const int gw = vcu * NWAVES + wave, NGW = G * NWAVES;
    for (int m = gw; m < T; m += NGW) {
        const GAS f32x4* xr = (const GAS f32x4*)(X1 + (size_t)m * D) + lane;
        f32x4 v[4];
#pragma unroll
        for (int j = 0; j < 4; ++j) v[j] = xr[64 * j];
#pragma unroll
        for (int r = 0; r < 4; ++r) { const int e = slot[(m * 4 + r) * 2], pos = slot[(m * 4 + r) * 2 + 1]; const size_t prow = (size_t)mts[e] * 256 + pos;
            const GAS u32x2* yr = (const GAS u32x2*)(YS + prow * D) + lane;
#pragma unroll
            for (int j = 0; j < 4; ++j) { const u32x2 w = yr[64 * j]; v[j].x += __uint_as_float(w.x << 16); v[j].y += __uint_as_float(w.x & 0xffff0000u); v[j].z += __uint_as_float(w.y << 16); v[j].w += __uint_as_float(w.y & 0xffff0000u); } }
        float s = 0.f;
        GAS f32x4* xo = (GAS f32x4*)(X2 + (size_t)m * D) + lane;
#pragma unroll
        for (int j = 0; j < 4; ++j) { xo[64 * j] = v[j]; s += (v[j].x * v[j].x + v[j].y * v[j].y) + (v[j].z * v[j].z + v[j].w * v[j].w); }
        const float rs = 1.f / sqrtf(wave_sum(s) * (1.f / D) + EPS);
        GAS u32x2* o8 = (GAS u32x2*)(H + (size_t)m * D) + lane;
#pragma unroll
        for (int j = 0; j < 4; ++j) { const f32x4 gg = ((const GAS f32x4*)a.g_ple)[lane + 64 * j]; const f32x4 hv = v[j] * rs * gg; u32x2 w; w.x = pk2(hv.x, hv.y); w.y = pk2(hv.z, hv.w); o8[64 * j] = w; }
    }
}
__device__ __forceinline__ void p10_final(const Args& a, int vcu, int G, int wave, int lane) {
    const float* X3 = (const float*)(a.ws + WS_X2);
    const int gw = vcu * NWAVES + wave, NGW = G * NWAVES;
    for (int m = gw; m < T; m += NGW) {
        const GAS f32x4* xr = (const GAS f32x4*)(X3 + (size_t)m * D) + lane;
        f32x4 v[4]; float s = 0.f;
#pragma unroll
        for (int j = 0; j < 4; ++j) { v[j] = xr[64 * j]; s += (v[j].x * v[j].x + v[j].y * v[j].y) + (v[j].z * v[j].z + v[j].w * v[j].w); }
        const float rs = 1.f / sqrtf(wave_sum(s) * (1.f / D) + EPS);
        GAS f32x4* o = (GAS f32x4*)(a.out + (size_t)m * D) + lane;
#pragma unroll
        for (int j = 0; j < 4; ++j) { const f32x4 gg = ((const GAS f32x4*)a.g_final)[lane + 64 * j]; o[64 * j] = v[j] * rs * gg; }
    }
}

constexpr int NPHASE = 11;
__global__ void __launch_bounds__(NWAVES * 64, 2) mk_fwd(Args a) {
    extern __shared__ __attribute__((aligned(16))) unsigned char lds_raw[];
    LAS unsigned char* lds = (LAS unsigned char*)lds_raw;
    const int tid = threadIdx.x, lane = tid & 63, wave = __builtin_amdgcn_readfirstlane(tid >> 6);
    const int G = gridDim.x; const int bx = blockIdx.x; const int vcu = (G % 8 == 0) ? (bx % 8) * (G / 8) + bx / 8 : bx;
    unsigned char* ws = a.ws; gu32* ctl = (gu32*)(ws + WS_CTL);
    for (int u = tid; u < (LDS_BYTES - LDSCTL_OFF) / 4; u += NWAVES * 64) ((LAS unsigned*)(lds + LDSCTL_OFF))[u] = 0u;
    __syncthreads();
    volatile LAS unsigned* MISC = (volatile LAS unsigned*)(lds + MISC_OFF);
    XcdBarrier bar; bar.bar = (unsigned*)(ctl + CW_BAR); bar.x = 0; bar.st = nullptr;
    if (a.use_bar) bar = xcd_barrier_post((unsigned*)(ctl + CW_BAR), MISC + 8);
    const int lo = a.ph_lo, hi = a.ph_hi;
#define IN(k) (lo <= (k) && (k) < hi)
#define SEAM(k) do { if (IN(k) && IN((k) + 1)) xcd_barrier(bar); } while (0)
    const LAS unsigned* gtab = (const LAS unsigned*)(lds + GTAB_OFF);
    bf16* H = (bf16*)(ws + WS_H); bf16* PJ = (bf16*)(ws + WS_PJ);

    if (IN(0)) { p0_prologue(a, lds, vcu, G, wave, lane, tid); SEAM(0); }
    if (IN(1)) {
        { pg8::DenseOrder S; S.init(H, ws + WS_WIN, T, NPJ, D, G, bx); pg8::EpiBf16S E{PJ, NPJ, 6, 8, attn_body::C2};
          pg8::gemm_phase<pg8::EpiBf16S, pg8::DenseOrder, false, true, true>(lds + RING_OFF, D, S, E, gtab); }
        { pg8::DenseOrder S; S.init(ws + WS_P16, ws + WS_WP, T, D, PLE, G, bx); pg8::EpiBf16S E{(bf16*)(ws + WS_PP), D, 0, 0, 1.f};
          pg8::gemm_phase<pg8::EpiBf16S, pg8::DenseOrder, false, true, true>(lds + RING_OFF, PLE, S, E, gtab); }
        SEAM(1);
    }
    if (IN(2)) {
        const attn_body::AttnTensors AT{(const attn_body::bf16*)PJ, (attn_body::bf16*)(ws + WS_O)};
        const attn_body::StaticOrder S(vcu);
        attn_body::attn_phase<attn_body::StaticOrder>((char*)lds_raw + RING_OFF, AT, S);
        SEAM(2);
    }
    if (IN(3)) { SEAM(3); }
    if (IN(4)) {
        pg8::DenseOrder S; S.init(ws + WS_YC, ws + WS_WOUT, T, D, D, G, bx); pg8::EpiResF32 E{a.x, (float*)(ws + WS_X1), D};
        pg8::gemm_phase<pg8::EpiResF32, pg8::DenseOrder, false, false, true>(lds + RING_OFF, D, S, E, gtab);
        SEAM(4);
    }
    if (IN(5)) { p5_router(a, lds, vcu, G, wave, lane, tid); SEAM(5); }
    if (IN(6)) {
        moe_setup(a, lds, tid);
        const LAS int* mts = (const LAS int*)(lds + MTS_OFF); const int NN = FF2 / 256, U = mts[NE] * NN;
        const int u0 = (int)((long)vcu * U / G), u1 = (int)((long)(vcu + 1) * U / G);
        moe_gtab(a, lds, tid, u0, u1, NN);
        pg8::MoeOrder S{mts, (const char*)H, (const char*)(ws + WS_WUP), (size_t)256 * D * 2, (size_t)FF2 * D * 2, NN, u0, u1, 1};
        pg8::EpiMoeUp E{(bf16*)(ws + WS_ACT), a.b_up};
        pg8::gemm_phase<pg8::EpiMoeUp, pg8::MoeOrder, true, true, true>(lds + RING_OFF, D, S, E, gtab);
        SEAM(6);
    }
    if (IN(7)) {
        moe_setup(a, lds, tid);
        const LAS int* mts = (const LAS int*)(lds + MTS_OFF); const int NN = D / 256, U = mts[NE] * NN;
        const int u0 = (int)((long)vcu * U / G), u1 = (int)((long)(vcu + 1) * U / G);
        pg8::MoeOrder S{mts, (const char*)(ws + WS_ACT), (const char*)(ws + WS_WDN), (size_t)256 * D * 2, (size_t)D * D * 2, NN, u0, u1, 0};
        pg8::EpiMoeDown E{(bf16*)(ws + WS_YS), a.b_down, (const float*)(ws + WS_ROWGATE)};
        pg8::gemm_phase<pg8::EpiMoeDown, pg8::MoeOrder, false, true, true>(lds + RING_OFF, D, S, E, gtab);
        SEAM(7);
    }
    if (IN(8)) { moe_setup(a, lds, tid); p8_combine(a, lds, vcu, G, wave, lane); SEAM(8); }
    if (IN(9)) {
        pg8::DenseOrder S; S.init(H, ws + WS_WG, T, D, D, G, bx); pg8::EpiPle E{(const float*)(ws + WS_X2), (const bf16*)(ws + WS_PP), (float*)(ws + WS_X2), D};
        pg8::gemm_phase<pg8::EpiPle, pg8::DenseOrder, false, false, true>(lds + RING_OFF, D, S, E, gtab);
        SEAM(9);
    }
    if (IN(10)) { p10_final(a, vcu, G, wave, lane); }
#undef IN
#undef SEAM
}

namespace nv {
__device__ __forceinline__ float wsum(float v) {
#pragma unroll
    for (int o = 32; o > 0; o >>= 1) v += __shfl_xor(v, o);
    return v;
}
__device__ __forceinline__ float siluf(float v) { return v / (1.f + expf(-v)); }
__global__ void __launch_bounds__(256) conv_k(const bf16* __restrict__ PJ, const float* __restrict__ cw, const float* __restrict__ cb, float* __restrict__ xbc) {
    const int idx = blockIdx.x * 256 + threadIdx.x; const int t = idx >> 10, c = idx & 1023; const int s = t & (SEQ - 1);
    float acc = cb[c];
#pragma unroll
    for (int j = 0; j < 4; ++j) { const int ss = s - 3 + j; if (ss >= 0) acc += cw[j * 1024 + c] * bf2f(PJ[(size_t)(t - 3 + j) * NPJ + 512 + c]); }
    xbc[idx] = siluf(acc);
}
__global__ void __launch_bounds__(256) ssd_k(const float* __restrict__ DT, const float* __restrict__ xbc, const float* __restrict__ a_log, const float* __restrict__ d_skip, float* __restrict__ yraw) {
    const int b = blockIdx.x >> 3, h = blockIdx.x & 7, g = h >> 2; const int tid = threadIdx.x, p = tid >> 2, nq = tid & 3;
    const float av = -expf(a_log[h]), dsk = d_skip[h];
    float st[32];
#pragma unroll
    for (int i = 0; i < 32; ++i) st[i] = 0.f;
    for (int s = 0; s < SEQ; ++s) {
        const size_t t = (size_t)b * SEQ + s;
        const float dtv = DT[t * 8 + h];
        const float dec = expf(av * dtv);
        const float xv = xbc[t * 1024 + h * 64 + p], xd = xv * dtv;
        const float4* Bv = (const float4*)(xbc + t * 1024 + 512 + g * 128 + nq * 32);
        const float4* Cv = (const float4*)(xbc + t * 1024 + 768 + g * 128 + nq * 32);
        float y = 0.f;
#pragma unroll
        for (int i = 0; i < 8; ++i) {
            const float4 bb = Bv[i], cc = Cv[i];
            st[4 * i + 0] = st[4 * i + 0] * dec + xd * bb.x; y += cc.x * st[4 * i + 0];
            st[4 * i + 1] = st[4 * i + 1] * dec + xd * bb.y; y += cc.y * st[4 * i + 1];
            st[4 * i + 2] = st[4 * i + 2] * dec + xd * bb.z; y += cc.z * st[4 * i + 2];
            st[4 * i + 3] = st[4 * i + 3] * dec + xd * bb.w; y += cc.w * st[4 * i + 3];
        }
        y += __shfl_xor(y, 1); y += __shfl_xor(y, 2);
        if (nq == 0) yraw[t * 512 + h * 64 + p] = y + dsk * xv;
    }
}
__global__ void __launch_bounds__(256) ssdnorm_k(const float* __restrict__ yraw, const bf16* __restrict__ PJ, const float* __restrict__ nw, bf16* __restrict__ YC) {
    const int w = blockIdx.x * 4 + (threadIdx.x >> 6), lane = threadIdx.x & 63; const int t = w >> 1, g = w & 1;
    float v[4]; float s = 0.f;
#pragma unroll
    for (int j = 0; j < 4; ++j) { const int c = g * 256 + lane + 64 * j; const float z = bf2f(PJ[(size_t)t * NPJ + c]); v[j] = yraw[(size_t)t * 512 + c] * siluf(z); s += v[j] * v[j]; }
    s = wsum(s);
    const float r = rsqrtf(s * (1.f / 256.f) + 1e-5f);
#pragma unroll
    for (int j = 0; j < 4; ++j) { const int c = g * 256 + lane + 64 * j; YC[(size_t)t * 1024 + c] = (bf16)f2bf(v[j] * r * nw[c]); }
}
__global__ void __launch_bounds__(256) attnpost_k(const bf16* __restrict__ O, const float* __restrict__ lq1, const float* __restrict__ lk1, const float* __restrict__ lq2, const float* __restrict__ lk2,
                                                 const float* __restrict__ subw, bf16* __restrict__ YC) {
    const int w = blockIdx.x * 4 + (threadIdx.x >> 6), lane = threadIdx.x & 63; const int t = w >> 2, h = w & 3;
    const float lam = expf(wsum(lq1[lane] * lk1[lane])) - expf(wsum(lq2[lane] * lk2[lane])) + LAM_INIT;
    const bf16* o = O + (size_t)t * 1024 + h * 256;
    const float a0 = bf2f(o[lane]) - lam * bf2f(o[128 + lane]), a1 = bf2f(o[64 + lane]) - lam * bf2f(o[192 + lane]);
    const float r = rsqrtf(wsum(a0 * a0 + a1 * a1) * (1.f / 128.f) + 1e-5f) * (1.f - LAM_INIT);
    YC[(size_t)t * 1024 + 512 + h * 128 + lane] = (bf16)f2bf(a0 * r * subw[lane]);
    YC[(size_t)t * 1024 + 512 + h * 128 + 64 + lane] = (bf16)f2bf(a1 * r * subw[64 + lane]);
}
}

extern "C" void kernel_launch(void* const* d_in, const int* in_sizes, int n_in, void* d_out, int out_size, void* d_ws, size_t ws_size, hipStream_t stream) {
    static int grid = 0;
    if (grid == 0) {
        int dev = 0, cus = 0, per_cu = 0;
        if (n_in != 27 || out_size != T * D || ws_size < WS_END) { fprintf(stderr, "kernel_launch: unexpected shapes (n_in %d out %d ws %zu)\n", n_in, out_size, ws_size); grid = -1; return; }
        if (hipGetDevice(&dev) != hipSuccess || hipDeviceGetAttribute(&cus, hipDeviceAttributeMultiprocessorCount, dev) != hipSuccess) { grid = -1; return; }
        if (hipFuncSetAttribute((const void*)mk_fwd, hipFuncAttributeMaxDynamicSharedMemorySize, LDS_BYTES) != hipSuccess) { fprintf(stderr, "kernel_launch: hipFuncSetAttribute failed\n"); grid = -1; return; }
        if (hipOccupancyMaxActiveBlocksPerMultiprocessor(&per_cu, (const void*)mk_fwd, NWAVES * 64, LDS_BYTES) != hipSuccess || per_cu < 1) { fprintf(stderr, "kernel_launch: occupancy query says %d blocks per CU\n", per_cu); (void)hipGetLastError(); grid = -1; return; }
        grid = cus;
    }
    if (grid < 0) return;
    if (hipMemsetAsync((char*)d_ws + WS_CTL, 0, CTL_ZERO_BYTES, stream) != hipSuccess) return;
    Args a{};
    const float** ap = (const float**)&a;
    for (int i = 0; i < 27; ++i) ap[i] = (const float*)d_in[i];
    a.out = (float*)d_out; a.ws = (unsigned char*)d_ws; a.use_bar = 0; a.pad = 0;
    unsigned char* ws = (unsigned char*)d_ws;
    auto run = [&](int lo, int hi) { a.ph_lo = lo; a.ph_hi = hi; hipLaunchKernelGGL(mk_fwd, dim3(grid), dim3(NWAVES * 64), LDS_BYTES, stream, a); };
    run(0, 1); run(1, 2); run(2, 3);
    {
        const bf16* PJ = (const bf16*)(ws + WS_PJ); float* xbc = (float*)(ws + WS_TMP); float* yraw = (float*)(ws + WS_TMP + 64 * MiB); bf16* YC = (bf16*)(ws + WS_YC);
        nv::conv_k<<<T * 1024 / 256, 256, 0, stream>>>(PJ, a.conv_w, a.conv_b, xbc);
        nv::ssd_k<<<64, 256, 0, stream>>>((const float*)(ws + WS_DT), xbc, a.a_log, a.d_skip, yraw);
        nv::ssdnorm_k<<<T * 2 / 4, 256, 0, stream>>>(yraw, PJ, a.ssd_norm_w, YC);
        nv::attnpost_k<<<T * 4 / 4, 256, 0, stream>>>((const bf16*)(ws + WS_O), a.lq1, a.lk1, a.lq2, a.lk2, a.subln_w, YC);
    }
    for (int ph = 4; ph < NPHASE; ++ph) run(ph, ph + 1);
}
```

```cpp
#include <hip/hip_runtime.h>
#include <cstdio>
#include <cstdint>
namespace pg8 {
#define PG8_LAS __attribute__((address_space(3)))
typedef unsigned short bf16_t;
typedef short bf16x8 __attribute__((ext_vector_type(8)));
typedef float f32x4 __attribute__((ext_vector_type(4)));
typedef unsigned u32x4 __attribute__((ext_vector_type(4)));
constexpr int BM = 256, BK = 64, HALF = 128, HTB = HALF * BK * 2  , STAGE_BYTES = 8 * HTB, NXCD = 8, WGM = 8;

__host__ __device__ __forceinline__ int lds_byte(int r, int c) { const int st = (r >> 4) * 2 + (c >> 5), rr = r & 15, cc = c & 31, ob = rr * 64 + cc * 2; return st * 1024 + (ob ^ (((ob >> 9) & 1) << 5)); }
__host__ __device__ __forceinline__ void stage_rc(int b, int& R, int& C) { const int st = b / 1024, sb = b % 1024, swz = sb ^ (((sb >> 9) & 1) << 5); R = (st >> 1) * 16 + swz / 64; C = (st & 1) * 32 + (swz % 64) / 2; }
__host__ __device__ __forceinline__ int perm32(int rho) { const int n = rho >> 4, i = rho & 15; return 8 * (i >> 2) + 4 * n + (i & 3); }


struct Unit { int pm, pn, e, r0; };
__device__ __forceinline__ unsigned cvt_pk_bf16(float lo, float hi) { unsigned r; asm volatile("v_cvt_pk_bf16_f32 %0, %1, %2" : "=v"(r) : "v"(lo), "v"(hi)); return r; }

struct DenseOrder {
    const char* A; const char* Bt; size_t tstep; int nM, nN, nwg, G, c;
    __device__ __forceinline__ void init(const void* A_, const void* Bt_, int M, int N, int K, int G_, int c_) { A = (const char*)A_; Bt = (const char*)Bt_; tstep = (size_t)BM * K * 2; nM = M / BM; nN = N / BM; nwg = nM * nN; G = G_; c = c_; }
    __device__ __forceinline__ bool next(int i, Unit& u) const {
        const long L = (long)i * G + c; if (L >= nwg) return false;
        int wgid = (int)L; { const int q = nwg / NXCD, r = nwg % NXCD, xcd = wgid % NXCD, off = wgid / NXCD; wgid = (xcd < r ? xcd * (q + 1) : r * (q + 1) + (xcd - r) * q) + off; }
        const int nig = WGM * nN, gid = wgid / nig, fm = gid * WGM, gsz = (nM - fm) < WGM ? (nM - fm) : WGM;
        u.pm = fm + ((wgid % nig) % gsz); u.pn = (wgid % nig) / gsz; u.e = 0; u.r0 = 0; return true;
    }
    __device__ __forceinline__ const char* a_ptr(const Unit& u) const { return A + (size_t)u.pm * tstep; }
    __device__ __forceinline__ const char* b_ptr(const Unit& u) const { return Bt + (size_t)u.pn * tstep; }
    __device__ __forceinline__ void a_ready(const Unit&) const {}
    __device__ __forceinline__ void done(const Unit&) const {}
};
struct MoeOrder {
    const PG8_LAS int* mts; const char* A; const char* Bt; size_t tstep, bexp; int NN, u0, u1, gather;
    __device__ __forceinline__ bool next(int i, Unit& u) const {
        const int idx = u0 + i; if (idx >= u1) return false;
        const int mt = idx / NN; u.pn = idx - mt * NN; u.pm = mt;
        int e = 0;
        for (int k = 1; k < 32; ++k) e += (__builtin_amdgcn_readfirstlane(mts[k]) <= mt) ? 1 : 0;
        u.e = e; u.r0 = (mt - __builtin_amdgcn_readfirstlane(mts[e])) * BM; return true;
    }
    __device__ __forceinline__ const char* a_ptr(const Unit& u) const { return gather ? A : A + (size_t)u.pm * tstep; }
    __device__ __forceinline__ const char* b_ptr(const Unit& u) const { return Bt + (size_t)u.e * bexp + (size_t)u.pn * tstep; }
    __device__ __forceinline__ void a_ready(const Unit&) const {}
    __device__ __forceinline__ void done(const Unit&) const {}
};

struct EpiBf16S {
    static constexpr bool PERM = true, AFTER_DRAIN = false;
    bf16_t* O; int ldc; int st0, st1; float scale;
    __device__ __forceinline__ void operator()(const f32x4 (&acc)[2][2][4][2], const Unit& u, int wr, int wc, int fr, int fq) const {
        const int row0 = u.pm * BM + wr * 64 + fr, col0 = u.pn * BM + wc * 32 + 8 * fq;
        const float sc = (u.pn >= st0 && u.pn < st1) ? scale : 1.f;
#pragma unroll
        for (int ai = 0; ai < 2; ++ai)
#pragma unroll
            for (int m = 0; m < 4; ++m) { bf16_t* rowp = O + (size_t)(row0 + ai * HALF + m * 16) * ldc + col0;
#pragma unroll
                for (int bj = 0; bj < 2; ++bj) { const f32x4 v0 = acc[ai][bj][m][0] * sc, v1 = acc[ai][bj][m][1] * sc;
                    u32x4 w; w.x = cvt_pk_bf16(v0[0], v0[1]); w.y = cvt_pk_bf16(v0[2], v0[3]); w.z = cvt_pk_bf16(v1[0], v1[1]); w.w = cvt_pk_bf16(v1[2], v1[3]);
                    *(u32x4*)(rowp + bj * HALF) = w; } }
    }
};
struct EpiResF32 {
    static constexpr bool PERM = false, AFTER_DRAIN = false;
    const float* base; float* out; int ldc;
    __device__ __forceinline__ void operator()(const f32x4 (&acc)[2][2][4][2], const Unit& u, int wr, int wc, int fr, int fq) const {
        const int row0 = u.pm * BM + wr * 64 + fr, col0 = u.pn * BM + wc * 32 + 4 * fq;
#pragma unroll
        for (int ai = 0; ai < 2; ++ai)
#pragma unroll
            for (int m = 0; m < 4; ++m) { const size_t off = (size_t)(row0 + ai * HALF + m * 16) * ldc + col0;
#pragma unroll
                for (int bj = 0; bj < 2; ++bj)
#pragma unroll
                    for (int n = 0; n < 2; ++n) { const f32x4 b = *(const f32x4*)(base + off + bj * HALF + n * 16); *(f32x4*)(out + off + bj * HALF + n * 16) = b + acc[ai][bj][m][n]; } }
    }
};
__device__ __forceinline__ float sigm_fast(float v) { return __builtin_amdgcn_rcpf(1.f + __builtin_amdgcn_exp2f(-1.4426950408889634f * v)); }
struct EpiPle {
    static constexpr bool PERM = false, AFTER_DRAIN = false;
    const float* base; const bf16_t* pp; float* out; int ldc;
    __device__ __forceinline__ void operator()(const f32x4 (&acc)[2][2][4][2], const Unit& u, int wr, int wc, int fr, int fq) const {
        typedef unsigned u32x2 __attribute__((ext_vector_type(2)));
        const int row0 = u.pm * BM + wr * 64 + fr, col0 = u.pn * BM + wc * 32 + 4 * fq;
#pragma unroll
        for (int ai = 0; ai < 2; ++ai)
#pragma unroll
            for (int m = 0; m < 4; ++m) { const size_t off = (size_t)(row0 + ai * HALF + m * 16) * ldc + col0;
#pragma unroll
                for (int bj = 0; bj < 2; ++bj)
#pragma unroll
                    for (int n = 0; n < 2; ++n) { const size_t o2 = off + bj * HALF + n * 16; const f32x4 b = *(const f32x4*)(base + o2); const u32x2 pw = *(const u32x2*)(pp + o2); const f32x4 a = acc[ai][bj][m][n];
                        f32x4 r; r[0] = b[0] + __uint_as_float(pw.x << 16) * sigm_fast(a[0]); r[1] = b[1] + __uint_as_float(pw.x & 0xffff0000u) * sigm_fast(a[1]);
                        r[2] = b[2] + __uint_as_float(pw.y << 16) * sigm_fast(a[2]); r[3] = b[3] + __uint_as_float(pw.y & 0xffff0000u) * sigm_fast(a[3]);
                        *(f32x4*)(out + o2) = r; } }
    }
};
struct EpiMoeUp {
    static constexpr bool PERM = true, AFTER_DRAIN = false;
    bf16_t* act; const float* bias;
    __device__ __forceinline__ void operator()(const f32x4 (&acc)[2][2][4][2], const Unit& u, int wr, int wc, int fr, int fq) const {
        typedef unsigned u32x2 __attribute__((ext_vector_type(2)));
        const int row0 = u.pm * BM + wr * 64 + fr, col0 = u.pn * BM + wc * 32 + 8 * fq;
        const float* bp = bias + (size_t)u.e * 2048 + col0;
        f32x4 bv[2][2];
#pragma unroll
        for (int bj = 0; bj < 2; ++bj)
#pragma unroll
            for (int n = 0; n < 2; ++n) bv[bj][n] = *(const f32x4*)(bp + bj * HALF + 4 * n);
#pragma unroll
        for (int ai = 0; ai < 2; ++ai)
#pragma unroll
            for (int m = 0; m < 4; ++m) { bf16_t* rowp = act + (size_t)(row0 + ai * HALF + m * 16) * 1024 + (col0 >> 1);
#pragma unroll
                for (int bj = 0; bj < 2; ++bj) { const f32x4 v0 = acc[ai][bj][m][0] + bv[bj][0], v1 = acc[ai][bj][m][1] + bv[bj][1];
                    float o[4];
#pragma unroll
                    for (int q = 0; q < 4; ++q) { const float g = fminf(q < 2 ? v0[2 * q] : v1[2 * q - 4], 7.f); const float up = fminf(fmaxf(q < 2 ? v0[2 * q + 1] : v1[2 * q - 3], -7.f), 7.f);
                        o[q] = (up + 1.f) * g * sigm_fast(1.702f * g); }
                    u32x2 w; w.x = cvt_pk_bf16(o[0], o[1]); w.y = cvt_pk_bf16(o[2], o[3]);
                    *(u32x2*)(rowp + bj * (HALF / 2)) = w; } }
    }
};
struct EpiMoeDown {
    static constexpr bool PERM = true, AFTER_DRAIN = false;
    bf16_t* ys; const float* bias; const float* row_gate;
    __device__ __forceinline__ void operator()(const f32x4 (&acc)[2][2][4][2], const Unit& u, int wr, int wc, int fr, int fq) const {
        const int lrow0 = wr * 64 + fr, col0 = u.pn * BM + wc * 32 + 8 * fq;
        const float* bp = bias + (size_t)u.e * 1024 + col0; const float* gp = row_gate + (size_t)u.e * 16384 + u.r0;
        f32x4 bv[2][2];
#pragma unroll
        for (int bj = 0; bj < 2; ++bj)
#pragma unroll
            for (int n = 0; n < 2; ++n) bv[bj][n] = *(const f32x4*)(bp + bj * HALF + 4 * n);
#pragma unroll
        for (int ai = 0; ai < 2; ++ai)
#pragma unroll
            for (int m = 0; m < 4; ++m) { const int lr = lrow0 + ai * HALF + m * 16; const float g = gp[lr]; bf16_t* rowp = ys + (size_t)(u.pm * BM + lr) * 1024 + col0;
#pragma unroll
                for (int bj = 0; bj < 2; ++bj) { const f32x4 v0 = (acc[ai][bj][m][0] + bv[bj][0]) * g, v1 = (acc[ai][bj][m][1] + bv[bj][1]) * g;
                    u32x4 w; w.x = cvt_pk_bf16(v0[0], v0[1]); w.y = cvt_pk_bf16(v0[2], v0[3]); w.z = cvt_pk_bf16(v1[0], v1[1]); w.w = cvt_pk_bf16(v1[2], v1[3]);
                    *(u32x4*)(rowp + bj * HALF) = w; } }
    }
};

template <class Epi, class Sched, bool GATHER = false, bool ALIGN_EPI = false, bool SP2 = false>
__device__ __forceinline__ void gemm_phase(PG8_LAS unsigned char* lds, const int K, const Sched& S, const Epi& E, const PG8_LAS unsigned* gtab) {
    const int tid = threadIdx.x, wid = __builtin_amdgcn_readfirstlane(tid >> 6), lane = tid & 63, wr = wid >> 2, wc = wid & 3, fr = lane & 15, fq = lane >> 4;
    const int nt = K / BK;
    unsigned voffA[2][2], voffB[2];
#pragma unroll
    for (int i = 0; i < 2; ++i) { int R, C; stage_rc(tid * 16 + i * 8192, R, C); const int Rb = Epi::PERM ? ((R & ~31) + perm32(R & 31)) : R;
        voffA[0][i] = (unsigned)(R * K + C) * 2u; voffA[1][i] = (unsigned)((R + HALF) * K + C) * 2u; voffB[i] = (unsigned)(Rb * K + C) * 2u; }
#define PG8_GLOAD(UI) do { _Pragma("unroll") for (int _i = 0; _i < 2; ++_i) { int R_, C_; stage_rc(tid * 16 + _i * 8192, R_, C_); \
        voffA[0][_i] = gtab[(UI) * 256 + R_] + (unsigned)C_ * 2u; voffA[1][_i] = gtab[(UI) * 256 + HALF + R_] + (unsigned)C_ * 2u; } } while (0)
    const size_t kstep = (size_t)(BK * 2);
    const size_t hstep = (size_t)HALF * K * 2;
    const size_t tstep = 2 * hstep;
    const unsigned ldsw = (unsigned)wid * 1024u;
    const int aoff = lds_byte(wr * 64 + fr, fq * 8), boff = lds_byte(wc * 32 + fr, fq * 8);
#define PG8_SA(b, h) (((b) * 2 + (h)) * HTB)
#define PG8_SB(b, h) ((4 + (b) * 2 + (h)) * HTB)
#define PG8_STAGE(bufoff, gbase, voff) do { _Pragma("unroll") for (int _i = 0; _i < 2; ++_i) \
        __builtin_amdgcn_global_load_lds((const unsigned*)((const char*)(gbase) + (voff)[_i]), (PG8_LAS unsigned*)(lds + (bufoff) + ldsw + _i * 8192), 16, 0, 0); } while (0)
#define PG8_LDA(dst, b, h) do { _Pragma("unroll") for (int m = 0; m < 4; ++m) _Pragma("unroll") for (int k = 0; k < 2; ++k) dst[m][k] = *(const PG8_LAS bf16x8*)(lds + PG8_SA(b, h) + aoff + m * 2048 + k * 1024); } while (0)
#define PG8_LDB(dst, b, h) do { _Pragma("unroll") for (int n = 0; n < 2; ++n) _Pragma("unroll") for (int k = 0; k < 2; ++k) dst[n][k] = *(const PG8_LAS bf16x8*)(lds + PG8_SB(b, h) + boff + n * 2048 + k * 1024); } while (0)
#define PG8_MMA(ai, bj, At, Bt) do { __builtin_amdgcn_s_setprio(1); _Pragma("unroll") for (int m = 0; m < 4; ++m) _Pragma("unroll") for (int n = 0; n < 2; ++n) _Pragma("unroll") for (int k = 0; k < 2; ++k) \
        acc[ai][bj][m][n] = __builtin_amdgcn_mfma_f32_16x16x32_bf16(Bt[n][k], At[m][k], acc[ai][bj][m][n], 0, 0, 0); __builtin_amdgcn_s_setprio(0); } while (0)
#define PG8_WAIT_V(n) asm volatile("s_waitcnt vmcnt(" #n ")" ::: "memory")
#define PG8_WAIT_L(n) asm volatile("s_waitcnt lgkmcnt(" #n ")" ::: "memory")
#define PG8_BAR __builtin_amdgcn_s_barrier()
#define PG8_SCHED __builtin_amdgcn_sched_barrier(0)
    Unit cur, nxt; int ui = 0;
    if (!S.next(0, cur)) return;
    f32x4 acc[2][2][4][2];
#pragma unroll
    for (int a = 0; a < 2; ++a)
#pragma unroll
        for (int b = 0; b < 2; ++b)
#pragma unroll
            for (int m = 0; m < 4; ++m)
#pragma unroll
                for (int n = 0; n < 2; ++n) acc[a][b][m][n] = (f32x4){0.f, 0.f, 0.f, 0.f};
    bf16x8 At[4][2], B0[2][2], B1[2][2];
    const char* cA = S.a_ptr(cur); const char* cB = S.b_ptr(cur);
    if constexpr (GATHER) PG8_GLOAD(0);
    S.a_ready(cur);
    if constexpr (SP2) {
        PG8_STAGE(PG8_SB(0, 0), cB, voffB); PG8_STAGE(PG8_SB(0, 1), cB + hstep, voffB); PG8_STAGE(PG8_SA(0, 0), cA, voffA[0]); PG8_STAGE(PG8_SA(0, 1), cA, voffA[1]);
        if (wr == 1) PG8_BAR;
        PG8_WAIT_V(2); PG8_BAR;
        PG8_STAGE(PG8_SB(1, 0), cB + kstep, voffB); PG8_STAGE(PG8_SA(1, 0), cA + kstep, voffA[0]); PG8_STAGE(PG8_SB(1, 1), cB + hstep + kstep, voffB);
        PG8_WAIT_V(6); PG8_BAR;
    } else {
        PG8_STAGE(PG8_SB(0, 0), cB, voffB); PG8_STAGE(PG8_SA(0, 0), cA, voffA[0]); PG8_STAGE(PG8_SB(0, 1), cB + hstep, voffB); PG8_STAGE(PG8_SA(0, 1), cA, voffA[1]);
        if (wr == 1) PG8_BAR;
        PG8_WAIT_V(4); PG8_BAR;
        PG8_STAGE(PG8_SB(1, 0), cB + kstep, voffB); PG8_STAGE(PG8_SA(1, 0), cA + kstep, voffA[0]); PG8_STAGE(PG8_SB(1, 1), cB + hstep + kstep, voffB);
        PG8_WAIT_V(6); PG8_BAR;
    }
    for (;;) {
        const bool has_next = S.next(ui + 1, nxt);
        const char* nA = has_next ? S.a_ptr(nxt) : cA; const char* nB = has_next ? S.b_ptr(nxt) : cB;
        for (int t = 0; t < nt; t += 2) {
            const bool last = (t == nt - 2);
            const char* a1 = cA + (size_t)(t + 1) * kstep;
            const char* a2 = last ? nA : cA + (size_t)(t + 2) * kstep; const char* b2 = last ? nB : cB + (size_t)(t + 2) * kstep;
            const char* a3 = a2 + kstep; const char* b3 = b2 + kstep;
            if (last && has_next) S.a_ready(nxt);
            if constexpr (SP2) {
            PG8_LDB(B0, 0, 0); PG8_LDB(B1, 0, 1); PG8_SCHED; PG8_LDA(At, 0, 0); PG8_STAGE(PG8_SA(1, 1), a1, voffA[1]); if constexpr (GATHER) { if (last && has_next) PG8_GLOAD(ui + 1); }
            PG8_WAIT_V(8); PG8_WAIT_L(0); PG8_BAR; PG8_MMA(0, 0, At, B0); PG8_MMA(0, 1, At, B1); PG8_BAR; PG8_SCHED;
            PG8_LDA(At, 0, 1); PG8_STAGE(PG8_SB(0, 0), b2, voffB); PG8_STAGE(PG8_SB(0, 1), b2 + hstep, voffB); PG8_STAGE(PG8_SA(0, 0), a2, voffA[0]);
            PG8_WAIT_V(8); PG8_WAIT_L(0); PG8_BAR; PG8_MMA(1, 0, At, B0); PG8_MMA(1, 1, At, B1); PG8_BAR; PG8_SCHED;
            PG8_LDB(B0, 1, 0); PG8_LDB(B1, 1, 1); PG8_SCHED; PG8_LDA(At, 1, 0); PG8_STAGE(PG8_SA(0, 1), a2, voffA[1]);
            PG8_WAIT_V(8); PG8_WAIT_L(0); PG8_BAR; PG8_MMA(0, 0, At, B0); PG8_MMA(0, 1, At, B1); PG8_BAR; PG8_SCHED;
            PG8_LDA(At, 1, 1); PG8_STAGE(PG8_SB(1, 0), b3, voffB); PG8_STAGE(PG8_SB(1, 1), b3 + hstep, voffB); PG8_STAGE(PG8_SA(1, 0), a3, voffA[0]);
            PG8_WAIT_V(8); PG8_WAIT_L(0); PG8_BAR; PG8_MMA(1, 0, At, B0); PG8_MMA(1, 1, At, B1); PG8_BAR; PG8_SCHED;
            } else {
            PG8_LDB(B0, 0, 0); PG8_SCHED; PG8_LDA(At, 0, 0); PG8_STAGE(PG8_SA(1, 1), a1, voffA[1]); if constexpr (GATHER) { if (last && has_next) PG8_GLOAD(ui + 1); }
            PG8_WAIT_L(8); PG8_BAR; PG8_WAIT_L(0); PG8_MMA(0, 0, At, B0); PG8_BAR; PG8_SCHED;
            PG8_LDB(B1, 0, 1); PG8_STAGE(PG8_SB(0, 0), b2, voffB);
            PG8_BAR; PG8_WAIT_L(0); PG8_MMA(0, 1, At, B1); PG8_BAR;
            PG8_LDA(At, 0, 1); PG8_STAGE(PG8_SA(0, 0), a2, voffA[0]);
            PG8_BAR; PG8_WAIT_L(0); PG8_MMA(1, 0, At, B0); PG8_BAR; PG8_SCHED;
            PG8_STAGE(PG8_SB(0, 1), b2 + hstep, voffB);
            PG8_WAIT_V(6); PG8_BAR; PG8_MMA(1, 1, At, B1); PG8_BAR;
            PG8_LDB(B0, 1, 0); PG8_SCHED; PG8_LDA(At, 1, 0); PG8_STAGE(PG8_SA(0, 1), a2, voffA[1]);
            PG8_WAIT_L(8); PG8_BAR; PG8_WAIT_L(0); PG8_MMA(0, 0, At, B0); PG8_BAR; PG8_SCHED;
            PG8_LDB(B1, 1, 1); PG8_STAGE(PG8_SB(1, 0), b3, voffB);
            PG8_BAR; PG8_WAIT_L(0); PG8_MMA(0, 1, At, B1); PG8_BAR;
            PG8_LDA(At, 1, 1); PG8_STAGE(PG8_SA(1, 0), a3, voffA[0]);
            PG8_BAR; PG8_WAIT_L(0); PG8_MMA(1, 0, At, B0); PG8_BAR; PG8_SCHED;
            PG8_STAGE(PG8_SB(1, 1), b3 + hstep, voffB);
            PG8_WAIT_V(6); PG8_BAR; PG8_MMA(1, 1, At, B1); PG8_BAR;
            }
        }
        if constexpr (ALIGN_EPI) { if (wr == 0) PG8_BAR; }
        if constexpr (!Epi::AFTER_DRAIN) { E(acc, cur, wr, wc, fr, fq); S.done(cur); }
        if (!has_next) break;
#pragma unroll
        for (int a = 0; a < 2; ++a)
#pragma unroll
            for (int b = 0; b < 2; ++b)
#pragma unroll
                for (int m = 0; m < 4; ++m)
#pragma unroll
                    for (int n = 0; n < 2; ++n) acc[a][b][m][n] = (f32x4){0.f, 0.f, 0.f, 0.f};
        cur = nxt; cA = nA; cB = nB; ++ui;
        if constexpr (ALIGN_EPI) { if (wr == 1) PG8_BAR; }
    }
    PG8_WAIT_V(0);
    if constexpr (!ALIGN_EPI) { if (wr == 0) PG8_BAR; }
    PG8_BAR;
    if constexpr (Epi::AFTER_DRAIN) { E.fused(acc, cur, wr, wc, fr, fq, lds, wid, lane); S.done(cur); }
#undef PG8_SA
#undef PG8_SB
#undef PG8_STAGE
#undef PG8_LDA
#undef PG8_LDB
#undef PG8_MMA
#undef PG8_WAIT_V
#undef PG8_WAIT_L
#undef PG8_BAR
#undef PG8_SCHED
#undef PG8_GLOAD
}
}
#include <hip/hip_bf16.h>
#include <cmath>
namespace attn_body {
using bf16=__hip_bfloat16;
using bf16x8=__attribute__((ext_vector_type(8)))short;
using s16x4=__attribute__((ext_vector_type(4)))short;
using f32x16=__attribute__((ext_vector_type(16)))float;
using u32x4=__attribute__((ext_vector_type(4)))unsigned;
constexpr int BATCH=8,NHEAD=16,SEQ=2048,D=64,DMI=3072,DMO=1024;
constexpr int NW=8,QBLK=32,QB=QBLK*NW,KVBLK=64,NQB=SEQ/QB;
constexpr int ATTN_UNIT_ROWS=QB;
__device__ __forceinline__ int crow(int r,int hi){return (r&3)+8*(r>>2)+4*hi;}
#define SBAR() __builtin_amdgcn_sched_barrier(0)
__device__ __forceinline__ void cmask(f32x16&p0,f32x16&p1,int jb,int qrel,int hi){
  const float NEG=-INFINITY; int kb=64*jb+4*hi;
  #pragma unroll
  for(int r=0;r<16;++r){int kv=kb+(r&3)+8*(r>>2); if(kv>qrel)p0[r]=NEG; if(kv+32>qrel)p1[r]=NEG;}
}

constexpr int NSLOT=3, SLOTB=8192;
constexpr int LDS_K=0, LDS_V=NSLOT*SLOTB, LDS_WS=2*NSLOT*SLOTB, LDS_OST=LDS_WS+NW*64*4, LDS_BYTES=LDS_OST+NW*4096;
constexpr float C2=0.125f*1.4426950408889634f;
__device__ __forceinline__ void glds16(const void*gsrc,unsigned lds_dst){unsigned keep;
  asm volatile("s_mov_b32 %0, m0\n\ts_mov_b32 m0, %2\n\ts_nop 0\n\tglobal_load_lds_dwordx4 %1, off\n\ts_mov_b32 m0, %0":"=&s"(keep):"v"(gsrc),"s"(lds_dst):"memory");}
__device__ __forceinline__ float max3f(float a,float b,float c){float r;asm("v_max3_f32 %0, %1, %2, %3":"=v"(r):"v"(a),"v"(b),"v"(c));return r;}
__device__ __forceinline__ float max2f(float a,float b){float r;asm("v_max_f32_e32 %0, %1, %2":"=v"(r):"v"(a),"v"(b));return r;}
__device__ __forceinline__ float fadd_s(float a,float b){float r;asm("v_add_f32_e32 %0, %1, %2":"=v"(r):"v"(a),"v"(b));return r;}
__device__ __forceinline__ float fsub_s(float a,float b){float r;asm("v_sub_f32_e32 %0, %1, %2":"=v"(r):"v"(a),"v"(b));return r;}
typedef float f32x2_t __attribute__((ext_vector_type(2))); typedef __bf16 bf16x2_t __attribute__((ext_vector_type(2)));
__device__ __forceinline__ unsigned cvtpk_s(float lo,float hi){f32x2_t v={lo,hi};bf16x2_t b=__builtin_convertvector(v,bf16x2_t);return __builtin_bit_cast(unsigned,b);}
#define WAIT_BAR(N) asm volatile("s_waitcnt vmcnt(" #N ") lgkmcnt(0)\n\ts_barrier":::"memory")

__device__ __forceinline__ void qkt(f32x16&p0,f32x16&p1,const char*Kslot,const bf16x8*qr,const f32x16&negm,int r32,int hi){
  const char*kb=Kslot+hi*1024+r32*16;
  #pragma unroll
  for(int d0=0;d0<4;++d0){
    const bf16x8 b0=*reinterpret_cast<const bf16x8*>(kb+d0*2048);
    const bf16x8 b1=*reinterpret_cast<const bf16x8*>(kb+d0*2048+512);
    if(d0==0){p0=__builtin_amdgcn_mfma_f32_32x32x16_bf16(b0,qr[0],negm,0,0,0);p1=__builtin_amdgcn_mfma_f32_32x32x16_bf16(b1,qr[0],negm,0,0,0);}
    else{p0=__builtin_amdgcn_mfma_f32_32x32x16_bf16(b0,qr[d0],p0,0,0,0);p1=__builtin_amdgcn_mfma_f32_32x32x16_bf16(b1,qr[d0],p1,0,0,0);}}
}
typedef __attribute__((address_space(3))) const char* lds_cptr;
typedef short v4i16_t __attribute__((ext_vector_type(4)));
__device__ __forceinline__ void kload8(bf16x8*kf,lds_cptr kp){
  kf[0]=*(const __attribute__((address_space(3))) bf16x8*)(kp);      kf[1]=*(const __attribute__((address_space(3))) bf16x8*)(kp+512);
  kf[2]=*(const __attribute__((address_space(3))) bf16x8*)(kp+2048); kf[3]=*(const __attribute__((address_space(3))) bf16x8*)(kp+2560);
  kf[4]=*(const __attribute__((address_space(3))) bf16x8*)(kp+4096); kf[5]=*(const __attribute__((address_space(3))) bf16x8*)(kp+4608);
  kf[6]=*(const __attribute__((address_space(3))) bf16x8*)(kp+6144); kf[7]=*(const __attribute__((address_space(3))) bf16x8*)(kp+6656);
}
__device__ __forceinline__ void kload2(bf16x8*kf,lds_cptr kp,int j){ kf[2*j]=*(const __attribute__((address_space(3))) bf16x8*)(kp+j*2048); kf[2*j+1]=*(const __attribute__((address_space(3))) bf16x8*)(kp+j*2048+512); }
__device__ __forceinline__ s16x4 vtr(lds_cptr p){ return __builtin_bit_cast(s16x4,__builtin_amdgcn_ds_read_tr16_b64_v4i16((__attribute__((address_space(3))) v4i16_t*)p)); }
__device__ __forceinline__ float rowmax(const f32x16&p0,const f32x16&p1){
  float a=max3f(p0[0],p0[1],p1[0]),b=max3f(p0[2],p0[3],p1[1]);a=max3f(a,p1[2],p1[3]);
  #pragma unroll
  for(int r=4;r<16;r+=4){a=max3f(a,p0[r],p0[r+1]);b=max3f(b,p0[r+2],p0[r+3]);a=max3f(a,p1[r],p1[r+1]);b=max3f(b,p1[r+2],p1[r+3]);}
  const float m=max2f(a,b);
  auto rr=__builtin_amdgcn_permlane32_swap(__float_as_uint(m),__float_as_uint(m),false,false);
  return max2f(__uint_as_float(rr[0]),__uint_as_float(rr[1]));
}
__device__ __forceinline__ void pv(f32x16*o,int vb,bf16x8 pa0,bf16x8 pa1,bf16x8 pa2,bf16x8 pa3){
  #pragma unroll
  for(int d0=0;d0<2;++d0){s16x4 lo[4],hi[4];
    #pragma unroll
    for(int ks=0;ks<4;++ks){
      asm volatile("ds_read_b64_tr_b16 %0,%1 offset:%c2":"=&v"(lo[ks]):"v"(vb),"i"(d0*4096+ks*1024):"memory");
      asm volatile("ds_read_b64_tr_b16 %0,%1 offset:%c2":"=&v"(hi[ks]):"v"(vb),"i"(d0*4096+ks*1024+512):"memory");}
    asm volatile("s_waitcnt lgkmcnt(0)":::"memory");SBAR();
    #define PK(k) (bf16x8){lo[k][0],lo[k][1],lo[k][2],lo[k][3],hi[k][0],hi[k][1],hi[k][2],hi[k][3]}
    o[d0]=__builtin_amdgcn_mfma_f32_32x32x16_bf16(pa0,PK(0),o[d0],0,0,0);
    o[d0]=__builtin_amdgcn_mfma_f32_32x32x16_bf16(pa1,PK(1),o[d0],0,0,0);
    o[d0]=__builtin_amdgcn_mfma_f32_32x32x16_bf16(pa2,PK(2),o[d0],0,0,0);
    o[d0]=__builtin_amdgcn_mfma_f32_32x32x16_bf16(pa3,PK(3),o[d0],0,0,0);
    #undef PK
  }
}

#ifndef ATTN_STORE16
#define ATTN_STORE16(p,v) (*(u32x4*)(p)=(v))
#endif
template<int THRL> __device__ __forceinline__ void attn_unit(int b,int qb,const bf16*Q,const bf16*__restrict__ K,const bf16*__restrict__ V,bf16*O,char*shm){
  const int tid=threadIdx.x,lane=tid&63,r32=lane&31,hi=lane>>5; const int wid=__builtin_amdgcn_readfirstlane(tid>>6);
  const long rowbase=(long)b*SEQ; const int q0=qb*QB;
  const bf16*Qw=Q+(rowbase+q0+wid*QBLK)*DMI;
  const bf16*Kh=K+rowbase*DMI,*Vh=V+rowbase*DMI;
  const unsigned lds0=(unsigned)(uintptr_t)shm;
  float*wsf=(float*)(shm+LDS_WS)+wid*64;
  const bf16*ksrc=Kh+(long)lane*DMI+wid*8;
  const bf16*vsrc=Vh+(long)(16*(wid&3)+(lane>>2))*DMI+(wid>>2)*32+(lane&3)*8;
  const unsigned kdst=lds0+LDS_K+wid*1024, vdst=lds0+LDS_V+wid*1024;
  #define DMA_K(t,slot) glds16(ksrc+(long)(t)*KVBLK*DMI,(unsigned)__builtin_amdgcn_readfirstlane(kdst+(slot)))
  #define DMA_V(t,slot) glds16(vsrc+(long)(t)*KVBLK*DMI,(unsigned)__builtin_amdgcn_readfirstlane(vdst+(slot)))
  const int vb0=(int)(lds0+LDS_V)+((lane>>4)&1)*32+(lane&3)*8+(4*hi+((lane&15)>>2))*64;
  const char*Kbase=shm+LDS_K; bf16x8 kf[8];
  const lds_cptr shm3=(lds_cptr)shm; const lds_cptr kp0=shm3+LDS_K+hi*1024+r32*16; const lds_cptr vp0=shm3+LDS_V+((lane>>4)&1)*32+(lane&3)*8+(4*hi+((lane&15)>>2))*64;
  const int NT=(q0+QB)/KVBLK;
  DMA_K(0,0);DMA_V(0,0);DMA_K(1,SLOTB);
  bf16x8 qr[4];
  #pragma unroll
  for(int d0=0;d0<4;++d0)qr[d0]=*reinterpret_cast<const bf16x8*>(&Qw[(long)r32*DMI+d0*16+hi*8]);
  float mhat=0.f,l_reg=0.f;f32x16 o[2];o[0]=f32x16{};o[1]=f32x16{};f32x16 negm=f32x16{};asm volatile("":"+v"(negm));
  const int qrel=wid*QBLK+r32;
  #define CMASK(P0,P1,t) do{int jb_=(t)-(NT-4); if(jb_>=0)cmask(P0,P1,jb_,qrel,hi);}while(0)
  bool resc=false;
  #define START(P0,P1) do{ const float rm=rowmax(P0,P1); resc=false; \
    { const float dl=rm; mhat=fadd_s(mhat,dl); \
      _Pragma("unroll") for(int r=0;r<16;++r){P0[r]=fsub_s(P0[r],dl);P1[r]=fsub_s(P1[r],dl);} \
      _Pragma("unroll") for(int r=0;r<16;++r)negm[r]=-mhat; asm volatile("":"+v"(negm)); } \
    _Pragma("unroll") for(int r=0;r<16;++r)P0[r]=__builtin_amdgcn_exp2f(P0[r]); }while(0)
  #define RESC() do{ if(resc){ asm volatile("s_waitcnt lgkmcnt(0)":::"memory"); \
      _Pragma("unroll") for(int d_=0;d_<2;++d_) _Pragma("unroll") for(int r=0;r<16;++r)o[d_][r]*=wsf[crow(r,hi)]; } }while(0)
  f32x16 pA0,pA1,pB0,pB1;
  int sl_prev=0,sl_cur=0,sl_next=SLOTB;
  #define ROT() do{sl_prev=sl_cur;sl_cur=sl_next;sl_next=(sl_next==(NSLOT-1)*SLOTB)?0:sl_next+SLOTB;}while(0)
  DMA_K(2,2*SLOTB);
  WAIT_BAR(3);
  qkt(pA0,pA1,Kbase,qr,negm,r32,hi);asm volatile("s_nop 15\n\ts_nop 7":"+v"(pA0),"+v"(pA1));CMASK(pA0,pA1,0);
  START(pA0,pA1);
  _Pragma("unroll") for(int r=0;r<16;++r)pA1[r]=__builtin_amdgcn_exp2f(pA1[r]);
  WAIT_BAR(0);
  DMA_K(3,0);DMA_V(1,SLOTB);
  ROT();
  kload8(kf,kp0+sl_cur);
  WAIT_BAR(2);
  s16x4 vlo[8],vhi[8]; u32x4 pw0,pw1,pw2,pw3;
  #define PKW(P,B) cvtpk_s(P[B],P[B+1])
  #define PAF(k) __builtin_bit_cast(bf16x8,pw##k)
  #define VFR(i) (bf16x8){vlo[i][0],vlo[i][1],vlo[i][2],vlo[i][3],vhi[i][0],vhi[i][1],vhi[i][2],vhi[i][3]}
  #define PIN(x) asm volatile("":"+v"(x))
  #define MX3(a,b,c) __builtin_fmaxf(__builtin_fmaxf((a),(b)),(c))
  #define GAPA(MF,A0,A1,A2,A3,W0,W1,PW) do{ MF; sacc+=A0; sacc+=A1; sacc+=A2; sacc+=A3; PIN(sacc); W0; W1; PIN(PW); SBAR(); }while(0)
  #define EX(v) __builtin_amdgcn_exp2f(v)
  #define GAPB(MF,X,B) do{ MF; X[B]=EX(X[B]); X[B+1]=EX(X[B+1]); X[B+2]=EX(X[B+2]); X[B+3]=EX(X[B+3]); PIN(X); SBAR(); }while(0)
  #define VRD(i) do{ vlo[i]=vtr(vp_+(((i)>>2)*4096+((i)&3)*1024)); vhi[i]=vtr(vp_+(((i)>>2)*4096+((i)&3)*1024+512)); }while(0)
  #define KRD(G,j) do{ if(G){ kload2(kf,kp0+sl_next,j); SBAR(); } }while(0)
  #define STEP(C0,C1,P0,P1,t,GK,GV,GL) do{ SBAR(); \
    const lds_cptr vp_=vp0+sl_prev; \
    VRD(0); SBAR(); float sacc=(P0[0]+P0[1]); \
    GAPA(C0=__builtin_amdgcn_mfma_f32_32x32x16_bf16(kf[0],qr[0],negm,0,0,0), P0[2],P0[3],P0[4],P0[5],     pw0[0]=PKW(P0,0), pw0[1]=PKW(P0,2), pw0); \
    VRD(4); SBAR(); GAPA(C1=__builtin_amdgcn_mfma_f32_32x32x16_bf16(kf[1],qr[0],negm,0,0,0), P0[6],P0[7],P0[8],P0[9],     pw0[2]=PKW(P0,4), pw0[3]=PKW(P0,6), pw0); \
    VRD(1); SBAR(); GAPA(C0=__builtin_amdgcn_mfma_f32_32x32x16_bf16(kf[2],qr[1],C0,0,0,0),   P0[10],P0[11],P0[12],P0[13], pw1[0]=PKW(P0,8), pw1[1]=PKW(P0,10), pw1); \
    VRD(5); SBAR(); GAPA(C1=__builtin_amdgcn_mfma_f32_32x32x16_bf16(kf[3],qr[1],C1,0,0,0),   P0[14],P0[15],P1[0],P1[1],   pw1[2]=PKW(P0,12),pw1[3]=PKW(P0,14), pw1); \
    VRD(2); SBAR(); GAPA(C0=__builtin_amdgcn_mfma_f32_32x32x16_bf16(kf[4],qr[2],C0,0,0,0),   P1[2],P1[3],P1[4],P1[5],     pw2[0]=PKW(P1,0), pw2[1]=PKW(P1,2), pw2); \
    VRD(6); SBAR(); GAPA(C1=__builtin_amdgcn_mfma_f32_32x32x16_bf16(kf[5],qr[2],C1,0,0,0),   P1[6],P1[7],P1[8],P1[9],     pw2[2]=PKW(P1,4), pw2[3]=PKW(P1,6), pw2); \
    VRD(3); SBAR(); GAPA(C0=__builtin_amdgcn_mfma_f32_32x32x16_bf16(kf[6],qr[3],C0,0,0,0),   P1[10],P1[11],P1[12],P1[13], pw3[0]=PKW(P1,8), pw3[1]=PKW(P1,10), pw3); \
    VRD(7); SBAR(); GAPA(C1=__builtin_amdgcn_mfma_f32_32x32x16_bf16(kf[7],qr[3],C1,0,0,0),   P1[14],P1[15],0.f,0.f,       pw3[2]=PKW(P1,12),pw3[3]=PKW(P1,14), pw3); \
    l_reg+=sacc; \
    if(GK){DMA_K((t)+3,sl_cur);} if(GV){DMA_V((t)+1,sl_next);} \
    CMASK(C0,C1,t); \
    { float a=MX3(C0[0],C0[1],C1[0]),b=MX3(C0[2],C0[3],C1[1]); a=MX3(a,C1[2],C1[3]); \
      _Pragma("unroll") for(int r=4;r<16;r+=4){a=MX3(a,C0[r],C0[r+1]);b=MX3(b,C0[r+2],C0[r+3]);a=MX3(a,C1[r],C1[r+1]);b=MX3(b,C1[r+2],C1[r+3]);} \
      float rm=__builtin_fmaxf(a,b); { auto rr=__builtin_amdgcn_permlane32_swap(__float_as_uint(rm),__float_as_uint(rm),false,false); rm=__builtin_fmaxf(__uint_as_float(rr[0]),__uint_as_float(rr[1])); } \
      resc=false; \
      if(__builtin_expect(__any(rm>(float)THRL),0)){ const float dl=__builtin_fmaxf(rm,0.f); mhat+=dl; \
        _Pragma("unroll") for(int r=0;r<16;++r){C0[r]-=dl;C1[r]-=dl;} \
        _Pragma("unroll") for(int r=0;r<16;++r)negm[r]=-mhat; asm volatile("":"+v"(negm)); \
        const float f=__builtin_amdgcn_exp2f(-dl); l_reg*=f; if(hi==0)wsf[r32]=f; resc=true; } } \
    SBAR(); \
    GAPB(o[0]=__builtin_amdgcn_mfma_f32_32x32x16_bf16(PAF(0),VFR(0),o[0],0,0,0), C0,0); \
    GAPB(o[1]=__builtin_amdgcn_mfma_f32_32x32x16_bf16(PAF(0),VFR(4),o[1],0,0,0), C0,4); \
    KRD(GL,0); GAPB(o[0]=__builtin_amdgcn_mfma_f32_32x32x16_bf16(PAF(1),VFR(1),o[0],0,0,0), C0,8); \
    KRD(GL,1); GAPB(o[1]=__builtin_amdgcn_mfma_f32_32x32x16_bf16(PAF(1),VFR(5),o[1],0,0,0), C0,12); \
    KRD(GL,2); GAPB(o[0]=__builtin_amdgcn_mfma_f32_32x32x16_bf16(PAF(2),VFR(2),o[0],0,0,0), C1,0); \
    KRD(GL,3); GAPB(o[1]=__builtin_amdgcn_mfma_f32_32x32x16_bf16(PAF(2),VFR(6),o[1],0,0,0), C1,4); \
    GAPB(o[0]=__builtin_amdgcn_mfma_f32_32x32x16_bf16(PAF(3),VFR(3),o[0],0,0,0), C1,8); \
    GAPB(o[1]=__builtin_amdgcn_mfma_f32_32x32x16_bf16(PAF(3),VFR(7),o[1],0,0,0), C1,12); \
    }while(0)
  int t=1;
  #undef CMASK
  #define CMASK(P0,P1,t) do{}while(0)
  for(;t+5<NT;t+=2){
    STEP(pB0,pB1,pA0,pA1,t,true,true,true);     WAIT_BAR(2); RESC(); ROT();
    STEP(pA0,pA1,pB0,pB1,t+1,true,true,true);   WAIT_BAR(2); RESC(); ROT();
  }
  #undef CMASK
  #define CMASK(P0,P1,t) do{int jb_=(t)-(NT-4); if(jb_>=0)cmask(P0,P1,jb_,qrel,hi);}while(0)
  #define ENDW(tt) do{ if((tt)+3<NT){WAIT_BAR(2);} else if((tt)+2<NT){WAIT_BAR(1);} else {WAIT_BAR(0);} }while(0)
  for(;t+1<NT;t+=2){
    STEP(pB0,pB1,pA0,pA1,t,(t+3<NT),(t+1<NT),(t+1<NT));       ENDW(t);   RESC(); ROT();
    STEP(pA0,pA1,pB0,pB1,t+1,(t+4<NT),(t+2<NT),(t+2<NT));     ENDW(t+1); RESC(); ROT();
  }
  STEP(pB0,pB1,pA0,pA1,NT-1,false,false,false); RESC();
  { float sacc=pB0[0]+pB0[1]; _Pragma("unroll") for(int r=2;r<16;++r)sacc+=pB0[r]; _Pragma("unroll") for(int r=0;r<16;++r)sacc+=pB1[r]; l_reg+=sacc;
    pw0=(u32x4){PKW(pB0,0),PKW(pB0,2),PKW(pB0,4),PKW(pB0,6)};pw1=(u32x4){PKW(pB0,8),PKW(pB0,10),PKW(pB0,12),PKW(pB0,14)};pw2=(u32x4){PKW(pB1,0),PKW(pB1,2),PKW(pB1,4),PKW(pB1,6)};pw3=(u32x4){PKW(pB1,8),PKW(pB1,10),PKW(pB1,12),PKW(pB1,14)};
    SBAR(); pv(o,vb0+sl_cur,PAF(0),PAF(1),PAF(2),PAF(3)); }
  #undef PKW
  #undef PAF
  #undef VFR
  #undef PIN
  #undef MX3
  #undef GAPA
  #undef GAPB
  #undef EX
  #undef VRD
  #undef KRD
  #undef STEP
  #undef ENDW
  {auto rr=__builtin_amdgcn_permlane32_swap(__float_as_uint(l_reg),__float_as_uint(l_reg),false,false);l_reg=__uint_as_float(rr[0])+__uint_as_float(rr[1]);}
  if(hi==0)wsf[32+r32]=l_reg;asm volatile("s_waitcnt lgkmcnt(0)":::"memory");
  float rli[16];
  #pragma unroll
  for(int r=0;r<16;++r)rli[r]=__builtin_amdgcn_rcpf(wsf[32+crow(r,hi)]);
  bf16*Ow=O+(rowbase+q0+wid*QBLK)*DMO;
  { bf16*stg=(bf16*)(shm+LDS_OST)+wid*2048;
    #pragma unroll
    for(int r=0;r<16;++r){const int orow=crow(r,hi);
      #pragma unroll
      for(int d0=0;d0<2;++d0)stg[orow*64+d0*32+r32]=__float2bfloat16(o[d0][r]*rli[r]);}
    asm volatile("s_waitcnt lgkmcnt(0)":::"memory");
    #pragma unroll
    for(int i=0;i<4;++i){const int row=i*8+(lane>>3),ch=lane&7; const u32x4 v=*(const u32x4*)(stg+row*64+ch*8); ATTN_STORE16(Ow+(long)row*DMO+ch*8,v);} }
  asm volatile("s_waitcnt lgkmcnt(0)\n\ts_barrier":::"memory");
  #undef DMA_K
  #undef DMA_V
  #undef CMASK
  #undef START
  #undef RESC
  #undef ROT
}
constexpr int ATTN_LDS_BYTES=LDS_BYTES;
struct AttnTensors { const bf16* PJ; bf16* O; };
struct AttnUnit { int bh; int qb; };
constexpr int QCOL=1536, KCOL=2048, VCOL=2560;
struct StaticOrder {
  int vcu;
  __device__ __forceinline__ explicit StaticOrder(int v):vcu(v){}
  __device__ __forceinline__ bool next(int i,AttnUnit&u)const{ if(i>=4||vcu>=256)return false; const int s=2*(vcu&1)+(i>>1); u.bh=vcu>>1; u.qb=(i&1)?7-s:s; return true; }
  __device__ __forceinline__ void a_ready(const AttnUnit&)const{}
  __device__ __forceinline__ void done(const AttnUnit&)const{}
};
template<class Sched,int THRL=8> __device__ __forceinline__ void attn_phase(char*lds,const AttnTensors&T,const Sched&S){
  AttnUnit u;
  for(int i=0;S.next(i,u);++i){ S.a_ready(u);
    const int b=u.bh>>4, vh=u.bh&15, hd=vh>>2, j=(vh>>1)&1, half=vh&1;
    attn_unit<THRL>(b,u.qb,T.PJ+QCOL+hd*128+j*64,T.PJ+KCOL+hd*128+j*64,T.PJ+VCOL+hd*128+half*64,T.O+vh*64,lds); S.done(u); }
}
#undef SBAR
#undef WAIT_BAR
}
#define GAS __attribute__((address_space(1)))
#define LAS __attribute__((address_space(3)))
typedef unsigned short bf16;
typedef unsigned v4u __attribute__((ext_vector_type(4)));
typedef float f32x4 __attribute__((ext_vector_type(4)));
typedef short bf16x8 __attribute__((ext_vector_type(8)));
typedef GAS unsigned gu32;
typedef GAS unsigned long long gu64;
#define RLX_AGENT __ATOMIC_RELAXED, __HIP_MEMORY_SCOPE_AGENT
#define LDS_WAIT() asm volatile("s_waitcnt lgkmcnt(0)" ::: "memory")
#define VM_WAIT() asm volatile("s_waitcnt vmcnt(0)" ::: "memory")
__device__ __forceinline__ unsigned long long rt() { return __builtin_amdgcn_s_memrealtime(); }
__device__ __forceinline__ unsigned f2bf(float f) { unsigned u = __builtin_bit_cast(unsigned, f); return (u + 0x7fffu + ((u >> 16) & 1u)) >> 16; }
__device__ __forceinline__ unsigned pk2(float lo, float hi) { return f2bf(lo) | (f2bf(hi) << 16); }

#define XB_TMO      128
#define XB_XCNT(j)  (256  + 64 * (j))
#define XB_XSUB(j)  (1280 + 64 * (j))
#define XB_XGEN(j)  (2304 + 64 * (j))
#define XB_TOP      3328
#define XB_TOPGEN   3392
#define XCD_BAR_WORDS 3456
#define XB_SPIN_CAP (1u << 18)

__device__ __forceinline__ unsigned xb_ld(unsigned* p)              { return __hip_atomic_load(p, __ATOMIC_RELAXED, __HIP_MEMORY_SCOPE_AGENT); }
__device__ __forceinline__ unsigned xb_add(unsigned* p, unsigned v) { return __hip_atomic_fetch_add(p, v, __ATOMIC_RELAXED, __HIP_MEMORY_SCOPE_AGENT); }
__device__ __forceinline__ unsigned xb_xcc_id() { return (unsigned)__builtin_amdgcn_s_getreg((3 << 11) | 20) & 0xFu; }
#define XB_SPIN(cond, bar) do { unsigned _sp = 0; while (cond) { __builtin_amdgcn_s_sleep(1); \
    if ((++_sp & 255u) == 0u) { if (xb_ld(&(bar)[XB_TMO])) break; if (_sp > XB_SPIN_CAP) { atomicAdd(&(bar)[XB_TMO], 1u); break; } } } } while (0)

struct XcdBarrier {
    unsigned* bar; unsigned x;
    volatile LAS unsigned* st;
};

__device__ __forceinline__ XcdBarrier xcd_barrier_post(unsigned* bar, volatile LAS unsigned* st) {
    XcdBarrier b; b.bar = bar; b.x = xb_xcc_id(); b.st = st;
    if (threadIdx.x == 0) (void)xb_add(&bar[XB_XCNT(b.x)], 1u);
    return b;
}
__device__ __forceinline__ void xcd_barrier_complete(unsigned* bar, unsigned x, unsigned& nloc, unsigned& nx) {
    const unsigned G = gridDim.x * gridDim.y * gridDim.z;
    unsigned sum, cnt, mine, sp = 0u;
    for (;;) {
        sum = 0u; cnt = 0u; mine = 0u;
#pragma unroll
        for (unsigned j = 0; j < 16; ++j) { const unsigned c = xb_ld(&bar[XB_XCNT(j)]); sum += c; cnt += (c > 0u) ? 1u : 0u; mine = (j == x) ? c : mine; }
        if (sum == G) break;
        __builtin_amdgcn_s_sleep(1);
        if ((++sp & 255u) == 0u) { if (xb_ld(&bar[XB_TMO])) break; if (sp > XB_SPIN_CAP) { atomicAdd(&bar[XB_TMO], 1u); break; } }
    }
    nloc = mine > 0u ? mine : 1u; nx = cnt > 0u ? cnt : 1u;
}

__device__ __forceinline__ void xcd_barrier(const XcdBarrier& b) {
    asm volatile("s_waitcnt vmcnt(0)" ::: "memory");
    __syncthreads();
    if (threadIdx.x == 0) {
        unsigned* bar = b.bar;
        __builtin_amdgcn_s_waitcnt(0);
        unsigned nloc = b.st[0], nx = b.st[1];
        if (nloc == 0u) { xcd_barrier_complete(bar, b.x, nloc, nx); b.st[0] = nloc; b.st[1] = nx; }
        const unsigned old = xb_add(&bar[XB_XSUB(b.x)], 1u);
        const unsigned gen = old / nloc;
        if (old + 1u == (gen + 1u) * nloc) {
            __builtin_amdgcn_fence(__ATOMIC_RELEASE, "agent");
            asm volatile("s_waitcnt vmcnt(0)" ::: "memory");
            const unsigned og = xb_add(&bar[XB_TOP], 1u);
            const unsigned tg = og / nx;
            if (og + 1u == (tg + 1u) * nx) xb_add(&bar[XB_TOPGEN], 1u);
            else XB_SPIN(xb_ld(&bar[XB_TOPGEN]) == tg, bar);
            __builtin_amdgcn_fence(__ATOMIC_ACQUIRE, "agent");
            xb_add(&bar[XB_XGEN(b.x)], 1u);
            asm volatile("s_waitcnt vmcnt(0)" ::: "memory");
        } else {
            XB_SPIN(xb_ld(&bar[XB_XGEN(b.x)]) == gen, bar);
            __builtin_amdgcn_fence(__ATOMIC_ACQUIRE, "agent");
            asm volatile("s_waitcnt vmcnt(0)" ::: "memory");
        }
    }
    __syncthreads();
}
constexpr int NWAVES = 8;
constexpr int Bsz = 8, SEQ = 2048, D = 1024, T = Bsz * SEQ;
constexpr int INP = 3080, NPJ = 3072, OFF_DT = 1536, OFF_Q2 = 1544;
constexpr int NE = 32, CAP = T, PLE = 256, FF2 = 2048;
constexpr int PADROWS = 4 * T + NE * 256;
constexpr float LAM_INIT = 0.2f, EPS = 1e-6f;
constexpr size_t MiB = 1u << 20;
constexpr size_t WS_CTL = 0, CTL_ZERO_BYTES = 1 * MiB;
constexpr size_t WS_ROWTOK = 1 * MiB, WS_ROWGATE = 3 * MiB, WS_SLOT = 5 * MiB, WS_DT = 6 * MiB, WS_WR = 7 * MiB;
constexpr size_t WS_WIN = 8 * MiB, WS_WOUT = 14 * MiB, WS_WG = 16 * MiB, WS_WP = 18 * MiB, WS_WUP = 20 * MiB, WS_WDN = 148 * MiB;
constexpr size_t WS_H = 212 * MiB, WS_PJ = 244 * MiB, WS_O = 340 * MiB, WS_YC = 372 * MiB, WS_X1 = 404 * MiB, WS_X2 = 468 * MiB, WS_PP = 532 * MiB, WS_P16 = 564 * MiB;
constexpr size_t WS_ACT = 572 * MiB, WS_YS = 716 * MiB, WS_TMP = 860 * MiB, WS_END = 960 * MiB;
static_assert(WS_ACT + (size_t)PADROWS * 1024 * 2 <= WS_YS && WS_YS + (size_t)PADROWS * 1024 * 2 <= WS_TMP, "d_ws map");
constexpr int CW_TMO = 0, CW_CODE = 1, CW_CNT = 64  , CW_BAR = 4096;
constexpr int RING_OFF = 0, RING_BYTES = 131072, LDSCTL_OFF = RING_BYTES, MISC_OFF = LDSCTL_OFF + 320, MTS_OFF = LDSCTL_OFF + 512, GTAB_OFF = LDSCTL_OFF + 1024, GTAB_UNITS = 10;
constexpr int LDS_BYTES = 147456;
static_assert(GTAB_OFF + GTAB_UNITS * 1024 <= LDS_BYTES, "LDS map");
__device__ __forceinline__ float wave_sum(float v) {
#pragma unroll
    for (int o = 1; o < 64; o <<= 1) v += __shfl_xor(v, o);
    return v;
}
__device__ __forceinline__ float bf2f(bf16 u) { return __uint_as_float((unsigned)u << 16); }
typedef unsigned u32x2 __attribute__((ext_vector_type(2)));

struct Args {
    const float *x, *p, *g_mix, *w_in, *conv_w, *conv_b, *dt_bias, *a_log, *d_skip, *ssd_norm_w, *lq1, *lk1, *lq2, *lk2, *subln_w, *w_out, *g_ffn, *w_router, *b_router,
                *w_up, *b_up, *w_down, *b_down, *g_ple, *w_ple_gate, *w_ple_proj, *g_final;
    float* out; unsigned char* ws; int ph_lo, ph_hi, use_bar, pad;
};

__device__ __forceinline__ void tr_item(const float* W, int ldw, int K, bf16* WT, int n0, int k0, int nrow0, LAS unsigned* scr, int lane) {
    const int n4 = (lane & 15) * 4, kr = lane >> 4;
    const float* src = W + (size_t)(k0 + kr * 2) * ldw + n0 + n4;
#pragma unroll
    for (int it = 0; it < 8; ++it) {
        const f32x4 a = *(const GAS f32x4*)(src + (size_t)(it * 8) * ldw);
        const f32x4 b = *(const GAS f32x4*)(src + (size_t)(it * 8 + 1) * ldw);
        const int kp = it * 4 + kr;
        scr[(n4 + 0) * 33 + kp] = pk2(a.x, b.x); scr[(n4 + 1) * 33 + kp] = pk2(a.y, b.y); scr[(n4 + 2) * 33 + kp] = pk2(a.z, b.z); scr[(n4 + 3) * 33 + kp] = pk2(a.w, b.w);
    }
    LDS_WAIT(); asm volatile("" ::: "memory");
    const int c = lane & 7;
#pragma unroll
    for (int it = 0; it < 8; ++it) { const int n = (lane >> 3) + 8 * it; const LAS unsigned* s = scr + n * 33 + c * 4;
        v4u o; o.x = s[0]; o.y = s[1]; o.z = s[2]; o.w = s[3];
        *(GAS v4u*)(WT + (size_t)(nrow0 + n) * K + k0 + 8 * c) = o; }
    LDS_WAIT(); asm volatile("" ::: "memory");
}
__device__ __forceinline__ void p0_prologue(const Args& a, LAS unsigned char* lds, int vcu, int G, int wave, int lane, int tid) {
    unsigned char* ws = a.ws;
    bf16* Win_t = (bf16*)(ws + WS_WIN); bf16* Wout_t = (bf16*)(ws + WS_WOUT); bf16* Wg_t = (bf16*)(ws + WS_WG); bf16* Wp_t = (bf16*)(ws + WS_WP); bf16* Wup_t = (bf16*)(ws + WS_WUP); bf16* Wdn_t = (bf16*)(ws + WS_WDN);
    LAS unsigned* scr = (LAS unsigned*)(lds + RING_OFF + wave * 8704);
    const int gw = vcu * NWAVES + wave, NGW = G * NWAVES;
    constexpr int I_IN = 16 * 24, I_SQ = 16 * 16, I_PP = 4 * 16, I_UP = 32 * 16 * 32, I_DN = 32 * 16 * 16;
    constexpr int NITEMS = 2 * I_IN + 2 * I_SQ + I_PP + I_UP + I_DN;
    for (int it = gw; it < NITEMS; it += NGW) {
        int r = it;
        if (r < I_UP) { const int e = r >> 9, q = r & 511; tr_item(a.w_up + (size_t)e * D * FF2, FF2, D, Wup_t + (size_t)e * FF2 * D, (q & 31) * 64, (q >> 5) * 64, (q & 31) * 64, scr, lane); continue; } r -= I_UP;
        if (r < I_DN) { const int e = r >> 8, q = r & 255; tr_item(a.w_down + (size_t)e * D * D, D, D, Wdn_t + (size_t)e * D * D, (q & 15) * 64, (q >> 4) * 64, (q & 15) * 64, scr, lane); continue; } r -= I_DN;
        if (r < I_IN) { tr_item(a.w_in, INP, D, Win_t, (r % 24) * 64, (r / 24) * 64, (r % 24) * 64, scr, lane); continue; } r -= I_IN;
        if (r < I_IN) { tr_item(a.w_in + OFF_Q2, INP, D, Win_t, (r % 24) * 64, (r / 24) * 64, 1536 + (r % 24) * 64, scr, lane); continue; } r -= I_IN;
        if (r < I_SQ) { tr_item(a.w_out, D, D, Wout_t, (r & 15) * 64, (r >> 4) * 64, (r & 15) * 64, scr, lane); continue; } r -= I_SQ;
        if (r < I_SQ) { tr_item(a.w_ple_gate, D, D, Wg_t, (r & 15) * 64, (r >> 4) * 64, (r & 15) * 64, scr, lane); continue; } r -= I_SQ;
        tr_item(a.w_ple_proj, D, PLE, Wp_t, (r & 15) * 64, (r >> 4) * 64, (r & 15) * 64, scr, lane);
    }
    { bf16* Wr_t = (bf16*)(ws + WS_WR); const int gt = vcu * (NWAVES * 64) + tid, NT_ = G * NWAVES * 64;
      for (int i = gt; i < NE * D; i += NT_) { const int n = i >> 10, k = i & 1023; Wr_t[i] = (bf16)f2bf(a.w_router[k * NE + n]); } }
    bf16* H = (bf16*)(ws + WS_H); float* DT = (float*)(ws + WS_DT);
    for (int m = gw; m < T; m += NGW) {
        const GAS f32x4* xr = (const GAS f32x4*)(a.x + (size_t)m * D) + lane;
        f32x4 v[4]; float s = 0.f;
#pragma unroll
        for (int j = 0; j < 4; ++j) { v[j] = xr[64 * j]; s += (v[j].x * v[j].x + v[j].y * v[j].y) + (v[j].z * v[j].z + v[j].w * v[j].w); }
        const float rs = 1.f / sqrtf(wave_sum(s) * (1.f / D) + EPS);
        GAS u32x2* o8 = (GAS u32x2*)(H + (size_t)m * D) + lane;
        float d[8];
#pragma unroll
        for (int h = 0; h < 8; ++h) d[h] = 0.f;
#pragma unroll
        for (int j = 0; j < 4; ++j) { const f32x4 gg = ((const GAS f32x4*)a.g_mix)[lane + 64 * j]; v[j] = v[j] * rs * gg;
            u32x2 w; w.x = pk2(v[j].x, v[j].y); w.y = pk2(v[j].z, v[j].w); o8[64 * j] = w;
#pragma unroll
            for (int i = 0; i < 4; ++i) { const float* wr = a.w_in + (size_t)(4 * lane + 256 * j + i) * INP + OFF_DT; const f32x4 w0 = *(const GAS f32x4*)wr, w1 = *(const GAS f32x4*)(wr + 4); const float hv = v[j][i];
                d[0] += hv * w0.x; d[1] += hv * w0.y; d[2] += hv * w0.z; d[3] += hv * w0.w; d[4] += hv * w1.x; d[5] += hv * w1.y; d[6] += hv * w1.z; d[7] += hv * w1.w; } }
#pragma unroll
        for (int h = 0; h < 8; ++h) d[h] = wave_sum(d[h]);
        if (lane < 8) { float mine = d[0];
#pragma unroll
            for (int h = 1; h < 8; ++h) mine = (lane == h) ? d[h] : mine;
            const float raw = mine + a.dt_bias[lane]; DT[(size_t)m * 8 + lane] = raw > 20.f ? raw : log1pf(expf(raw)); }
    }
    { bf16* P16 = (bf16*)(ws + WS_P16); const int gt = vcu * (NWAVES * 64) + tid, NT_ = G * NWAVES * 64;
      for (int i = gt; i < T * PLE / 8; i += NT_) { const f32x4 v0 = ((const GAS f32x4*)a.p)[2 * i], v1 = ((const GAS f32x4*)a.p)[2 * i + 1];
          v4u o; o.x = pk2(v0.x, v0.y); o.y = pk2(v0.z, v0.w); o.z = pk2(v1.x, v1.y); o.w = pk2(v1.z, v1.w); ((GAS v4u*)P16)[i] = o; } }
}

__device__ __forceinline__ void p5_router(const Args& a, LAS unsigned char* lds, int vcu, int G, int wave, int lane, int tid) {
    typedef float f32x16 __attribute__((ext_vector_type(16)));
    unsigned char* ws = a.ws;
    const float* X1 = (const float*)(ws + WS_X1); bf16* H = (bf16*)(ws + WS_H); const bf16* Wr_t = (const bf16*)(ws + WS_WR);
    int* cnt = (int*)(ws + WS_CTL) + CW_CNT; int* row_tok = (int*)(ws + WS_ROWTOK); float* row_gate = (float*)(ws + WS_ROWGATE); int* slot = (int*)(ws + WS_SLOT);
    for (int tile = vcu; tile < T / 64; tile += G) {
        for (int tt = 0; tt < 8; ++tt) {
            const int lr = wave * 8 + tt, m = tile * 64 + lr;
            const GAS f32x4* xr = (const GAS f32x4*)(X1 + (size_t)m * D) + lane;
            f32x4 v[4]; float s = 0.f;
#pragma unroll
            for (int j = 0; j < 4; ++j) { v[j] = xr[64 * j]; s += (v[j].x * v[j].x + v[j].y * v[j].y) + (v[j].z * v[j].z + v[j].w * v[j].w); }
            const float rs = 1.f / sqrtf(wave_sum(s) * (1.f / D) + EPS);
            GAS u32x2* o8 = (GAS u32x2*)(H + (size_t)m * D) + lane;
#pragma unroll
            for (int j = 0; j < 4; ++j) { const f32x4 gg = ((const GAS f32x4*)a.g_ffn)[lane + 64 * j]; const f32x4 hv = v[j] * rs * gg;
                u32x2 w; w.x = pk2(hv.x, hv.y); w.y = pk2(hv.z, hv.w); o8[64 * j] = w;
                const int chunk = (lane >> 1) + 32 * j;
                *(LAS u32x2*)(lds + lr * 2048 + ((chunk ^ (lr & 7)) << 4) + (lane & 1) * 8) = w; }
        }
        __syncthreads();
        const int r32 = lane & 31, hi = lane >> 5, mh = wave & 1, kq = wave >> 1;
        f32x16 acc = {};
#pragma unroll 4
        for (int st = 0; st < 16; ++st) { const int row = 32 * mh + r32, chunk = 2 * (kq * 16 + st) + hi;
            const bf16x8 af = *(const LAS bf16x8*)(lds + row * 2048 + ((chunk ^ (row & 7)) << 4));
            const bf16x8 bfr = *(const GAS bf16x8*)(Wr_t + (size_t)r32 * D + chunk * 8);
            acc = __builtin_amdgcn_mfma_f32_32x32x16_bf16(af, bfr, acc, 0, 0, 0); }
        __syncthreads();
        LAS float* part = (LAS float*)lds;
#pragma unroll
        for (int r = 0; r < 16; ++r) { const int row = (r & 3) + 8 * (r >> 2) + 4 * hi; part[(wave * 32 + row) * 33 + r32] = acc[r]; }
        __syncthreads();
        for (int rd = 0; rd < 4; ++rd) {
            const int lt = rd * 16 + (tid >> 5), e = tid & 31, mh2 = lt >> 5, lrow = lt & 31;
            float v = a.b_router[e];
#pragma unroll
            for (int q = 0; q < 4; ++q) v += part[((q * 2 + mh2) * 32 + lrow) * 33 + e];
            float tv[4]; int ti[4];
#pragma unroll
            for (int r = 0; r < 4; ++r) { float bv = v; int bi = e;
#pragma unroll
                for (int o = 16; o > 0; o >>= 1) { const float ov = __shfl_xor(bv, o); const int oi = __shfl_xor(bi, o); if (ov > bv || (ov == bv && oi < bi)) { bv = ov; bi = oi; } }
                tv[r] = bv; ti[r] = bi; if (e == bi) v = -INFINITY; }
            if (e == 0) { const int m = tile * 64 + lt; float ex[4], sm = 0.f;
#pragma unroll
                for (int r = 0; r < 4; ++r) { ex[r] = expf(tv[r] - tv[0]); sm += ex[r]; }
#pragma unroll
                for (int r = 0; r < 4; ++r) { const int pos = atomicAdd(&cnt[ti[r]], 1); row_tok[ti[r] * CAP + pos] = m; row_gate[ti[r] * CAP + pos] = ex[r] / sm; slot[(m * 4 + r) * 2] = ti[r]; slot[(m * 4 + r) * 2 + 1] = pos; } }
        }
        __syncthreads();
    }
}

__device__ __forceinline__ void moe_setup(const Args& a, LAS unsigned char* lds, int tid) {
    LAS int* mts = (LAS int*)(lds + MTS_OFF); const int* cnt = (const int*)(a.ws + WS_CTL) + CW_CNT;
    if (tid == 0) { int s = 0; for (int e = 0; e < NE; ++e) { mts[e] = s; s += (cnt[e] + 255) >> 8; } mts[NE] = s; }
    __syncthreads();
}
__device__ __forceinline__ void moe_gtab(const Args& a, LAS unsigned char* lds, int tid, int u0, int u1, int NN) {
    LAS int* mts = (LAS int*)(lds + MTS_OFF); LAS unsigned* gtab = (LAS unsigned*)(lds + GTAB_OFF);
    const int* cnt = (const int*)(a.ws + WS_CTL) + CW_CNT; const int* row_tok = (const int*)(a.ws + WS_ROWTOK);
    for (int i = 0; i < u1 - u0 && i < GTAB_UNITS; ++i) {
        const int mt = (u0 + i) / NN; int e = 0;
        for (int k = 1; k < 32; ++k) e += (mts[k] <= mt) ? 1 : 0;
        const int r0 = (mt - mts[e]) * 256, c = cnt[e];
        if (tid < 256) { const int r = r0 + tid; const int tok = (r < c) ? row_tok[e * CAP + r] : 0; gtab[i * 256 + tid] = (unsigned)tok * (unsigned)(D * 2); }
    }
    __syncthreads();
}

__device__ __forceinline__ void p8_combine(const Args& a, LAS unsigned char* lds, int vcu, int G, int wave, int lane) {
    unsigned char* ws = a.ws; LAS int* mts = (LAS int*)(lds + MTS_OFF);
    const float* X1 = (const float*)(ws + WS_X1); float* X2 = (float*)(ws + WS_X2); bf16* H = (bf16*)(ws + WS_H); const bf16* YS = (const bf16*)(ws + WS_YS); const int* slot = (const int*)(ws + WS_SLOT);
    const int gw = vcu * NWAVES + wave, NGW = G * NWAVES;
    for (int m = gw; m < T; m += NGW) {
        const GAS f32x4* xr = (const GAS f32x4*)(X1 + (size_t)m * D) + lane;
        f32x4 v[4];
#pragma unroll
        for (int j = 0; j < 4; ++j) v[j] = xr[64 * j];
#pragma unroll
        for (int r = 0; r < 4; ++r) { const int e = slot[(m * 4 + r) * 2], pos = slot[(m * 4 + r) * 2 + 1]; const size_t prow = (size_t)mts[e] * 256 + pos;
            const GAS u32x2* yr = (const GAS u32x2*)(YS + prow * D) + lane;
#pragma unroll
            for (int j = 0; j < 4; ++j) { const u32x2 w = yr[64 * j]; v[j].x += __uint_as_float(w.x << 16); v[j].y += __uint_as_float(w.x & 0xffff0000u); v[j].z += __uint_as_float(w.y << 16); v[j].w += __uint_as_float(w.y & 0xffff0000u); } }
        float s = 0.f;
        GAS f32x4* xo = (GAS f32x4*)(X2 + (size_t)m * D) + lane;
#pragma unroll
        for (int j = 0; j < 4; ++j) { xo[64 * j] = v[j]; s += (v[j].x * v[j].x + v[j].y * v[j].y) + (v[j].z * v[j].z + v[j].w * v[j].w); }
        const float rs = 1.f / sqrtf(wave_sum(s) * (1.f / D) + EPS);
        GAS u32x2* o8 = (GAS u32x2*)(H + (size_t)m * D) + lane;
#pragma unroll
        for (int j = 0; j < 4; ++j) { const f32x4 gg = ((const GAS f32x4*)a.g_ple)[lane + 64 * j]; const f32x4 hv = v[j] * rs * gg; u32x2 w; w.x = pk2(hv.x, hv.y); w.y = pk2(hv.z, hv.w); o8[64 * j] = w; }
    }
}
__device__ __forceinline__ void p10_final(const Args& a, int vcu, int G, int wave, int lane) {
    const float* X3 = (const float*)(a.ws + WS_X2);
    const int gw = vcu * NWAVES + wave, NGW = G * NWAVES;
    for (int m = gw; m < T; m += NGW) {
        const GAS f32x4* xr = (const GAS f32x4*)(X3 + (size_t)m * D) + lane;
        f32x4 v[4]; float s = 0.f;
#pragma unroll
        for (int j = 0; j < 4; ++j) { v[j] = xr[64 * j]; s += (v[j].x * v[j].x + v[j].y * v[j].y) + (v[j].z * v[j].z + v[j].w * v[j].w); }
        const float rs = 1.f / sqrtf(wave_sum(s) * (1.f / D) + EPS);
        GAS f32x4* o = (GAS f32x4*)(a.out + (size_t)m * D) + lane;
#pragma unroll
        for (int j = 0; j < 4; ++j) { const f32x4 gg = ((const GAS f32x4*)a.g_final)[lane + 64 * j]; o[64 * j] = v[j] * rs * gg; }
    }
}


__device__ __forceinline__ float siluf(float v) { return v / (1.f + __expf(-v)); }
__device__ __forceinline__ void p2_conv(const Args& a, int vcu, int G, int tid) {
    const bf16* PJ = (const bf16*)(a.ws + WS_PJ); float* xbc = (float*)(a.ws + WS_TMP);
    const int gt = vcu * (NWAVES * 64) + tid, NT_ = G * NWAVES * 64;
    for (int idx = gt; idx < T * 1024; idx += NT_) { const int t = idx >> 10, c = idx & 1023; const int s = t & (SEQ - 1);
        float acc = a.conv_b[c];
#pragma unroll
        for (int j = 0; j < 4; ++j) { const int ss = s - 3 + j; if (ss >= 0) acc += a.conv_w[j * 1024 + c] * bf2f(PJ[(size_t)(t - 3 + j) * NPJ + 512 + c]); }
        xbc[idx] = siluf(acc); }
}
__device__ __forceinline__ void p3_ssd_seq(const Args& a, int vcu, int tid) {
    if (vcu >= 64) return;
    const float* DT = (const float*)(a.ws + WS_DT); const float* xbc = (const float*)(a.ws + WS_TMP); float* yraw = (float*)(a.ws + WS_TMP + 64 * MiB);
    const int b = vcu >> 3, h = vcu & 7, g = h >> 2, p = tid >> 3, nq = tid & 7;
    const float av = -expf(a.a_log[h]), dsk = a.d_skip[h];
    float st[16];
#pragma unroll
    for (int i = 0; i < 16; ++i) st[i] = 0.f;
    for (int s = 0; s < SEQ; ++s) {
        const size_t t = (size_t)b * SEQ + s;
        const float dtv = DT[t * 8 + h], dec = expf(av * dtv);
        const float xv = xbc[t * 1024 + h * 64 + p], xd = xv * dtv;
        const GAS f32x4* Bv = (const GAS f32x4*)(xbc + t * 1024 + 512 + g * 128 + nq * 16);
        const GAS f32x4* Cv = (const GAS f32x4*)(xbc + t * 1024 + 768 + g * 128 + nq * 16);
        float y = 0.f;
#pragma unroll
        for (int i = 0; i < 4; ++i) { const f32x4 bb = Bv[i], cc = Cv[i];
            st[4 * i + 0] = st[4 * i + 0] * dec + xd * bb.x; y += cc.x * st[4 * i + 0];
            st[4 * i + 1] = st[4 * i + 1] * dec + xd * bb.y; y += cc.y * st[4 * i + 1];
            st[4 * i + 2] = st[4 * i + 2] * dec + xd * bb.z; y += cc.z * st[4 * i + 2];
            st[4 * i + 3] = st[4 * i + 3] * dec + xd * bb.w; y += cc.w * st[4 * i + 3]; }
        y += __shfl_xor(y, 1); y += __shfl_xor(y, 2); y += __shfl_xor(y, 4);
        if (nq == 0) yraw[t * 512 + h * 64 + p] = y + dsk * xv;
    }
}
__device__ __forceinline__ void p4_mixer_post(const Args& a, int vcu, int G, int wave, int lane) {
    const bf16* PJ = (const bf16*)(a.ws + WS_PJ); const float* yraw = (const float*)(a.ws + WS_TMP + 64 * MiB); bf16* YC = (bf16*)(a.ws + WS_YC); const bf16* O = (const bf16*)(a.ws + WS_O);
    const int gw = vcu * NWAVES + wave, NGW = G * NWAVES;
    for (int w = gw; w < T * 2; w += NGW) { const int t = w >> 1, g = w & 1;
        float v[4]; float s = 0.f;
#pragma unroll
        for (int j = 0; j < 4; ++j) { const int c = g * 256 + lane + 64 * j; const float z = bf2f(PJ[(size_t)t * NPJ + c]); v[j] = yraw[(size_t)t * 512 + c] * siluf(z); s += v[j] * v[j]; }
        const float r = 1.f / sqrtf(wave_sum(s) * (1.f / 256.f) + 1e-5f);
#pragma unroll
        for (int j = 0; j < 4; ++j) { const int c = g * 256 + lane + 64 * j; YC[(size_t)t * 1024 + c] = (bf16)f2bf(v[j] * r * a.ssd_norm_w[c]); } }
    const float lam = expf(wave_sum(a.lq1[lane] * a.lk1[lane])) - expf(wave_sum(a.lq2[lane] * a.lk2[lane])) + LAM_INIT;
    for (int w = gw; w < T * 4; w += NGW) { const int t = w >> 2, h = w & 3;
        const bf16* o = O + (size_t)t * 1024 + h * 256;
        const float a0 = bf2f(o[lane]) - lam * bf2f(o[128 + lane]), a1 = bf2f(o[64 + lane]) - lam * bf2f(o[192 + lane]);
        const float r = (1.f - LAM_INIT) / sqrtf(wave_sum(a0 * a0 + a1 * a1) * (1.f / 128.f) + 1e-5f);
        YC[(size_t)t * 1024 + 512 + h * 128 + lane] = (bf16)f2bf(a0 * r * a.subln_w[lane]);
        YC[(size_t)t * 1024 + 512 + h * 128 + 64 + lane] = (bf16)f2bf(a1 * r * a.subln_w[64 + lane]); }
}

constexpr int NPHASE = 12;
__global__ void __launch_bounds__(NWAVES * 64, 2) mk_fwd(Args a) {
    extern __shared__ __attribute__((aligned(16))) unsigned char lds_raw[];
    LAS unsigned char* lds = (LAS unsigned char*)lds_raw;
    const int tid = threadIdx.x, lane = tid & 63, wave = __builtin_amdgcn_readfirstlane(tid >> 6);
    const int G = gridDim.x; const int bx = blockIdx.x; const int vcu = (G % 8 == 0) ? (bx % 8) * (G / 8) + bx / 8 : bx;
    unsigned char* ws = a.ws; gu32* ctl = (gu32*)(ws + WS_CTL);
    for (int u = tid; u < (LDS_BYTES - LDSCTL_OFF) / 4; u += NWAVES * 64) ((LAS unsigned*)(lds + LDSCTL_OFF))[u] = 0u;
    __syncthreads();
    volatile LAS unsigned* MISC = (volatile LAS unsigned*)(lds + MISC_OFF);
    XcdBarrier bar; bar.bar = (unsigned*)(ctl + CW_BAR); bar.x = 0; bar.st = nullptr;
    if (a.use_bar) bar = xcd_barrier_post((unsigned*)(ctl + CW_BAR), MISC + 8);
    const int lo = a.ph_lo, hi = a.ph_hi;
#define IN(k) (lo <= (k) && (k) < hi)
#define SEAM(k) do { if (IN(k) && IN((k) + 1)) xcd_barrier(bar); } while (0)
    const LAS unsigned* gtab = (const LAS unsigned*)(lds + GTAB_OFF);
    bf16* H = (bf16*)(ws + WS_H); bf16* PJ = (bf16*)(ws + WS_PJ);

    if (IN(0)) { p0_prologue(a, lds, vcu, G, wave, lane, tid); SEAM(0); }
    if (IN(1)) {
        { pg8::DenseOrder S; S.init(H, ws + WS_WIN, T, NPJ, D, G, bx); pg8::EpiBf16S E{PJ, NPJ, 6, 8, attn_body::C2};
          pg8::gemm_phase<pg8::EpiBf16S, pg8::DenseOrder, false, true, true>(lds + RING_OFF, D, S, E, gtab); }
        { pg8::DenseOrder S; S.init(ws + WS_P16, ws + WS_WP, T, D, PLE, G, bx); pg8::EpiBf16S E{(bf16*)(ws + WS_PP), D, 0, 0, 1.f};
          pg8::gemm_phase<pg8::EpiBf16S, pg8::DenseOrder, false, true, true>(lds + RING_OFF, PLE, S, E, gtab); }
        SEAM(1);
    }
    if (IN(2)) {
        p2_conv(a, vcu, G, tid);
        const attn_body::AttnTensors AT{(const attn_body::bf16*)PJ, (attn_body::bf16*)(ws + WS_O)};
        const attn_body::StaticOrder S(vcu);
        attn_body::attn_phase<attn_body::StaticOrder>((char*)lds_raw + RING_OFF, AT, S);
        SEAM(2);
    }
    if (IN(3)) { p3_ssd_seq(a, vcu, tid); SEAM(3); }
    if (IN(4)) { p4_mixer_post(a, vcu, G, wave, lane); SEAM(4); }
    if (IN(5)) {
        pg8::DenseOrder S; S.init(ws + WS_YC, ws + WS_WOUT, T, D, D, G, bx); pg8::EpiResF32 E{a.x, (float*)(ws + WS_X1), D};
        pg8::gemm_phase<pg8::EpiResF32, pg8::DenseOrder, false, false, true>(lds + RING_OFF, D, S, E, gtab);
        SEAM(5);
    }
    if (IN(6)) { p5_router(a, lds, vcu, G, wave, lane, tid); SEAM(6); }
    if (IN(7)) {
        moe_setup(a, lds, tid);
        const LAS int* mts = (const LAS int*)(lds + MTS_OFF); const int NN = FF2 / 256, U = mts[NE] * NN;
        const int u0 = (int)((long)vcu * U / G), u1 = (int)((long)(vcu + 1) * U / G);
        moe_gtab(a, lds, tid, u0, u1, NN);
        pg8::MoeOrder S{mts, (const char*)H, (const char*)(ws + WS_WUP), (size_t)256 * D * 2, (size_t)FF2 * D * 2, NN, u0, u1, 1};
        pg8::EpiMoeUp E{(bf16*)(ws + WS_ACT), a.b_up};
        pg8::gemm_phase<pg8::EpiMoeUp, pg8::MoeOrder, true, true, true>(lds + RING_OFF, D, S, E, gtab);
        SEAM(7);
    }
    if (IN(8)) {
        moe_setup(a, lds, tid);
        const LAS int* mts = (const LAS int*)(lds + MTS_OFF); const int NN = D / 256, U = mts[NE] * NN;
        const int u0 = (int)((long)vcu * U / G), u1 = (int)((long)(vcu + 1) * U / G);
        pg8::MoeOrder S{mts, (const char*)(ws + WS_ACT), (const char*)(ws + WS_WDN), (size_t)256 * D * 2, (size_t)D * D * 2, NN, u0, u1, 0};
        pg8::EpiMoeDown E{(bf16*)(ws + WS_YS), a.b_down, (const float*)(ws + WS_ROWGATE)};
        pg8::gemm_phase<pg8::EpiMoeDown, pg8::MoeOrder, false, true, true>(lds + RING_OFF, D, S, E, gtab);
        SEAM(8);
    }
    if (IN(9)) { moe_setup(a, lds, tid); p8_combine(a, lds, vcu, G, wave, lane); SEAM(9); }
    if (IN(10)) {
        pg8::DenseOrder S; S.init(H, ws + WS_WG, T, D, D, G, bx); pg8::EpiPle E{(const float*)(ws + WS_X2), (const bf16*)(ws + WS_PP), (float*)(ws + WS_X2), D};
        pg8::gemm_phase<pg8::EpiPle, pg8::DenseOrder, false, false, true>(lds + RING_OFF, D, S, E, gtab);
        SEAM(10);
    }
    if (IN(11)) { p10_final(a, vcu, G, wave, lane); }
#undef IN
#undef SEAM
}

extern "C" void kernel_launch(void* const* d_in, const int* in_sizes, int n_in, void* d_out, int out_size, void* d_ws, size_t ws_size, hipStream_t stream) {
    static int grid = 0;
    if (grid == 0) {
        int dev = 0, cus = 0, per_cu = 0;
        if (n_in != 27 || out_size != T * D || ws_size < WS_END) { fprintf(stderr, "kernel_launch: unexpected shapes (n_in %d out %d ws %zu)\n", n_in, out_size, ws_size); grid = -1; return; }
        if (hipGetDevice(&dev) != hipSuccess || hipDeviceGetAttribute(&cus, hipDeviceAttributeMultiprocessorCount, dev) != hipSuccess) { grid = -1; return; }
        if (hipFuncSetAttribute((const void*)mk_fwd, hipFuncAttributeMaxDynamicSharedMemorySize, LDS_BYTES) != hipSuccess) { fprintf(stderr, "kernel_launch: hipFuncSetAttribute failed\n"); grid = -1; return; }
        if (hipOccupancyMaxActiveBlocksPerMultiprocessor(&per_cu, (const void*)mk_fwd, NWAVES * 64, LDS_BYTES) != hipSuccess || per_cu < 1) { fprintf(stderr, "kernel_launch: occupancy query says %d blocks per CU\n", per_cu); (void)hipGetLastError(); grid = -1; return; }
        grid = cus;
    }
    if (grid < 0) return;
    if (hipMemsetAsync((char*)d_ws + WS_CTL, 0, CTL_ZERO_BYTES, stream) != hipSuccess) return;
    Args a{};
    const float** ap = (const float**)&a;
    for (int i = 0; i < 27; ++i) ap[i] = (const float*)d_in[i];
    a.out = (float*)d_out; a.ws = (unsigned char*)d_ws; a.use_bar = 0; a.pad = 0;
    a.use_bar = 1; a.ph_lo = 0; a.ph_hi = NPHASE;
    hipLaunchKernelGGL(mk_fwd, dim3(grid), dim3(NWAVES * 64), LDS_BYTES, stream, a);
}
```

```cpp
#include <hip/hip_runtime.h>
#include <cstdio>
#include <cstdint>
namespace pg8 {
#define PG8_LAS __attribute__((address_space(3)))
typedef unsigned short bf16_t;
typedef short bf16x8 __attribute__((ext_vector_type(8)));
typedef float f32x4 __attribute__((ext_vector_type(4)));
typedef unsigned u32x4 __attribute__((ext_vector_type(4)));
constexpr int BM = 256, BK = 64, HALF = 128, HTB = HALF * BK * 2  , STAGE_BYTES = 8 * HTB, NXCD = 8, WGM = 8;

__host__ __device__ __forceinline__ int lds_byte(int r, int c) { const int st = (r >> 4) * 2 + (c >> 5), rr = r & 15, cc = c & 31, ob = rr * 64 + cc * 2; return st * 1024 + (ob ^ (((ob >> 9) & 1) << 5)); }
__host__ __device__ __forceinline__ void stage_rc(int b, int& R, int& C) { const int st = b / 1024, sb = b % 1024, swz = sb ^ (((sb >> 9) & 1) << 5); R = (st >> 1) * 16 + swz / 64; C = (st & 1) * 32 + (swz % 64) / 2; }
__host__ __device__ __forceinline__ int perm32(int rho) { const int n = rho >> 4, i = rho & 15; return 8 * (i >> 2) + 4 * n + (i & 3); }


struct Unit { int pm, pn, e, r0; };
__device__ __forceinline__ unsigned cvt_pk_bf16(float lo, float hi) { unsigned r; asm volatile("v_cvt_pk_bf16_f32 %0, %1, %2" : "=v"(r) : "v"(lo), "v"(hi)); return r; }

struct DenseOrder {
    const char* A; const char* Bt; size_t tstep; int nM, nN, nwg, G, c;
    __device__ __forceinline__ void init(const void* A_, const void* Bt_, int M, int N, int K, int G_, int c_) { A = (const char*)A_; Bt = (const char*)Bt_; tstep = (size_t)BM * K * 2; nM = M / BM; nN = N / BM; nwg = nM * nN; G = G_; c = c_; }
    __device__ __forceinline__ bool next(int i, Unit& u) const {
        const long L = (long)i * G + c; if (L >= nwg) return false;
        int wgid = (int)L; { const int q = nwg / NXCD, r = nwg % NXCD, xcd = wgid % NXCD, off = wgid / NXCD; wgid = (xcd < r ? xcd * (q + 1) : r * (q + 1) + (xcd - r) * q) + off; }
        const int nig = WGM * nN, gid = wgid / nig, fm = gid * WGM, gsz = (nM - fm) < WGM ? (nM - fm) : WGM;
        u.pm = fm + ((wgid % nig) % gsz); u.pn = (wgid % nig) / gsz; u.e = 0; u.r0 = 0; return true;
    }
    __device__ __forceinline__ const char* a_ptr(const Unit& u) const { return A + (size_t)u.pm * tstep; }
    __device__ __forceinline__ const char* b_ptr(const Unit& u) const { return Bt + (size_t)u.pn * tstep; }
    __device__ __forceinline__ void a_ready(const Unit&) const {}
    __device__ __forceinline__ void done(const Unit&) const {}
};
struct MoeOrder {
    const PG8_LAS int* mts; const char* A; const char* Bt; size_t tstep, bexp; int NN, u0, u1, gather;
    __device__ __forceinline__ bool next(int i, Unit& u) const {
        const int idx = u0 + i; if (idx >= u1) return false;
        const int mt = idx / NN; u.pn = idx - mt * NN; u.pm = mt;
        int e = 0;
        for (int k = 1; k < 32; ++k) e += (__builtin_amdgcn_readfirstlane(mts[k]) <= mt) ? 1 : 0;
        u.e = e; u.r0 = (mt - __builtin_amdgcn_readfirstlane(mts[e])) * BM; return true;
    }
    __device__ __forceinline__ const char* a_ptr(const Unit& u) const { return gather ? A : A + (size_t)u.pm * tstep; }
    __device__ __forceinline__ const char* b_ptr(const Unit& u) const { return Bt + (size_t)u.e * bexp + (size_t)u.pn * tstep; }
    __device__ __forceinline__ void a_ready(const Unit&) const {}
    __device__ __forceinline__ void done(const Unit&) const {}
};

struct EpiBf16S {
    static constexpr bool PERM = true, AFTER_DRAIN = false;
    bf16_t* O; int ldc; int st0, st1; float scale;
    __device__ __forceinline__ void operator()(const f32x4 (&acc)[2][2][4][2], const Unit& u, int wr, int wc, int fr, int fq) const {
        const int row0 = u.pm * BM + wr * 64 + fr, col0 = u.pn * BM + wc * 32 + 8 * fq;
        const float sc = (u.pn >= st0 && u.pn < st1) ? scale : 1.f;
#pragma unroll
        for (int ai = 0; ai < 2; ++ai)
#pragma unroll
            for (int m = 0; m < 4; ++m) { bf16_t* rowp = O + (size_t)(row0 + ai * HALF + m * 16) * ldc + col0;
#pragma unroll
                for (int bj = 0; bj < 2; ++bj) { const f32x4 v0 = acc[ai][bj][m][0] * sc, v1 = acc[ai][bj][m][1] * sc;
                    u32x4 w; w.x = cvt_pk_bf16(v0[0], v0[1]); w.y = cvt_pk_bf16(v0[2], v0[3]); w.z = cvt_pk_bf16(v1[0], v1[1]); w.w = cvt_pk_bf16(v1[2], v1[3]);
                    *(u32x4*)(rowp + bj * HALF) = w; } }
    }
};
struct EpiResF32 {
    static constexpr bool PERM = false, AFTER_DRAIN = false;
    const float* base; float* out; int ldc;
    __device__ __forceinline__ void operator()(const f32x4 (&acc)[2][2][4][2], const Unit& u, int wr, int wc, int fr, int fq) const {
        const int row0 = u.pm * BM + wr * 64 + fr, col0 = u.pn * BM + wc * 32 + 4 * fq;
#pragma unroll
        for (int ai = 0; ai < 2; ++ai)
#pragma unroll
            for (int m = 0; m < 4; ++m) { const size_t off = (size_t)(row0 + ai * HALF + m * 16) * ldc + col0;
#pragma unroll
                for (int bj = 0; bj < 2; ++bj)
#pragma unroll
                    for (int n = 0; n < 2; ++n) { const f32x4 b = *(const f32x4*)(base + off + bj * HALF + n * 16); *(f32x4*)(out + off + bj * HALF + n * 16) = b + acc[ai][bj][m][n]; } }
    }
};
__device__ __forceinline__ float sigm_fast(float v) { return __builtin_amdgcn_rcpf(1.f + __builtin_amdgcn_exp2f(-1.4426950408889634f * v)); }
struct EpiPle {
    static constexpr bool PERM = false, AFTER_DRAIN = false;
    const float* base; const bf16_t* pp; float* out; int ldc;
    __device__ __forceinline__ void operator()(const f32x4 (&acc)[2][2][4][2], const Unit& u, int wr, int wc, int fr, int fq) const {
        typedef unsigned u32x2 __attribute__((ext_vector_type(2)));
        const int row0 = u.pm * BM + wr * 64 + fr, col0 = u.pn * BM + wc * 32 + 4 * fq;
#pragma unroll
        for (int ai = 0; ai < 2; ++ai)
#pragma unroll
            for (int m = 0; m < 4; ++m) { const size_t off = (size_t)(row0 + ai * HALF + m * 16) * ldc + col0;
#pragma unroll
                for (int bj = 0; bj < 2; ++bj)
#pragma unroll
                    for (int n = 0; n < 2; ++n) { const size_t o2 = off + bj * HALF + n * 16; const f32x4 b = *(const f32x4*)(base + o2); const u32x2 pw = *(const u32x2*)(pp + o2); const f32x4 a = acc[ai][bj][m][n];
                        f32x4 r; r[0] = b[0] + __uint_as_float(pw.x << 16) * sigm_fast(a[0]); r[1] = b[1] + __uint_as_float(pw.x & 0xffff0000u) * sigm_fast(a[1]);
                        r[2] = b[2] + __uint_as_float(pw.y << 16) * sigm_fast(a[2]); r[3] = b[3] + __uint_as_float(pw.y & 0xffff0000u) * sigm_fast(a[3]);
                        *(f32x4*)(out + o2) = r; } }
    }
};
struct EpiMoeUp {
    static constexpr bool PERM = true, AFTER_DRAIN = false;
    bf16_t* act; const float* bias;
    __device__ __forceinline__ void operator()(const f32x4 (&acc)[2][2][4][2], const Unit& u, int wr, int wc, int fr, int fq) const {
        typedef unsigned u32x2 __attribute__((ext_vector_type(2)));
        const int row0 = u.pm * BM + wr * 64 + fr, col0 = u.pn * BM + wc * 32 + 8 * fq;
        const float* bp = bias + (size_t)u.e * 2048 + col0;
        f32x4 bv[2][2];
#pragma unroll
        for (int bj = 0; bj < 2; ++bj)
#pragma unroll
            for (int n = 0; n < 2; ++n) bv[bj][n] = *(const f32x4*)(bp + bj * HALF + 4 * n);
#pragma unroll
        for (int ai = 0; ai < 2; ++ai)
#pragma unroll
            for (int m = 0; m < 4; ++m) { bf16_t* rowp = act + (size_t)(row0 + ai * HALF + m * 16) * 1024 + (col0 >> 1);
#pragma unroll
                for (int bj = 0; bj < 2; ++bj) { const f32x4 v0 = acc[ai][bj][m][0] + bv[bj][0], v1 = acc[ai][bj][m][1] + bv[bj][1];
                    float o[4];
#pragma unroll
                    for (int q = 0; q < 4; ++q) { const float g = fminf(q < 2 ? v0[2 * q] : v1[2 * q - 4], 7.f); const float up = fminf(fmaxf(q < 2 ? v0[2 * q + 1] : v1[2 * q - 3], -7.f), 7.f);
                        o[q] = (up + 1.f) * g * sigm_fast(1.702f * g); }
                    u32x2 w; w.x = cvt_pk_bf16(o[0], o[1]); w.y = cvt_pk_bf16(o[2], o[3]);
                    *(u32x2*)(rowp + bj * (HALF / 2)) = w; } }
    }
};
struct EpiMoeDown {
    static constexpr bool PERM = true, AFTER_DRAIN = false;
    bf16_t* ys; const float* bias; const float* row_gate;
    __device__ __forceinline__ void operator()(const f32x4 (&acc)[2][2][4][2], const Unit& u, int wr, int wc, int fr, int fq) const {
        const int lrow0 = wr * 64 + fr, col0 = u.pn * BM + wc * 32 + 8 * fq;
        const float* bp = bias + (size_t)u.e * 1024 + col0; const float* gp = row_gate + (size_t)u.e * 16384 + u.r0;
        f32x4 bv[2][2];
#pragma unroll
        for (int bj = 0; bj < 2; ++bj)
#pragma unroll
            for (int n = 0; n < 2; ++n) bv[bj][n] = *(const f32x4*)(bp + bj * HALF + 4 * n);
#pragma unroll
        for (int ai = 0; ai < 2; ++ai)
#pragma unroll
            for (int m = 0; m < 4; ++m) { const int lr = lrow0 + ai * HALF + m * 16; const float g = gp[lr]; bf16_t* rowp = ys + (size_t)(u.pm * BM + lr) * 1024 + col0;
#pragma unroll
                for (int bj = 0; bj < 2; ++bj) { const f32x4 v0 = (acc[ai][bj][m][0] + bv[bj][0]) * g, v1 = (acc[ai][bj][m][1] + bv[bj][1]) * g;
                    u32x4 w; w.x = cvt_pk_bf16(v0[0], v0[1]); w.y = cvt_pk_bf16(v0[2], v0[3]); w.z = cvt_pk_bf16(v1[0], v1[1]); w.w = cvt_pk_bf16(v1[2], v1[3]);
                    *(u32x4*)(rowp + bj * HALF) = w; } }
    }
};

template <class Epi, class Sched, bool GATHER = false, bool ALIGN_EPI = false, bool SP2 = false>
__device__ __forceinline__ void gemm_phase(PG8_LAS unsigned char* lds, const int K, const Sched& S, const Epi& E, const PG8_LAS unsigned* gtab) {
    const int tid = threadIdx.x, wid = __builtin_amdgcn_readfirstlane(tid >> 6), lane = tid & 63, wr = wid >> 2, wc = wid & 3, fr = lane & 15, fq = lane >> 4;
    const int nt = K / BK;
    unsigned voffA[2][2], voffB[2];
#pragma unroll
    for (int i = 0; i < 2; ++i) { int R, C; stage_rc(tid * 16 + i * 8192, R, C); const int Rb = Epi::PERM ? ((R & ~31) + perm32(R & 31)) : R;
        voffA[0][i] = (unsigned)(R * K + C) * 2u; voffA[1][i] = (unsigned)((R + HALF) * K + C) * 2u; voffB[i] = (unsigned)(Rb * K + C) * 2u; }
#define PG8_GLOAD(UI) do { _Pragma("unroll") for (int _i = 0; _i < 2; ++_i) { int R_, C_; stage_rc(tid * 16 + _i * 8192, R_, C_); \
        voffA[0][_i] = gtab[(UI) * 256 + R_] + (unsigned)C_ * 2u; voffA[1][_i] = gtab[(UI) * 256 + HALF + R_] + (unsigned)C_ * 2u; } } while (0)
    const size_t kstep = (size_t)(BK * 2);
    const size_t hstep = (size_t)HALF * K * 2;
    const size_t tstep = 2 * hstep;
    const unsigned ldsw = (unsigned)wid * 1024u;
    const int aoff = lds_byte(wr * 64 + fr, fq * 8), boff = lds_byte(wc * 32 + fr, fq * 8);
#define PG8_SA(b, h) (((b) * 2 + (h)) * HTB)
#define PG8_SB(b, h) ((4 + (b) * 2 + (h)) * HTB)
#define PG8_STAGE(bufoff, gbase, voff) do { _Pragma("unroll") for (int _i = 0; _i < 2; ++_i) \
        __builtin_amdgcn_global_load_lds((const unsigned*)((const char*)(gbase) + (voff)[_i]), (PG8_LAS unsigned*)(lds + (bufoff) + ldsw + _i * 8192), 16, 0, 0); } while (0)
#define PG8_LDA(dst, b, h) do { _Pragma("unroll") for (int m = 0; m < 4; ++m) _Pragma("unroll") for (int k = 0; k < 2; ++k) dst[m][k] = *(const PG8_LAS bf16x8*)(lds + PG8_SA(b, h) + aoff + m * 2048 + k * 1024); } while (0)
#define PG8_LDB(dst, b, h) do { _Pragma("unroll") for (int n = 0; n < 2; ++n) _Pragma("unroll") for (int k = 0; k < 2; ++k) dst[n][k] = *(const PG8_LAS bf16x8*)(lds + PG8_SB(b, h) + boff + n * 2048 + k * 1024); } while (0)
#define PG8_MMA(ai, bj, At, Bt) do { __builtin_amdgcn_s_setprio(1); _Pragma("unroll") for (int m = 0; m < 4; ++m) _Pragma("unroll") for (int n = 0; n < 2; ++n) _Pragma("unroll") for (int k = 0; k < 2; ++k) \
        acc[ai][bj][m][n] = __builtin_amdgcn_mfma_f32_16x16x32_bf16(Bt[n][k], At[m][k], acc[ai][bj][m][n], 0, 0, 0); __builtin_amdgcn_s_setprio(0); } while (0)
#define PG8_WAIT_V(n) asm volatile("s_waitcnt vmcnt(" #n ")" ::: "memory")
#define PG8_WAIT_L(n) asm volatile("s_waitcnt lgkmcnt(" #n ")" ::: "memory")
#define PG8_BAR __builtin_amdgcn_s_barrier()
#define PG8_SCHED __builtin_amdgcn_sched_barrier(0)
    Unit cur, nxt; int ui = 0;
    if (!S.next(0, cur)) return;
    f32x4 acc[2][2][4][2];
#pragma unroll
    for (int a = 0; a < 2; ++a)
#pragma unroll
        for (int b = 0; b < 2; ++b)
#pragma unroll
            for (int m = 0; m < 4; ++m)
#pragma unroll
                for (int n = 0; n < 2; ++n) acc[a][b][m][n] = (f32x4){0.f, 0.f, 0.f, 0.f};
    bf16x8 At[4][2], B0[2][2], B1[2][2];
    const char* cA = S.a_ptr(cur); const char* cB = S.b_ptr(cur);
    if constexpr (GATHER) PG8_GLOAD(0);
    S.a_ready(cur);
    if constexpr (SP2) {
        PG8_STAGE(PG8_SB(0, 0), cB, voffB); PG8_STAGE(PG8_SB(0, 1), cB + hstep, voffB); PG8_STAGE(PG8_SA(0, 0), cA, voffA[0]); PG8_STAGE(PG8_SA(0, 1), cA, voffA[1]);
        if (wr == 1) PG8_BAR;
        PG8_WAIT_V(2); PG8_BAR;
        PG8_STAGE(PG8_SB(1, 0), cB + kstep, voffB); PG8_STAGE(PG8_SA(1, 0), cA + kstep, voffA[0]); PG8_STAGE(PG8_SB(1, 1), cB + hstep + kstep, voffB);
        PG8_WAIT_V(6); PG8_BAR;
    } else {
        PG8_STAGE(PG8_SB(0, 0), cB, voffB); PG8_STAGE(PG8_SA(0, 0), cA, voffA[0]); PG8_STAGE(PG8_SB(0, 1), cB + hstep, voffB); PG8_STAGE(PG8_SA(0, 1), cA, voffA[1]);
        if (wr == 1) PG8_BAR;
        PG8_WAIT_V(4); PG8_BAR;
        PG8_STAGE(PG8_SB(1, 0), cB + kstep, voffB); PG8_STAGE(PG8_SA(1, 0), cA + kstep, voffA[0]); PG8_STAGE(PG8_SB(1, 1), cB + hstep + kstep, voffB);
        PG8_WAIT_V(6); PG8_BAR;
    }
    for (;;) {
        const bool has_next = S.next(ui + 1, nxt);
        const char* nA = has_next ? S.a_ptr(nxt) : cA; const char* nB = has_next ? S.b_ptr(nxt) : cB;
        for (int t = 0; t < nt; t += 2) {
            const bool last = (t == nt - 2);
            const char* a1 = cA + (size_t)(t + 1) * kstep;
            const char* a2 = last ? nA : cA + (size_t)(t + 2) * kstep; const char* b2 = last ? nB : cB + (size_t)(t + 2) * kstep;
            const char* a3 = a2 + kstep; const char* b3 = b2 + kstep;
            if (last && has_next) S.a_ready(nxt);
            if constexpr (SP2) {
            PG8_LDB(B0, 0, 0); PG8_LDB(B1, 0, 1); PG8_SCHED; PG8_LDA(At, 0, 0); PG8_STAGE(PG8_SA(1, 1), a1, voffA[1]); if constexpr (GATHER) { if (last && has_next) PG8_GLOAD(ui + 1); }
            PG8_WAIT_V(8); PG8_WAIT_L(0); PG8_BAR; PG8_MMA(0, 0, At, B0); PG8_MMA(0, 1, At, B1); PG8_BAR; PG8_SCHED;
            PG8_LDA(At, 0, 1); PG8_STAGE(PG8_SB(0, 0), b2, voffB); PG8_STAGE(PG8_SB(0, 1), b2 + hstep, voffB); PG8_STAGE(PG8_SA(0, 0), a2, voffA[0]);
            PG8_WAIT_V(8); PG8_WAIT_L(0); PG8_BAR; PG8_MMA(1, 0, At, B0); PG8_MMA(1, 1, At, B1); PG8_BAR; PG8_SCHED;
            PG8_LDB(B0, 1, 0); PG8_LDB(B1, 1, 1); PG8_SCHED; PG8_LDA(At, 1, 0); PG8_STAGE(PG8_SA(0, 1), a2, voffA[1]);
            PG8_WAIT_V(8); PG8_WAIT_L(0); PG8_BAR; PG8_MMA(0, 0, At, B0); PG8_MMA(0, 1, At, B1); PG8_BAR; PG8_SCHED;
            PG8_LDA(At, 1, 1); PG8_STAGE(PG8_SB(1, 0), b3, voffB); PG8_STAGE(PG8_SB(1, 1), b3 + hstep, voffB); PG8_STAGE(PG8_SA(1, 0), a3, voffA[0]);
            PG8_WAIT_V(8); PG8_WAIT_L(0); PG8_BAR; PG8_MMA(1, 0, At, B0); PG8_MMA(1, 1, At, B1); PG8_BAR; PG8_SCHED;
            } else {
            PG8_LDB(B0, 0, 0); PG8_SCHED; PG8_LDA(At, 0, 0); PG8_STAGE(PG8_SA(1, 1), a1, voffA[1]); if constexpr (GATHER) { if (last && has_next) PG8_GLOAD(ui + 1); }
            PG8_WAIT_L(8); PG8_BAR; PG8_WAIT_L(0); PG8_MMA(0, 0, At, B0); PG8_BAR; PG8_SCHED;
            PG8_LDB(B1, 0, 1); PG8_STAGE(PG8_SB(0, 0), b2, voffB);
            PG8_BAR; PG8_WAIT_L(0); PG8_MMA(0, 1, At, B1); PG8_BAR;
            PG8_LDA(At, 0, 1); PG8_STAGE(PG8_SA(0, 0), a2, voffA[0]);
            PG8_BAR; PG8_WAIT_L(0); PG8_MMA(1, 0, At, B0); PG8_BAR; PG8_SCHED;
            PG8_STAGE(PG8_SB(0, 1), b2 + hstep, voffB);
            PG8_WAIT_V(6); PG8_BAR; PG8_MMA(1, 1, At, B1); PG8_BAR;
            PG8_LDB(B0, 1, 0); PG8_SCHED; PG8_LDA(At, 1, 0); PG8_STAGE(PG8_SA(0, 1), a2, voffA[1]);
            PG8_WAIT_L(8); PG8_BAR; PG8_WAIT_L(0); PG8_MMA(0, 0, At, B0); PG8_BAR; PG8_SCHED;
            PG8_LDB(B1, 1, 1); PG8_STAGE(PG8_SB(1, 0), b3, voffB);
            PG8_BAR; PG8_WAIT_L(0); PG8_MMA(0, 1, At, B1); PG8_BAR;
            PG8_LDA(At, 1, 1); PG8_STAGE(PG8_SA(1, 0), a3, voffA[0]);
            PG8_BAR; PG8_WAIT_L(0); PG8_MMA(1, 0, At, B0); PG8_BAR; PG8_SCHED;
            PG8_STAGE(PG8_SB(1, 1), b3 + hstep, voffB);
            PG8_WAIT_V(6); PG8_BAR; PG8_MMA(1, 1, At, B1); PG8_BAR;
            }
        }
        if constexpr (ALIGN_EPI) { if (wr == 0) PG8_BAR; }
        if constexpr (!Epi::AFTER_DRAIN) { E(acc, cur, wr, wc, fr, fq); S.done(cur); }
        if (!has_next) break;
#pragma unroll
        for (int a = 0; a < 2; ++a)
#pragma unroll
            for (int b = 0; b < 2; ++b)
#pragma unroll
                for (int m = 0; m < 4; ++m)
#pragma unroll
                    for (int n = 0; n < 2; ++n) acc[a][b][m][n] = (f32x4){0.f, 0.f, 0.f, 0.f};
        cur = nxt; cA = nA; cB = nB; ++ui;
        if constexpr (ALIGN_EPI) { if (wr == 1) PG8_BAR; }
    }
    PG8_WAIT_V(0);
    if constexpr (!ALIGN_EPI) { if (wr == 0) PG8_BAR; }
    PG8_BAR;
    if constexpr (Epi::AFTER_DRAIN) { E.fused(acc, cur, wr, wc, fr, fq, lds, wid, lane); S.done(cur); }
#undef PG8_SA
#undef PG8_SB
#undef PG8_STAGE
#undef PG8_LDA
#undef PG8_LDB
#undef PG8_MMA
#undef PG8_WAIT_V
#undef PG8_WAIT_L
#undef PG8_BAR
#undef PG8_SCHED
#undef PG8_GLOAD
}
}
#include <hip/hip_bf16.h>
#include <cmath>
namespace attn_body {
using bf16=__hip_bfloat16;
using bf16x8=__attribute__((ext_vector_type(8)))short;
using s16x4=__attribute__((ext_vector_type(4)))short;
using f32x16=__attribute__((ext_vector_type(16)))float;
using u32x4=__attribute__((ext_vector_type(4)))unsigned;
constexpr int BATCH=8,NHEAD=16,SEQ=2048,D=64,DMI=3072,DMO=1024;
constexpr int NW=8,QBLK=32,QB=QBLK*NW,KVBLK=64,NQB=SEQ/QB;
constexpr int ATTN_UNIT_ROWS=QB;
__device__ __forceinline__ int crow(int r,int hi){return (r&3)+8*(r>>2)+4*hi;}
#define SBAR() __builtin_amdgcn_sched_barrier(0)
__device__ __forceinline__ void cmask(f32x16&p0,f32x16&p1,int jb,int qrel,int hi){
  const float NEG=-INFINITY; int kb=64*jb+4*hi;
  #pragma unroll
  for(int r=0;r<16;++r){int kv=kb+(r&3)+8*(r>>2); if(kv>qrel)p0[r]=NEG; if(kv+32>qrel)p1[r]=NEG;}
}

constexpr int NSLOT=3, SLOTB=8192;
constexpr int LDS_K=0, LDS_V=NSLOT*SLOTB, LDS_WS=2*NSLOT*SLOTB, LDS_OST=LDS_WS+NW*64*4, LDS_BYTES=LDS_OST+NW*4096;
constexpr float C2=0.125f*1.4426950408889634f;
__device__ __forceinline__ void glds16(const void*gsrc,unsigned lds_dst){unsigned keep;
  asm volatile("s_mov_b32 %0, m0\n\ts_mov_b32 m0, %2\n\ts_nop 0\n\tglobal_load_lds_dwordx4 %1, off\n\ts_mov_b32 m0, %0":"=&s"(keep):"v"(gsrc),"s"(lds_dst):"memory");}
__device__ __forceinline__ float max3f(float a,float b,float c){float r;asm("v_max3_f32 %0, %1, %2, %3":"=v"(r):"v"(a),"v"(b),"v"(c));return r;}
__device__ __forceinline__ float max2f(float a,float b){float r;asm("v_max_f32_e32 %0, %1, %2":"=v"(r):"v"(a),"v"(b));return r;}
__device__ __forceinline__ float fadd_s(float a,float b){float r;asm("v_add_f32_e32 %0, %1, %2":"=v"(r):"v"(a),"v"(b));return r;}
__device__ __forceinline__ float fsub_s(float a,float b){float r;asm("v_sub_f32_e32 %0, %1, %2":"=v"(r):"v"(a),"v"(b));return r;}
typedef float f32x2_t __attribute__((ext_vector_type(2))); typedef __bf16 bf16x2_t __attribute__((ext_vector_type(2)));
__device__ __forceinline__ unsigned cvtpk_s(float lo,float hi){f32x2_t v={lo,hi};bf16x2_t b=__builtin_convertvector(v,bf16x2_t);return __builtin_bit_cast(unsigned,b);}
#define WAIT_BAR(N) asm volatile("s_waitcnt vmcnt(" #N ") lgkmcnt(0)\n\ts_barrier":::"memory")

__device__ __forceinline__ void qkt(f32x16&p0,f32x16&p1,const char*Kslot,const bf16x8*qr,const f32x16&negm,int r32,int hi){
  const char*kb=Kslot+hi*1024+r32*16;
  #pragma unroll
  for(int d0=0;d0<4;++d0){
    const bf16x8 b0=*reinterpret_cast<const bf16x8*>(kb+d0*2048);
    const bf16x8 b1=*reinterpret_cast<const bf16x8*>(kb+d0*2048+512);
    if(d0==0){p0=__builtin_amdgcn_mfma_f32_32x32x16_bf16(b0,qr[0],negm,0,0,0);p1=__builtin_amdgcn_mfma_f32_32x32x16_bf16(b1,qr[0],negm,0,0,0);}
    else{p0=__builtin_amdgcn_mfma_f32_32x32x16_bf16(b0,qr[d0],p0,0,0,0);p1=__builtin_amdgcn_mfma_f32_32x32x16_bf16(b1,qr[d0],p1,0,0,0);}}
}
typedef __attribute__((address_space(3))) const char* lds_cptr;
typedef short v4i16_t __attribute__((ext_vector_type(4)));
__device__ __forceinline__ void kload8(bf16x8*kf,lds_cptr kp){
  kf[0]=*(const __attribute__((address_space(3))) bf16x8*)(kp);      kf[1]=*(const __attribute__((address_space(3))) bf16x8*)(kp+512);
  kf[2]=*(const __attribute__((address_space(3))) bf16x8*)(kp+2048); kf[3]=*(const __attribute__((address_space(3))) bf16x8*)(kp+2560);
  kf[4]=*(const __attribute__((address_space(3))) bf16x8*)(kp+4096); kf[5]=*(const __attribute__((address_space(3))) bf16x8*)(kp+4608);
  kf[6]=*(const __attribute__((address_space(3))) bf16x8*)(kp+6144); kf[7]=*(const __attribute__((address_space(3))) bf16x8*)(kp+6656);
}
__device__ __forceinline__ void kload2(bf16x8*kf,lds_cptr kp,int j){ kf[2*j]=*(const __attribute__((address_space(3))) bf16x8*)(kp+j*2048); kf[2*j+1]=*(const __attribute__((address_space(3))) bf16x8*)(kp+j*2048+512); }
__device__ __forceinline__ s16x4 vtr(lds_cptr p){ return __builtin_bit_cast(s16x4,__builtin_amdgcn_ds_read_tr16_b64_v4i16((__attribute__((address_space(3))) v4i16_t*)p)); }
__device__ __forceinline__ float rowmax(const f32x16&p0,const f32x16&p1){
  float a=max3f(p0[0],p0[1],p1[0]),b=max3f(p0[2],p0[3],p1[1]);a=max3f(a,p1[2],p1[3]);
  #pragma unroll
  for(int r=4;r<16;r+=4){a=max3f(a,p0[r],p0[r+1]);b=max3f(b,p0[r+2],p0[r+3]);a=max3f(a,p1[r],p1[r+1]);b=max3f(b,p1[r+2],p1[r+3]);}
  const float m=max2f(a,b);
  auto rr=__builtin_amdgcn_permlane32_swap(__float_as_uint(m),__float_as_uint(m),false,false);
  return max2f(__uint_as_float(rr[0]),__uint_as_float(rr[1]));
}
__device__ __forceinline__ void pv(f32x16*o,int vb,bf16x8 pa0,bf16x8 pa1,bf16x8 pa2,bf16x8 pa3){
  #pragma unroll
  for(int d0=0;d0<2;++d0){s16x4 lo[4],hi[4];
    #pragma unroll
    for(int ks=0;ks<4;++ks){
      asm volatile("ds_read_b64_tr_b16 %0,%1 offset:%c2":"=&v"(lo[ks]):"v"(vb),"i"(d0*4096+ks*1024):"memory");
      asm volatile("ds_read_b64_tr_b16 %0,%1 offset:%c2":"=&v"(hi[ks]):"v"(vb),"i"(d0*4096+ks*1024+512):"memory");}
    asm volatile("s_waitcnt lgkmcnt(0)":::"memory");SBAR();
    #define PK(k) (bf16x8){lo[k][0],lo[k][1],lo[k][2],lo[k][3],hi[k][0],hi[k][1],hi[k][2],hi[k][3]}
    o[d0]=__builtin_amdgcn_mfma_f32_32x32x16_bf16(pa0,PK(0),o[d0],0,0,0);
    o[d0]=__builtin_amdgcn_mfma_f32_32x32x16_bf16(pa1,PK(1),o[d0],0,0,0);
    o[d0]=__builtin_amdgcn_mfma_f32_32x32x16_bf16(pa2,PK(2),o[d0],0,0,0);
    o[d0]=__builtin_amdgcn_mfma_f32_32x32x16_bf16(pa3,PK(3),o[d0],0,0,0);
    #undef PK
  }
}

#ifndef ATTN_STORE16
#define ATTN_STORE16(p,v) (*(u32x4*)(p)=(v))
#endif
template<int THRL> __device__ __forceinline__ void attn_unit(int b,int qb,const bf16*Q,const bf16*__restrict__ K,const bf16*__restrict__ V,bf16*O,char*shm){
  const int tid=threadIdx.x,lane=tid&63,r32=lane&31,hi=lane>>5; const int wid=__builtin_amdgcn_readfirstlane(tid>>6);
  const long rowbase=(long)b*SEQ; const int q0=qb*QB;
  const bf16*Qw=Q+(rowbase+q0+wid*QBLK)*DMI;
  const bf16*Kh=K+rowbase*DMI,*Vh=V+rowbase*DMI;
  const unsigned lds0=(unsigned)(uintptr_t)shm;
  float*wsf=(float*)(shm+LDS_WS)+wid*64;
  const bf16*ksrc=Kh+(long)lane*DMI+wid*8;
  const bf16*vsrc=Vh+(long)(16*(wid&3)+(lane>>2))*DMI+(wid>>2)*32+(lane&3)*8;
  const unsigned kdst=lds0+LDS_K+wid*1024, vdst=lds0+LDS_V+wid*1024;
  #define DMA_K(t,slot) glds16(ksrc+(long)(t)*KVBLK*DMI,(unsigned)__builtin_amdgcn_readfirstlane(kdst+(slot)))
  #define DMA_V(t,slot) glds16(vsrc+(long)(t)*KVBLK*DMI,(unsigned)__builtin_amdgcn_readfirstlane(vdst+(slot)))
  const int vb0=(int)(lds0+LDS_V)+((lane>>4)&1)*32+(lane&3)*8+(4*hi+((lane&15)>>2))*64;
  const char*Kbase=shm+LDS_K; bf16x8 kf[8];
  const lds_cptr shm3=(lds_cptr)shm; const lds_cptr kp0=shm3+LDS_K+hi*1024+r32*16; const lds_cptr vp0=shm3+LDS_V+((lane>>4)&1)*32+(lane&3)*8+(4*hi+((lane&15)>>2))*64;
  const int NT=(q0+QB)/KVBLK;
  DMA_K(0,0);DMA_V(0,0);DMA_K(1,SLOTB);
  bf16x8 qr[4];
  #pragma unroll
  for(int d0=0;d0<4;++d0)qr[d0]=*reinterpret_cast<const bf16x8*>(&Qw[(long)r32*DMI+d0*16+hi*8]);
  float mhat=0.f,l_reg=0.f;f32x16 o[2];o[0]=f32x16{};o[1]=f32x16{};f32x16 negm=f32x16{};asm volatile("":"+v"(negm));
  const int qrel=wid*QBLK+r32;
  #define CMASK(P0,P1,t) do{int jb_=(t)-(NT-4); if(jb_>=0)cmask(P0,P1,jb_,qrel,hi);}while(0)
  bool resc=false;
  #define START(P0,P1) do{ const float rm=rowmax(P0,P1); resc=false; \
    { const float dl=rm; mhat=fadd_s(mhat,dl); \
      _Pragma("unroll") for(int r=0;r<16;++r){P0[r]=fsub_s(P0[r],dl);P1[r]=fsub_s(P1[r],dl);} \
      _Pragma("unroll") for(int r=0;r<16;++r)negm[r]=-mhat; asm volatile("":"+v"(negm)); } \
    _Pragma("unroll") for(int r=0;r<16;++r)P0[r]=__builtin_amdgcn_exp2f(P0[r]); }while(0)
  #define RESC() do{ if(resc){ asm volatile("s_waitcnt lgkmcnt(0)":::"memory"); \
      _Pragma("unroll") for(int d_=0;d_<2;++d_) _Pragma("unroll") for(int r=0;r<16;++r)o[d_][r]*=wsf[crow(r,hi)]; } }while(0)
  f32x16 pA0,pA1,pB0,pB1;
  int sl_prev=0,sl_cur=0,sl_next=SLOTB;
  #define ROT() do{sl_prev=sl_cur;sl_cur=sl_next;sl_next=(sl_next==(NSLOT-1)*SLOTB)?0:sl_next+SLOTB;}while(0)
  DMA_K(2,2*SLOTB);
  WAIT_BAR(3);
  qkt(pA0,pA1,Kbase,qr,negm,r32,hi);asm volatile("s_nop 15\n\ts_nop 7":"+v"(pA0),"+v"(pA1));CMASK(pA0,pA1,0);
  START(pA0,pA1);
  _Pragma("unroll") for(int r=0;r<16;++r)pA1[r]=__builtin_amdgcn_exp2f(pA1[r]);
  WAIT_BAR(0);
  DMA_K(3,0);DMA_V(1,SLOTB);
  ROT();
  kload8(kf,kp0+sl_cur);
  WAIT_BAR(2);
  s16x4 vlo[8],vhi[8]; u32x4 pw0,pw1,pw2,pw3;
  #define PKW(P,B) cvtpk_s(P[B],P[B+1])
  #define PAF(k) __builtin_bit_cast(bf16x8,pw##k)
  #define VFR(i) (bf16x8){vlo[i][0],vlo[i][1],vlo[i][2],vlo[i][3],vhi[i][0],vhi[i][1],vhi[i][2],vhi[i][3]}
  #define PIN(x) asm volatile("":"+v"(x))
  #define MX3(a,b,c) __builtin_fmaxf(__builtin_fmaxf((a),(b)),(c))
  #define GAPA(MF,A0,A1,A2,A3,W0,W1,PW) do{ MF; sacc+=A0; sacc+=A1; sacc+=A2; sacc+=A3; PIN(sacc); W0; W1; PIN(PW); SBAR(); }while(0)
  #define EX(v) __builtin_amdgcn_exp2f(v)
  #define GAPB(MF,X,B) do{ MF; X[B]=EX(X[B]); X[B+1]=EX(X[B+1]); X[B+2]=EX(X[B+2]); X[B+3]=EX(X[B+3]); PIN(X); SBAR(); }while(0)
  #define VRD(i) do{ vlo[i]=vtr(vp_+(((i)>>2)*4096+((i)&3)*1024)); vhi[i]=vtr(vp_+(((i)>>2)*4096+((i)&3)*1024+512)); }while(0)
  #define KRD(G,j) do{ if(G){ kload2(kf,kp0+sl_next,j); SBAR(); } }while(0)
  #define STEP(C0,C1,P0,P1,t,GK,GV,GL) do{ SBAR(); \
    const lds_cptr vp_=vp0+sl_prev; \
    VRD(0); SBAR(); float sacc=(P0[0]+P0[1]); \
    GAPA(C0=__builtin_amdgcn_mfma_f32_32x32x16_bf16(kf[0],qr[0],negm,0,0,0), P0[2],P0[3],P0[4],P0[5],     pw0[0]=PKW(P0,0), pw0[1]=PKW(P0,2), pw0); \
    VRD(4); SBAR(); GAPA(C1=__builtin_amdgcn_mfma_f32_32x32x16_bf16(kf[1],qr[0],negm,0,0,0), P0[6],P0[7],P0[8],P0[9],     pw0[2]=PKW(P0,4), pw0[3]=PKW(P0,6), pw0); \
    VRD(1); SBAR(); GAPA(C0=__builtin_amdgcn_mfma_f32_32x32x16_bf16(kf[2],qr[1],C0,0,0,0),   P0[10],P0[11],P0[12],P0[13], pw1[0]=PKW(P0,8), pw1[1]=PKW(P0,10), pw1); \
    VRD(5); SBAR(); GAPA(C1=__builtin_amdgcn_mfma_f32_32x32x16_bf16(kf[3],qr[1],C1,0,0,0),   P0[14],P0[15],P1[0],P1[1],   pw1[2]=PKW(P0,12),pw1[3]=PKW(P0,14), pw1); \
    VRD(2); SBAR(); GAPA(C0=__builtin_amdgcn_mfma_f32_32x32x16_bf16(kf[4],qr[2],C0,0,0,0),   P1[2],P1[3],P1[4],P1[5],     pw2[0]=PKW(P1,0), pw2[1]=PKW(P1,2), pw2); \
    VRD(6); SBAR(); GAPA(C1=__builtin_amdgcn_mfma_f32_32x32x16_bf16(kf[5],qr[2],C1,0,0,0),   P1[6],P1[7],P1[8],P1[9],     pw2[2]=PKW(P1,4), pw2[3]=PKW(P1,6), pw2); \
    VRD(3); SBAR(); GAPA(C0=__builtin_amdgcn_mfma_f32_32x32x16_bf16(kf[6],qr[3],C0,0,0,0),   P1[10],P1[11],P1[12],P1[13], pw3[0]=PKW(P1,8), pw3[1]=PKW(P1,10), pw3); \
    VRD(7); SBAR(); GAPA(C1=__builtin_amdgcn_mfma_f32_32x32x16_bf16(kf[7],qr[3],C1,0,0,0),   P1[14],P1[15],0.f,0.f,       pw3[2]=PKW(P1,12),pw3[3]=PKW(P1,14), pw3); \
    l_reg+=sacc; \
    if(GK){DMA_K((t)+3,sl_cur);} if(GV){DMA_V((t)+1,sl_next);} \
    CMASK(C0,C1,t); \
    { float a=MX3(C0[0],C0[1],C1[0]),b=MX3(C0[2],C0[3],C1[1]); a=MX3(a,C1[2],C1[3]); \
      _Pragma("unroll") for(int r=4;r<16;r+=4){a=MX3(a,C0[r],C0[r+1]);b=MX3(b,C0[r+2],C0[r+3]);a=MX3(a,C1[r],C1[r+1]);b=MX3(b,C1[r+2],C1[r+3]);} \
      float rm=__builtin_fmaxf(a,b); { auto rr=__builtin_amdgcn_permlane32_swap(__float_as_uint(rm),__float_as_uint(rm),false,false); rm=__builtin_fmaxf(__uint_as_float(rr[0]),__uint_as_float(rr[1])); } \
      resc=false; \
      if(__builtin_expect(__any(rm>(float)THRL),0)){ const float dl=__builtin_fmaxf(rm,0.f); mhat+=dl; \
        _Pragma("unroll") for(int r=0;r<16;++r){C0[r]-=dl;C1[r]-=dl;} \
        _Pragma("unroll") for(int r=0;r<16;++r)negm[r]=-mhat; asm volatile("":"+v"(negm)); \
        const float f=__builtin_amdgcn_exp2f(-dl); l_reg*=f; if(hi==0)wsf[r32]=f; resc=true; } } \
    SBAR(); \
    GAPB(o[0]=__builtin_amdgcn_mfma_f32_32x32x16_bf16(PAF(0),VFR(0),o[0],0,0,0), C0,0); \
    GAPB(o[1]=__builtin_amdgcn_mfma_f32_32x32x16_bf16(PAF(0),VFR(4),o[1],0,0,0), C0,4); \
    KRD(GL,0); GAPB(o[0]=__builtin_amdgcn_mfma_f32_32x32x16_bf16(PAF(1),VFR(1),o[0],0,0,0), C0,8); \
    KRD(GL,1); GAPB(o[1]=__builtin_amdgcn_mfma_f32_32x32x16_bf16(PAF(1),VFR(5),o[1],0,0,0), C0,12); \
    KRD(GL,2); GAPB(o[0]=__builtin_amdgcn_mfma_f32_32x32x16_bf16(PAF(2),VFR(2),o[0],0,0,0), C1,0); \
    KRD(GL,3); GAPB(o[1]=__builtin_amdgcn_mfma_f32_32x32x16_bf16(PAF(2),VFR(6),o[1],0,0,0), C1,4); \
    GAPB(o[0]=__builtin_amdgcn_mfma_f32_32x32x16_bf16(PAF(3),VFR(3),o[0],0,0,0), C1,8); \
    GAPB(o[1]=__builtin_amdgcn_mfma_f32_32x32x16_bf16(PAF(3),VFR(7),o[1],0,0,0), C1,12); \
    }while(0)
  int t=1;
  #undef CMASK
  #define CMASK(P0,P1,t) do{}while(0)
  for(;t+5<NT;t+=2){
    STEP(pB0,pB1,pA0,pA1,t,true,true,true);     WAIT_BAR(2); RESC(); ROT();
    STEP(pA0,pA1,pB0,pB1,t+1,true,true,true);   WAIT_BAR(2); RESC(); ROT();
  }
  #undef CMASK
  #define CMASK(P0,P1,t) do{int jb_=(t)-(NT-4); if(jb_>=0)cmask(P0,P1,jb_,qrel,hi);}while(0)
  #define ENDW(tt) do{ if((tt)+3<NT){WAIT_BAR(2);} else if((tt)+2<NT){WAIT_BAR(1);} else {WAIT_BAR(0);} }while(0)
  for(;t+1<NT;t+=2){
    STEP(pB0,pB1,pA0,pA1,t,(t+3<NT),(t+1<NT),(t+1<NT));       ENDW(t);   RESC(); ROT();
    STEP(pA0,pA1,pB0,pB1,t+1,(t+4<NT),(t+2<NT),(t+2<NT));     ENDW(t+1); RESC(); ROT();
  }
  STEP(pB0,pB1,pA0,pA1,NT-1,false,false,false); RESC();
  { float sacc=pB0[0]+pB0[1]; _Pragma("unroll") for(int r=2;r<16;++r)sacc+=pB0[r]; _Pragma("unroll") for(int r=0;r<16;++r)sacc+=pB1[r]; l_reg+=sacc;
    pw0=(u32x4){PKW(pB0,0),PKW(pB0,2),PKW(pB0,4),PKW(pB0,6)};pw1=(u32x4){PKW(pB0,8),PKW(pB0,10),PKW(pB0,12),PKW(pB0,14)};pw2=(u32x4){PKW(pB1,0),PKW(pB1,2),PKW(pB1,4),PKW(pB1,6)};pw3=(u32x4){PKW(pB1,8),PKW(pB1,10),PKW(pB1,12),PKW(pB1,14)};
    SBAR(); pv(o,vb0+sl_cur,PAF(0),PAF(1),PAF(2),PAF(3)); }
  #undef PKW
  #undef PAF
  #undef VFR
  #undef PIN
  #undef MX3
  #undef GAPA
  #undef GAPB
  #undef EX
  #undef VRD
  #undef KRD
  #undef STEP
  #undef ENDW
  {auto rr=__builtin_amdgcn_permlane32_swap(__float_as_uint(l_reg),__float_as_uint(l_reg),false,false);l_reg=__uint_as_float(rr[0])+__uint_as_float(rr[1]);}
  if(hi==0)wsf[32+r32]=l_reg;asm volatile("s_waitcnt lgkmcnt(0)":::"memory");
  float rli[16];
  #pragma unroll
  for(int r=0;r<16;++r)rli[r]=__builtin_amdgcn_rcpf(wsf[32+crow(r,hi)]);
  bf16*Ow=O+(rowbase+q0+wid*QBLK)*DMO;
  { bf16*stg=(bf16*)(shm+LDS_OST)+wid*2048;
    #pragma unroll
    for(int r=0;r<16;++r){const int orow=crow(r,hi);
      #pragma unroll
      for(int d0=0;d0<2;++d0)stg[orow*64+d0*32+r32]=__float2bfloat16(o[d0][r]*rli[r]);}
    asm volatile("s_waitcnt lgkmcnt(0)":::"memory");
    #pragma unroll
    for(int i=0;i<4;++i){const int row=i*8+(lane>>3),ch=lane&7; const u32x4 v=*(const u32x4*)(stg+row*64+ch*8); ATTN_STORE16(Ow+(long)row*DMO+ch*8,v);} }
  asm volatile("s_waitcnt lgkmcnt(0)\n\ts_barrier":::"memory");
  #undef DMA_K
  #undef DMA_V
  #undef CMASK
  #undef START
  #undef RESC
  #undef ROT
}
constexpr int ATTN_LDS_BYTES=LDS_BYTES;
struct AttnTensors { const bf16* PJ; bf16* O; };
struct AttnUnit { int bh; int qb; };
constexpr int QCOL=1536, KCOL=2048, VCOL=2560;
struct StaticOrder {
  int vcu;
  __device__ __forceinline__ explicit StaticOrder(int v):vcu(v){}
  __device__ __forceinline__ bool next(int i,AttnUnit&u)const{ if(i>=4||vcu>=256)return false; const int s=2*(vcu&1)+(i>>1); u.bh=vcu>>1; u.qb=(i&1)?7-s:s; return true; }
  __device__ __forceinline__ void a_ready(const AttnUnit&)const{}
  __device__ __forceinline__ void done(const AttnUnit&)const{}
};
template<class Sched,int THRL=8> __device__ __forceinline__ void attn_phase(char*lds,const AttnTensors&T,const Sched&S){
  AttnUnit u;
  for(int i=0;S.next(i,u);++i){ S.a_ready(u);
    const int b=u.bh>>4, vh=u.bh&15, hd=vh>>2, j=(vh>>1)&1, half=vh&1;
    attn_unit<THRL>(b,u.qb,T.PJ+QCOL+hd*128+j*64,T.PJ+KCOL+hd*128+j*64,T.PJ+VCOL+hd*128+half*64,T.O+vh*64,lds); S.done(u); }
}
#undef SBAR
#undef WAIT_BAR
}
#define GAS __attribute__((address_space(1)))
#define LAS __attribute__((address_space(3)))
typedef unsigned short bf16;
typedef unsigned v4u __attribute__((ext_vector_type(4)));
typedef float f32x4 __attribute__((ext_vector_type(4)));
typedef short bf16x8 __attribute__((ext_vector_type(8)));
typedef GAS unsigned gu32;
typedef GAS unsigned long long gu64;
#define RLX_AGENT __ATOMIC_RELAXED, __HIP_MEMORY_SCOPE_AGENT
#define LDS_WAIT() asm volatile("s_waitcnt lgkmcnt(0)" ::: "memory")
#define VM_WAIT() asm volatile("s_waitcnt vmcnt(0)" ::: "memory")
__device__ __forceinline__ unsigned long long rt() { return __builtin_amdgcn_s_memrealtime(); }
__device__ __forceinline__ unsigned f2bf(float f) { unsigned u = __builtin_bit_cast(unsigned, f); return (u + 0x7fffu + ((u >> 16) & 1u)) >> 16; }
__device__ __forceinline__ unsigned pk2(float lo, float hi) { return f2bf(lo) | (f2bf(hi) << 16); }

#define XB_TMO      128
#define XB_XCNT(j)  (256  + 64 * (j))
#define XB_XSUB(j)  (1280 + 64 * (j))
#define XB_XGEN(j)  (2304 + 64 * (j))
#define XB_TOP      3328
#define XB_TOPGEN   3392
#define XCD_BAR_WORDS 3456
#define XB_SPIN_CAP (1u << 18)

__device__ __forceinline__ unsigned xb_ld(unsigned* p)              { return __hip_atomic_load(p, __ATOMIC_RELAXED, __HIP_MEMORY_SCOPE_AGENT); }
__device__ __forceinline__ unsigned xb_add(unsigned* p, unsigned v) { return __hip_atomic_fetch_add(p, v, __ATOMIC_RELAXED, __HIP_MEMORY_SCOPE_AGENT); }
__device__ __forceinline__ unsigned xb_xcc_id() { return (unsigned)__builtin_amdgcn_s_getreg((3 << 11) | 20) & 0xFu; }
#define XB_SPIN(cond, bar) do { unsigned _sp = 0; while (cond) { __builtin_amdgcn_s_sleep(1); \
    if ((++_sp & 255u) == 0u) { if (xb_ld(&(bar)[XB_TMO])) break; if (_sp > XB_SPIN_CAP) { atomicAdd(&(bar)[XB_TMO], 1u); break; } } } } while (0)

struct XcdBarrier {
    unsigned* bar; unsigned x;
    volatile LAS unsigned* st;
};

__device__ __forceinline__ XcdBarrier xcd_barrier_post(unsigned* bar, volatile LAS unsigned* st) {
    XcdBarrier b; b.bar = bar; b.x = xb_xcc_id(); b.st = st;
    if (threadIdx.x == 0) (void)xb_add(&bar[XB_XCNT(b.x)], 1u);
    return b;
}
__device__ __forceinline__ void xcd_barrier_complete(unsigned* bar, unsigned x, unsigned& nloc, unsigned& nx) {
    const unsigned G = gridDim.x * gridDim.y * gridDim.z;
    unsigned sum, cnt, mine, sp = 0u;
    for (;;) {
        sum = 0u; cnt = 0u; mine = 0u;
#pragma unroll
        for (unsigned j = 0; j < 16; ++j) { const unsigned c = xb_ld(&bar[XB_XCNT(j)]); sum += c; cnt += (c > 0u) ? 1u : 0u; mine = (j == x) ? c : mine; }
        if (sum == G) break;
        __builtin_amdgcn_s_sleep(1);
        if ((++sp & 255u) == 0u) { if (xb_ld(&bar[XB_TMO])) break; if (sp > XB_SPIN_CAP) { atomicAdd(&bar[XB_TMO], 1u); break; } }
    }
    nloc = mine > 0u ? mine : 1u; nx = cnt > 0u ? cnt : 1u;
}

__device__ __forceinline__ void xcd_barrier(const XcdBarrier& b) {
    asm volatile("s_waitcnt vmcnt(0)" ::: "memory");
    __syncthreads();
    if (threadIdx.x == 0) {
        unsigned* bar = b.bar;
        __builtin_amdgcn_s_waitcnt(0);
        unsigned nloc = b.st[0], nx = b.st[1];
        if (nloc == 0u) { xcd_barrier_complete(bar, b.x, nloc, nx); b.st[0] = nloc; b.st[1] = nx; }
        const unsigned old = xb_add(&bar[XB_XSUB(b.x)], 1u);
        const unsigned gen = old / nloc;
        if (old + 1u == (gen + 1u) * nloc) {
            __builtin_amdgcn_fence(__ATOMIC_RELEASE, "agent");
            asm volatile("s_waitcnt vmcnt(0)" ::: "memory");
            const unsigned og = xb_add(&bar[XB_TOP], 1u);
            const unsigned tg = og / nx;
            if (og + 1u == (tg + 1u) * nx) xb_add(&bar[XB_TOPGEN], 1u);
            else XB_SPIN(xb_ld(&bar[XB_TOPGEN]) == tg, bar);
            __builtin_amdgcn_fence(__ATOMIC_ACQUIRE, "agent");
            xb_add(&bar[XB_XGEN(b.x)], 1u);
            asm volatile("s_waitcnt vmcnt(0)" ::: "memory");
        } else {
            XB_SPIN(xb_ld(&bar[XB_XGEN(b.x)]) == gen, bar);
            __builtin_amdgcn_fence(__ATOMIC_ACQUIRE, "agent");
            asm volatile("s_waitcnt vmcnt(0)" ::: "memory");
        }
    }
    __syncthreads();
}
constexpr int NWAVES = 8;
constexpr int Bsz = 8, SEQ = 2048, D = 1024, T = Bsz * SEQ;
constexpr int INP = 3080, NPJ = 3072, OFF_DT = 1536, OFF_Q2 = 1544;
constexpr int NE = 32, CAP = T, PLE = 256, FF2 = 2048;
constexpr int PADROWS = 4 * T + NE * 256;
constexpr float LAM_INIT = 0.2f, EPS = 1e-6f;
constexpr size_t MiB = 1u << 20;
constexpr size_t WS_CTL = 0, CTL_ZERO_BYTES = 1 * MiB;
constexpr size_t WS_ROWTOK = 1 * MiB, WS_ROWGATE = 3 * MiB, WS_SLOT = 5 * MiB, WS_DT = 6 * MiB, WS_WR = 7 * MiB;
constexpr size_t WS_WIN = 8 * MiB, WS_WOUT = 14 * MiB, WS_WG = 16 * MiB, WS_WP = 18 * MiB, WS_WUP = 20 * MiB, WS_WDN = 148 * MiB;
constexpr size_t WS_H = 212 * MiB, WS_PJ = 244 * MiB, WS_O = 340 * MiB, WS_YC = 372 * MiB, WS_X1 = 404 * MiB, WS_X2 = 468 * MiB, WS_PP = 532 * MiB, WS_P16 = 564 * MiB;
constexpr size_t WS_ACT = 572 * MiB, WS_YS = 716 * MiB, WS_TMP = 860 * MiB, WS_END = 960 * MiB;
static_assert(WS_ACT + (size_t)PADROWS * 1024 * 2 <= WS_YS && WS_YS + (size_t)PADROWS * 1024 * 2 <= WS_TMP, "d_ws map");
constexpr int CW_TMO = 0, CW_CODE = 1, CW_CNT = 64  , CW_BAR = 4096;
constexpr int RING_OFF = 0, RING_BYTES = 131072, LDSCTL_OFF = RING_BYTES, MISC_OFF = LDSCTL_OFF + 320, MTS_OFF = LDSCTL_OFF + 512, GTAB_OFF = LDSCTL_OFF + 1024, GTAB_UNITS = 10;
constexpr int LDS_BYTES = 147456;
static_assert(GTAB_OFF + GTAB_UNITS * 1024 <= LDS_BYTES, "LDS map");
__device__ __forceinline__ float wave_sum(float v) {
#pragma unroll
    for (int o = 1; o < 64; o <<= 1) v += __shfl_xor(v, o);
    return v;
}
__device__ __forceinline__ float bf2f(bf16 u) { return __uint_as_float((unsigned)u << 16); }
typedef unsigned u32x2 __attribute__((ext_vector_type(2)));

struct Args {
    const float *x, *p, *g_mix, *w_in, *conv_w, *conv_b, *dt_bias, *a_log, *d_skip, *ssd_norm_w, *lq1, *lk1, *lq2, *lk2, *subln_w, *w_out, *g_ffn, *w_router, *b_router,
                *w_up, *b_up, *w_down, *b_down, *g_ple, *w_ple_gate, *w_ple_proj, *g_final;
    float* out; unsigned char* ws; int ph_lo, ph_hi, use_bar, pad;
};

__device__ __forceinline__ void tr_item(const float* W, int ldw, int K, bf16* WT, int n0, int k0, int nrow0, LAS unsigned* scr, int lane) {
    const int n4 = (lane & 15) * 4, kr = lane >> 4;
    const float* src = W + (size_t)(k0 + kr * 2) * ldw + n0 + n4;
#pragma unroll
    for (int it = 0; it < 8; ++it) {
        const f32x4 a = *(const GAS f32x4*)(src + (size_t)(it * 8) * ldw);
        const f32x4 b = *(const GAS f32x4*)(src + (size_t)(it * 8 + 1) * ldw);
        const int kp = it * 4 + kr;
        scr[(n4 + 0) * 33 + kp] = pk2(a.x, b.x); scr[(n4 + 1) * 33 + kp] = pk2(a.y, b.y); scr[(n4 + 2) * 33 + kp] = pk2(a.z, b.z); scr[(n4 + 3) * 33 + kp] = pk2(a.w, b.w);
    }
    LDS_WAIT(); asm volatile("" ::: "memory");
    const int c = lane & 7;
#pragma unroll
    for (int it = 0; it < 8; ++it) { const int n = (lane >> 3) + 8 * it; const LAS unsigned* s = scr + n * 33 + c * 4;
        v4u o; o.x = s[0]; o.y = s[1]; o.z = s[2]; o.w = s[3];
        *(GAS v4u*)(WT + (size_t)(nrow0 + n) * K + k0 + 8 * c) = o; }
    LDS_WAIT(); asm volatile("" ::: "memory");
}
__device__ __forceinline__ void p0_prologue(const Args& a, LAS unsigned char* lds, int vcu, int G, int wave, int lane, int tid) {
    unsigned char* ws = a.ws;
    bf16* Win_t = (bf16*)(ws + WS_WIN); bf16* Wout_t = (bf16*)(ws + WS_WOUT); bf16* Wg_t = (bf16*)(ws + WS_WG); bf16* Wp_t = (bf16*)(ws + WS_WP); bf16* Wup_t = (bf16*)(ws + WS_WUP); bf16* Wdn_t = (bf16*)(ws + WS_WDN);
    LAS unsigned* scr = (LAS unsigned*)(lds + RING_OFF + wave * 8704);
    const int gw = vcu * NWAVES + wave, NGW = G * NWAVES;
    constexpr int I_IN = 16 * 24, I_SQ = 16 * 16, I_PP = 4 * 16, I_UP = 32 * 16 * 32, I_DN = 32 * 16 * 16;
    constexpr int NITEMS = 2 * I_IN + 2 * I_SQ + I_PP + I_UP + I_DN;
    for (int it = gw; it < NITEMS; it += NGW) {
        int r = it;
        if (r < I_UP) { const int e = r >> 9, q = r & 511; tr_item(a.w_up + (size_t)e * D * FF2, FF2, D, Wup_t + (size_t)e * FF2 * D, (q & 31) * 64, (q >> 5) * 64, (q & 31) * 64, scr, lane); continue; } r -= I_UP;
        if (r < I_DN) { const int e = r >> 8, q = r & 255; tr_item(a.w_down + (size_t)e * D * D, D, D, Wdn_t + (size_t)e * D * D, (q & 15) * 64, (q >> 4) * 64, (q & 15) * 64, scr, lane); continue; } r -= I_DN;
        if (r < I_IN) { tr_item(a.w_in, INP, D, Win_t, (r % 24) * 64, (r / 24) * 64, (r % 24) * 64, scr, lane); continue; } r -= I_IN;
        if (r < I_IN) { tr_item(a.w_in + OFF_Q2, INP, D, Win_t, (r % 24) * 64, (r / 24) * 64, 1536 + (r % 24) * 64, scr, lane); continue; } r -= I_IN;
        if (r < I_SQ) { tr_item(a.w_out, D, D, Wout_t, (r & 15) * 64, (r >> 4) * 64, (r & 15) * 64, scr, lane); continue; } r -= I_SQ;
        if (r < I_SQ) { tr_item(a.w_ple_gate, D, D, Wg_t, (r & 15) * 64, (r >> 4) * 64, (r & 15) * 64, scr, lane); continue; } r -= I_SQ;
        tr_item(a.w_ple_proj, D, PLE, Wp_t, (r & 15) * 64, (r >> 4) * 64, (r & 15) * 64, scr, lane);
    }
    { bf16* Wr_t = (bf16*)(ws + WS_WR); const int gt = vcu * (NWAVES * 64) + tid, NT_ = G * NWAVES * 64;
      for (int i = gt; i < NE * D; i += NT_) { const int n = i >> 10, k = i & 1023; Wr_t[i] = (bf16)f2bf(a.w_router[k * NE + n]); } }
    bf16* H = (bf16*)(ws + WS_H); float* DT = (float*)(ws + WS_DT);
    for (int m = gw; m < T; m += NGW) {
        const GAS f32x4* xr = (const GAS f32x4*)(a.x + (size_t)m * D) + lane;
        f32x4 v[4]; float s = 0.f;
#pragma unroll
        for (int j = 0; j < 4; ++j) { v[j] = xr[64 * j]; s += (v[j].x * v[j].x + v[j].y * v[j].y) + (v[j].z * v[j].z + v[j].w * v[j].w); }
        const float rs = 1.f / sqrtf(wave_sum(s) * (1.f / D) + EPS);
        GAS u32x2* o8 = (GAS u32x2*)(H + (size_t)m * D) + lane;
        float d[8];
#pragma unroll
        for (int h = 0; h < 8; ++h) d[h] = 0.f;
#pragma unroll
        for (int j = 0; j < 4; ++j) { const f32x4 gg = ((const GAS f32x4*)a.g_mix)[lane + 64 * j]; v[j] = v[j] * rs * gg;
            u32x2 w; w.x = pk2(v[j].x, v[j].y); w.y = pk2(v[j].z, v[j].w); o8[64 * j] = w;
#pragma unroll
            for (int i = 0; i < 4; ++i) { const float* wr = a.w_in + (size_t)(4 * lane + 256 * j + i) * INP + OFF_DT; const f32x4 w0 = *(const GAS f32x4*)wr, w1 = *(const GAS f32x4*)(wr + 4); const float hv = v[j][i];
                d[0] += hv * w0.x; d[1] += hv * w0.y; d[2] += hv * w0.z; d[3] += hv * w0.w; d[4] += hv * w1.x; d[5] += hv * w1.y; d[6] += hv * w1.z; d[7] += hv * w1.w; } }
#pragma unroll
        for (int h = 0; h < 8; ++h) d[h] = wave_sum(d[h]);
        if (lane < 8) { float mine = d[0];
#pragma unroll
            for (int h = 1; h < 8; ++h) mine = (lane == h) ? d[h] : mine;
            const float raw = mine + a.dt_bias[lane]; DT[(size_t)m * 8 + lane] = raw > 20.f ? raw : log1pf(expf(raw)); }
    }
    { bf16* P16 = (bf16*)(ws + WS_P16); const int gt = vcu * (NWAVES * 64) + tid, NT_ = G * NWAVES * 64;
      for (int i = gt; i < T * PLE / 8; i += NT_) { const f32x4 v0 = ((const GAS f32x4*)a.p)[2 * i], v1 = ((const GAS f32x4*)a.p)[2 * i + 1];
          v4u o; o.x = pk2(v0.x, v0.y); o.y = pk2(v0.z, v0.w); o.z = pk2(v1.x, v1.y); o.w = pk2(v1.z, v1.w); ((GAS v4u*)P16)[i] = o; } }
}

__device__ __forceinline__ void p5_router(const Args& a, LAS unsigned char* lds, int vcu, int G, int wave, int lane, int tid) {
    typedef float f32x16 __attribute__((ext_vector_type(16)));
    unsigned char* ws = a.ws;
    const float* X1 = (const float*)(ws + WS_X1); bf16* H = (bf16*)(ws + WS_H); const bf16* Wr_t = (const bf16*)(ws + WS_WR);
    int* cnt = (int*)(ws + WS_CTL) + CW_CNT; int* row_tok = (int*)(ws + WS_ROWTOK); float* row_gate = (float*)(ws + WS_ROWGATE); int* slot = (int*)(ws + WS_SLOT);
    for (int tile = vcu; tile < T / 64; tile += G) {
        for (int tt = 0; tt < 8; ++tt) {
            const int lr = wave * 8 + tt, m = tile * 64 + lr;
            const GAS f32x4* xr = (const GAS f32x4*)(X1 + (size_t)m * D) + lane;
            f32x4 v[4]; float s = 0.f;
#pragma unroll
            for (int j = 0; j < 4; ++j) { v[j] = xr[64 * j]; s += (v[j].x * v[j].x + v[j].y * v[j].y) + (v[j].z * v[j].z + v[j].w * v[j].w); }
            const float rs = 1.f / sqrtf(wave_sum(s) * (1.f / D) + EPS);
            GAS u32x2* o8 = (GAS u32x2*)(H + (size_t)m * D) + lane;
#pragma unroll
            for (int j = 0; j < 4; ++j) { const f32x4 gg = ((const GAS f32x4*)a.g_ffn)[lane + 64 * j]; const f32x4 hv = v[j] * rs * gg;
                u32x2 w; w.x = pk2(hv.x, hv.y); w.y = pk2(hv.z, hv.w); o8[64 * j] = w;
                const int chunk = (lane >> 1) + 32 * j;
                *(LAS u32x2*)(lds + lr * 2048 + ((chunk ^ (lr & 7)) << 4) + (lane & 1) * 8) = w; }
        }
        __syncthreads();
        const int r32 = lane & 31, hi = lane >> 5, mh = wave & 1, kq = wave >> 1;
        f32x16 acc = {};
#pragma unroll 4
        for (int st = 0; st < 16; ++st) { const int row = 32 * mh + r32, chunk = 2 * (kq * 16 + st) + hi;
            const bf16x8 af = *(const LAS bf16x8*)(lds + row * 2048 + ((chunk ^ (row & 7)) << 4));
            const bf16x8 bfr = *(const GAS bf16x8*)(Wr_t + (size_t)r32 * D + chunk * 8);
            acc = __builtin_amdgcn_mfma_f32_32x32x16_bf16(af, bfr, acc, 0, 0, 0); }
        __syncthreads();
        LAS float* part = (LAS float*)lds;
#pragma unroll
        for (int r = 0; r < 16; ++r) { const int row = (r & 3) + 8 * (r >> 2) + 4 * hi; part[(wave * 32 + row) * 33 + r32] = acc[r]; }
        __syncthreads();
        for (int rd = 0; rd < 4; ++rd) {
            const int lt = rd * 16 + (tid >> 5), e = tid & 31, mh2 = lt >> 5, lrow = lt & 31;
            float v = a.b_router[e];
#pragma unroll
            for (int q = 0; q < 4; ++q) v += part[((q * 2 + mh2) * 32 + lrow) * 33 + e];
            float tv[4]; int ti[4];
#pragma unroll
            for (int r = 0; r < 4; ++r) { float bv = v; int bi = e;
#pragma unroll
                for (int o = 16; o > 0; o >>= 1) { const float ov = __shfl_xor(bv, o); const int oi = __shfl_xor(bi, o); if (ov > bv || (ov == bv && oi < bi)) { bv = ov; bi = oi; } }
                tv[r] = bv; ti[r] = bi; if (e == bi) v = -INFINITY; }
            if (e == 0) { const int m = tile * 64 + lt; float ex[4], sm = 0.f;
#pragma unroll
                for (int r = 0; r < 4; ++r) { ex[r] = expf(tv[r] - tv[0]); sm += ex[r]; }
#pragma unroll
                for (int r = 0; r < 4; ++r) { const int pos = atomicAdd(&cnt[ti[r]], 1); row_tok[ti[r] * CAP + pos] = m; row_gate[ti[r] * CAP + pos] = ex[r] / sm; slot[(m * 4 + r) * 2] = ti[r]; slot[(m * 4 + r) * 2 + 1] = pos; } }
        }
        __syncthreads();
    }
}

__device__ __forceinline__ void moe_setup(const Args& a, LAS unsigned char* lds, int tid) {
    LAS int* mts = (LAS int*)(lds + MTS_OFF); const int* cnt = (const int*)(a.ws + WS_CTL) + CW_CNT;
    if (tid == 0) { int s = 0; for (int e = 0; e < NE; ++e) { mts[e] = s; s += (cnt[e] + 255) >> 8; } mts[NE] = s; }
    __syncthreads();
}
__device__ __forceinline__ void moe_gtab(const Args& a, LAS unsigned char* lds, int tid, int u0, int u1, int NN) {
    LAS int* mts = (LAS int*)(lds + MTS_OFF); LAS unsigned* gtab = (LAS unsigned*)(lds + GTAB_OFF);
    const int* cnt = (const int*)(a.ws + WS_CTL) + CW_CNT; const int* row_tok = (const int*)(a.ws + WS_ROWTOK);
    for (int i = 0; i < u1 - u0 && i < GTAB_UNITS; ++i) {
        const int mt = (u0 + i) / NN; int e = 0;
        for (int k = 1; k < 32; ++k) e += (mts[k] <= mt) ? 1 : 0;
        const int r0 = (mt - mts[e]) * 256, c = cnt[e];
        if (tid < 256) { const int r = r0 + tid; const int tok = (r < c) ? row_tok[e * CAP + r] : 0; gtab[i * 256 + tid] = (unsigned)tok * (unsigned)(D * 2); }
    }
    __syncthreads();
}

__device__ __forceinline__ void p8_combine(const Args& a, LAS unsigned char* lds, int vcu, int G, int wave, int lane) {
    unsigned char* ws = a.ws; LAS int* mts = (LAS int*)(lds + MTS_OFF);
    const float* X1 = (const float*)(ws + WS_X1); float* X2 = (float*)(ws + WS_X2); bf16* H = (bf16*)(ws + WS_H); const bf16* YS = (const bf16*)(ws + WS_YS); const int* slot = (const int*)(ws + WS_SLOT);
    const int gw = vcu * NWAVES + wave, NGW = G * NWAVES;
    for (int m = gw; m < T; m += NGW) {
        const GAS f32x4* xr = (const GAS f32x4*)(X1 + (size_t)m * D) + lane;
        f32x4 v[4];
#pragma unroll
        for (int j = 0; j < 4; ++j) v[j] = xr[64 * j];
#pragma unroll
        for (int r = 0; r < 4; ++r) { const int e = slot[(m * 4 + r) * 2], pos = slot[(m * 4 + r) * 2 + 1]; const size_t prow = (size_t)mts[e] * 256 + pos;
            const GAS u32x2* yr = (const GAS u32x2*)(YS + prow * D) + lane;
#pragma unroll
            for (int j = 0; j < 4; ++j) { const u32x2 w = yr[64 * j]; v[j].x += __uint_as_float(w.x << 16); v[j].y += __uint_as_float(w.x & 0xffff0000u); v[j].z += __uint_as_float(w.y << 16); v[j].w += __uint_as_float(w.y & 0xffff0000u); } }
        float s = 0.f;
        GAS f32x4* xo = (GAS f32x4*)(X2 + (size_t)m * D) + lane;
#pragma unroll
        for (int j = 0; j < 4; ++j) { xo[64 * j] = v[j]; s += (v[j].x * v[j].x + v[j].y * v[j].y) + (v[j].z * v[j].z + v[j].w * v[j].w); }
        const float rs = 1.f / sqrtf(wave_sum(s) * (1.f / D) + EPS);
        GAS u32x2* o8 = (GAS u32x2*)(H + (size_t)m * D) + lane;
#pragma unroll
        for (int j = 0; j < 4; ++j) { const f32x4 gg = ((const GAS f32x4*)a.g_ple)[lane + 64 * j]; const f32x4 hv = v[j] * rs * gg; u32x2 w; w.x = pk2(hv.x, hv.y); w.y = pk2(hv.z, hv.w); o8[64 * j] = w; }
    }
}
__device__ __forceinline__ void p10_final(const Args& a, int vcu, int G, int wave, int lane) {
    const float* X3 = (const float*)(a.ws + WS_X2);
    const int gw = vcu * NWAVES + wave, NGW = G * NWAVES;
    for (int m = gw; m < T; m += NGW) {
        const GAS f32x4* xr = (const GAS f32x4*)(X3 + (size_t)m * D) + lane;
        f32x4 v[4]; float s = 0.f;
#pragma unroll
        for (int j = 0; j < 4; ++j) { v[j] = xr[64 * j]; s += (v[j].x * v[j].x + v[j].y * v[j].y) + (v[j].z * v[j].z + v[j].w * v[j].w); }
        const float rs = 1.f / sqrtf(wave_sum(s) * (1.f / D) + EPS);
        GAS f32x4* o = (GAS f32x4*)(a.out + (size_t)m * D) + lane;
#pragma unroll
        for (int j = 0; j < 4; ++j) { const f32x4 gg = ((const GAS f32x4*)a.g_final)[lane + 64 * j]; o[64 * j] = v[j] * rs * gg; }
    }
}


constexpr size_t SSD_XN = WS_TMP, SSD_XDT = WS_TMP + 16 * MiB, SSD_BN = WS_TMP + 32 * MiB, SSD_CN = WS_TMP + 40 * MiB, SSD_ST = WS_TMP + 48 * MiB, SSD_ACUM = WS_TMP + 64 * MiB, SSD_CD = WS_TMP + 65 * MiB;
static_assert(SSD_CD + 4096 <= WS_END, "ssd scratch");
typedef float f32x16 __attribute__((ext_vector_type(16)));
__device__ __forceinline__ int img_off(int row, int chunk) { return row * 272 + (chunk << 4); }
__device__ __forceinline__ float silu_fast(float v) { return v * __builtin_amdgcn_rcpf(1.f + __builtin_amdgcn_exp2f(-1.4426950408889634f * v)); }
__device__ __forceinline__ int crow16(int r, int hi) { return (r & 3) + 8 * (r >> 2) + 4 * hi; }

constexpr int SA_XT = 0, SA_BT = 69632, SA_ACUM = 104448, SA_WTS = 106496, SA_DTS = 108544;
template <int TYPE  > __device__ __forceinline__ void ssd_conv_patch(const Args& a, LAS unsigned char* lds, int unit, int g, int c, int t0, int cbl, int lb8) {
    const bf16* PJ = (const bf16*)(a.ws + WS_PJ);
    const int ch = (TYPE == 0 ? g * 256 : TYPE == 1 ? 512 + g * 128 : 768 + g * 128) + cbl * 8;
    const int l0 = lb8 * 8;
    v4u in[11];
#pragma unroll
    for (int i = 0; i < 11; ++i) { const int r = l0 - 3 + i; const bool ok = (c > 0) || (r >= 0);
        in[i] = ok ? *(const GAS v4u*)(PJ + (size_t)(t0 + r) * NPJ + 512 + ch) : (v4u){0u, 0u, 0u, 0u}; }
    f32x4 w[4][2], bia[2];
#pragma unroll
    for (int j = 0; j < 4; ++j) { w[j][0] = *(const GAS f32x4*)(a.conv_w + j * 1024 + ch); w[j][1] = *(const GAS f32x4*)(a.conv_w + j * 1024 + ch + 4); }
    bia[0] = *(const GAS f32x4*)(a.conv_b + ch); bia[1] = *(const GAS f32x4*)(a.conv_b + ch + 4);
    float wt[8], dtl[8];
    const int hl = cbl >> 3;
    if (TYPE == 0) {
#pragma unroll
        for (int li = 0; li < 8; ++li) { wt[li] = ((const LAS float*)(lds + SA_WTS))[hl * 128 + l0 + li]; dtl[li] = ((const LAS float*)(lds + SA_DTS))[hl * 128 + l0 + li]; } }
    v4u nat[8];
#pragma unroll
    for (int ep = 0; ep < 4; ++ep) {
        float o[2][8];
#pragma unroll
        for (int q = 0; q < 2; ++q) { const int e = 2 * ep + q;
            float xin[11];
#pragma unroll
            for (int i = 0; i < 11; ++i) { const unsigned wd = in[i][ep]; xin[i] = __uint_as_float(q ? (wd & 0xffff0000u) : (wd << 16)); }
            const float be = bia[e >> 2][e & 3];
#pragma unroll
            for (int li = 0; li < 8; ++li) { float acc = be;
#pragma unroll
                for (int j = 0; j < 4; ++j) acc += w[j][e >> 2][e & 3] * xin[li + j];
                o[q][li] = silu_fast(acc); }
            if (TYPE == 0) { const int pp = cbl * 8 + e;
                v4u pk; pk.x = pk2(o[q][0] * wt[0], o[q][1] * wt[1]); pk.y = pk2(o[q][2] * wt[2], o[q][3] * wt[3]); pk.z = pk2(o[q][4] * wt[4], o[q][5] * wt[5]); pk.w = pk2(o[q][6] * wt[6], o[q][7] * wt[7]);
                *(LAS v4u*)(lds + SA_XT + img_off(pp, lb8)) = pk;
                bf16* xd = (bf16*)(a.ws + SSD_XDT) + ((size_t)unit * 256 + pp) * 128 + 16 * (lb8 >> 1) + 4 * (lb8 & 1);
                u32x2 d0, d1; d0.x = pk2(o[q][0] * dtl[0], o[q][1] * dtl[1]); d0.y = pk2(o[q][2] * dtl[2], o[q][3] * dtl[3]); d1.x = pk2(o[q][4] * dtl[4], o[q][5] * dtl[5]); d1.y = pk2(o[q][6] * dtl[6], o[q][7] * dtl[7]);
                *(GAS u32x2*)xd = d0; *(GAS u32x2*)(xd + 8) = d1; }
            if (TYPE == 1) { const int n = cbl * 8 + e;
                v4u pk; pk.x = pk2(o[q][0], o[q][1]); pk.y = pk2(o[q][2], o[q][3]); pk.z = pk2(o[q][4], o[q][5]); pk.w = pk2(o[q][6], o[q][7]);
                *(LAS v4u*)(lds + SA_BT + img_off(n, lb8)) = pk; }
        }
#pragma unroll
        for (int li = 0; li < 8; ++li) nat[li][ep] = pk2(o[0][li], o[1][li]);
    }
    bf16* dst = TYPE == 0 ? (bf16*)(a.ws + SSD_XN) + ((size_t)unit * 128 + l0) * 256 + cbl * 8 : (bf16*)(a.ws + (TYPE == 1 ? SSD_BN : SSD_CN)) + ((size_t)unit * 128 + l0) * 128 + cbl * 8;
    const int pitch = TYPE == 0 ? 256 : 128;
#pragma unroll
    for (int li = 0; li < 8; ++li) *(GAS v4u*)(dst + li * pitch) = nat[li];
}
__device__ __forceinline__ void ssd_state_unit(const Args& a, LAS unsigned char* lds, int unit, int tid, int wave, int lane) {
    const int c = unit & 15, g = (unit >> 4) & 1, b = unit >> 5, t0 = b * SEQ + c * 128;
    const float* DT = (const float*)(a.ws + WS_DT);
    if (wave < 4) {
        const int h = 4 * g + wave; const float av = -expf(a.a_log[h]);
        const float d0 = DT[(size_t)(t0 + 2 * lane) * 8 + h], d1 = DT[(size_t)(t0 + 2 * lane + 1) * 8 + h];
        const float v0 = av * d0, v1 = av * d1; float sc = v0 + v1;
#pragma unroll
        for (int o = 1; o < 64; o <<= 1) { const float t = __shfl_up(sc, o); if (lane >= o) sc += t; }
        const float A0 = sc - v1, A1 = sc, tot = __shfl(sc, 63);
        LAS float* ac = (LAS float*)(lds + SA_ACUM) + wave * 128 + 2 * lane; LAS float* wt = (LAS float*)(lds + SA_WTS) + wave * 128 + 2 * lane; LAS float* dd = (LAS float*)(lds + SA_DTS) + wave * 128 + 2 * lane;
        ac[0] = A0; ac[1] = A1; wt[0] = d0 * expf(tot - A0); wt[1] = d1 * expf(tot - A1); dd[0] = d0; dd[1] = d1;
        float* ag = (float*)(a.ws + SSD_ACUM) + ((size_t)unit * 4 + wave) * 128 + 2 * lane; ag[0] = A0; ag[1] = A1;
        if (lane == 0) ((float*)(a.ws + SSD_CD))[unit * 4 + wave] = expf(tot);
    }
    __syncthreads();
    ssd_conv_patch<0>(a, lds, unit, g, c, t0, lane & 31, 2 * wave + (lane >> 5));
    if (wave < 4) ssd_conv_patch<1>(a, lds, unit, g, c, t0, lane & 15, 4 * wave + (lane >> 4));
    else ssd_conv_patch<2>(a, lds, unit, g, c, t0, lane & 15, 4 * (wave - 4) + (lane >> 4));
    __syncthreads();
    const int r32 = lane & 31, hi = lane >> 5, pp = 32 * wave + r32;
    bf16x8 bx[8];
#pragma unroll
    for (int ks = 0; ks < 8; ++ks) bx[ks] = *(const LAS bf16x8*)(lds + SA_XT + img_off(pp, 2 * ks + hi));
    bf16* st = (bf16*)(a.ws + SSD_ST) + ((size_t)unit * 256 + pp) * 128;
#pragma unroll
    for (int nb = 0; nb < 4; ++nb) {
        f32x16 acc = {};
#pragma unroll
        for (int ks = 0; ks < 8; ++ks) { const bf16x8 af = *(const LAS bf16x8*)(lds + SA_BT + img_off(32 * nb + r32, 2 * ks + hi)); acc = __builtin_amdgcn_mfma_f32_32x32x16_bf16(af, bx[ks], acc, 0, 0, 0); }
#pragma unroll
        for (int rg = 0; rg < 4; ++rg) { u32x2 w; w.x = pk2(acc[4 * rg], acc[4 * rg + 1]); w.y = pk2(acc[4 * rg + 2], acc[4 * rg + 3]); *(GAS u32x2*)(st + 32 * nb + 8 * rg + 4 * hi) = w; }
    }
    __syncthreads();
}

constexpr int SB_BN = 0, SB_CN = 34816, SB_ACUM = 69632, SB_SSQ = 71680, SB_RSTD = 75776;
__device__ __forceinline__ void ssd_out_unit(const Args& a, LAS unsigned char* lds, int unit, int tid, int wave, int lane) {
    const int c = unit & 15, g = (unit >> 4) & 1, b = unit >> 5, t0 = b * SEQ + c * 128;
    const int r32 = lane & 31, hi = lane >> 5, hl = wave >> 1, pp = 32 * wave + r32;
    for (int i = tid; i < 4096; i += NWAVES * 64) { const int im = i >> 11, idx = i & 2047, row = idx >> 4, ch = idx & 15;
        const v4u v = *(const GAS v4u*)((const bf16*)(a.ws + (im ? SSD_CN : SSD_BN)) + ((size_t)unit * 128 + row) * 128 + ch * 8);
        *(LAS v4u*)(lds + (im ? SB_CN : SB_BN) + img_off(row, ch)) = v; }
    ((LAS float*)(lds + SB_ACUM))[tid] = ((const float*)(a.ws + SSD_ACUM))[(size_t)unit * 512 + tid];
    bf16x8 pf[8];
    {
        float pv[8][8];
#pragma unroll
        for (int ks = 0; ks < 8; ++ks)
#pragma unroll
            for (int j = 0; j < 8; ++j) pv[ks][j] = 0.f;
        for (int cc = 0; cc < c; ++cc) { const int u2 = unit - c + cc; const float cd = ((const float*)(a.ws + SSD_CD))[u2 * 4 + hl];
            const bf16* sp = (const bf16*)(a.ws + SSD_ST) + ((size_t)u2 * 256 + pp) * 128 + 8 * hi;
#pragma unroll
            for (int ks = 0; ks < 8; ++ks) { const v4u s = *(const GAS v4u*)(sp + 16 * ks);
#pragma unroll
                for (int j = 0; j < 4; ++j) { pv[ks][2 * j] = pv[ks][2 * j] * cd + __uint_as_float(s[j] << 16); pv[ks][2 * j + 1] = pv[ks][2 * j + 1] * cd + __uint_as_float(s[j] & 0xffff0000u); } } }
#pragma unroll
        for (int ks = 0; ks < 8; ++ks) { v4u w; w.x = pk2(pv[ks][0], pv[ks][1]); w.y = pk2(pv[ks][2], pv[ks][3]); w.z = pk2(pv[ks][4], pv[ks][5]); w.w = pk2(pv[ks][6], pv[ks][7]); pf[ks] = __builtin_bit_cast(bf16x8, w); }
    }
    const bf16* xp = (const bf16*)(a.ws + SSD_XDT) + ((size_t)unit * 256 + pp) * 128 + 8 * hi;
    __syncthreads();
    const LAS float* acum = (const LAS float*)(lds + SB_ACUM) + hl * 128;
    f32x16 y[4];
#pragma unroll
    for (int lb = 0; lb < 4; ++lb) {
        f32x16 ao = {};
#pragma unroll
        for (int ks = 0; ks < 8; ++ks) { const bf16x8 bfr = *(const LAS bf16x8*)(lds + SB_CN + img_off(32 * lb + r32, 2 * ks + hi)); ao = __builtin_amdgcn_mfma_f32_32x32x16_bf16(pf[ks], bfr, ao, 0, 0, 0); }
        const float eL = __builtin_amdgcn_exp2f(1.4426950408889634f * acum[32 * lb + r32]);
#pragma unroll
        for (int r = 0; r < 16; ++r) y[lb][r] = eL * ao[r];
        __builtin_amdgcn_sched_barrier(0);
    }
#pragma unroll
    for (int lb = 0; lb < 4; ++lb) {
        const float AcL = acum[32 * lb + r32];
        f32x16 ay = y[lb];
#pragma unroll
        for (int sb = 0; sb < 4; ++sb) if (sb <= lb) {
            f32x16 cbt = {};
#pragma unroll
            for (int ks = 0; ks < 8; ++ks) { const bf16x8 af = *(const LAS bf16x8*)(lds + SB_BN + img_off(32 * sb + r32, 2 * ks + hi)); const bf16x8 bfr = *(const LAS bf16x8*)(lds + SB_CN + img_off(32 * lb + r32, 2 * ks + hi));
                cbt = __builtin_amdgcn_mfma_f32_32x32x16_bf16(af, bfr, cbt, 0, 0, 0); }
            float m[16];
#pragma unroll
            for (int rg = 0; rg < 4; ++rg) { const f32x4 as = *(const LAS f32x4*)(acum + 32 * sb + 8 * rg + 4 * hi);
#pragma unroll
                for (int q = 0; q < 4; ++q) { const int r = 4 * rg + q; float v = cbt[r] * __builtin_amdgcn_exp2f(1.4426950408889634f * (AcL - as[q]));
                    if (sb == lb) v = (8 * rg + 4 * hi + q <= r32) ? v : 0.f;
                    m[r] = v; } }
            v4u w0, w1; w0.x = pk2(m[0], m[1]); w0.y = pk2(m[2], m[3]); w0.z = pk2(m[4], m[5]); w0.w = pk2(m[6], m[7]); w1.x = pk2(m[8], m[9]); w1.y = pk2(m[10], m[11]); w1.z = pk2(m[12], m[13]); w1.w = pk2(m[14], m[15]);
            const bf16x8 xa0 = *(const GAS bf16x8*)(xp + 32 * sb), xa1 = *(const GAS bf16x8*)(xp + 32 * sb + 16);
            ay = __builtin_amdgcn_mfma_f32_32x32x16_bf16(xa0, __builtin_bit_cast(bf16x8, w0), ay, 0, 0, 0);
            ay = __builtin_amdgcn_mfma_f32_32x32x16_bf16(xa1, __builtin_bit_cast(bf16x8, w1), ay, 0, 0, 0);
            __builtin_amdgcn_sched_barrier(0);
        }
        y[lb] = ay;
        __builtin_amdgcn_sched_barrier(0);
    }
    const float dsk = a.d_skip[4 * g + hl];
    const bf16* PJ = (const bf16*)(a.ws + WS_PJ); const bf16* XN = (const bf16*)(a.ws + SSD_XN) + (size_t)unit * 128 * 256;
    LAS float* ssq = (LAS float*)(lds + SB_SSQ);
#pragma unroll
    for (int lb = 0; lb < 4; ++lb) { const int l = 32 * lb + r32; float s = 0.f;
#pragma unroll
        for (int rg = 0; rg < 4; ++rg) { const int p0 = 32 * wave + 8 * rg + 4 * hi;
            const u32x2 xw = *(const GAS u32x2*)(XN + (size_t)l * 256 + p0); const u32x2 zw = *(const GAS u32x2*)(PJ + (size_t)(t0 + l) * NPJ + g * 256 + p0);
            const float xv[4] = {__uint_as_float(xw.x << 16), __uint_as_float(xw.x & 0xffff0000u), __uint_as_float(xw.y << 16), __uint_as_float(xw.y & 0xffff0000u)};
            const float zv[4] = {__uint_as_float(zw.x << 16), __uint_as_float(zw.x & 0xffff0000u), __uint_as_float(zw.y << 16), __uint_as_float(zw.y & 0xffff0000u)};
#pragma unroll
            for (int q = 0; q < 4; ++q) { const float v = (y[lb][4 * rg + q] + dsk * xv[q]) * silu_fast(zv[q]); y[lb][4 * rg + q] = v; s += v * v; } }
        s += __shfl_xor(s, 32);
        if (hi == 0) ssq[wave * 128 + l] = s;
        __builtin_amdgcn_sched_barrier(0); }
    __syncthreads();
    if (tid < 128) { float s = 0.f;
#pragma unroll
        for (int w = 0; w < 8; ++w) s += ssq[w * 128 + tid];
        ((LAS float*)(lds + SB_RSTD))[tid] = 1.f / sqrtf(s * (1.f / 256.f) + 1e-5f); }
    __syncthreads();
    bf16* YC = (bf16*)(a.ws + WS_YC);
#pragma unroll
    for (int lb = 0; lb < 4; ++lb) { const int l = 32 * lb + r32; const float rs = ((const LAS float*)(lds + SB_RSTD))[l];
#pragma unroll
        for (int rg = 0; rg < 4; ++rg) { const int p0 = 32 * wave + 8 * rg + 4 * hi; const f32x4 nw = *(const GAS f32x4*)(a.ssd_norm_w + g * 256 + p0);
            u32x2 w; w.x = pk2(y[lb][4 * rg] * rs * nw.x, y[lb][4 * rg + 1] * rs * nw.y); w.y = pk2(y[lb][4 * rg + 2] * rs * nw.z, y[lb][4 * rg + 3] * rs * nw.w);
            *(GAS u32x2*)(YC + (size_t)(t0 + l) * 1024 + g * 256 + p0) = w; } }
    __syncthreads();
}
__device__ __forceinline__ void attn_post(const Args& a, int vcu, int G, int wave, int lane) {
    bf16* YC = (bf16*)(a.ws + WS_YC); const bf16* O = (const bf16*)(a.ws + WS_O);
    const int gw = vcu * NWAVES + wave, NGW = G * NWAVES;
    const float lam = expf(wave_sum(a.lq1[lane] * a.lk1[lane])) - expf(wave_sum(a.lq2[lane] * a.lk2[lane])) + LAM_INIT;
    for (int w = gw; w < T * 4; w += NGW) { const int t = w >> 2, h = w & 3;
        const bf16* o = O + (size_t)t * 1024 + h * 256;
        const float a0 = bf2f(o[lane]) - lam * bf2f(o[128 + lane]), a1 = bf2f(o[64 + lane]) - lam * bf2f(o[192 + lane]);
        const float r = (1.f - LAM_INIT) / sqrtf(wave_sum(a0 * a0 + a1 * a1) * (1.f / 128.f) + 1e-5f);
        YC[(size_t)t * 1024 + 512 + h * 128 + lane] = (bf16)f2bf(a0 * r * a.subln_w[lane]);
        YC[(size_t)t * 1024 + 512 + h * 128 + 64 + lane] = (bf16)f2bf(a1 * r * a.subln_w[64 + lane]); }
}

constexpr int NPHASE = 11;
__global__ void __launch_bounds__(NWAVES * 64, 2) mk_fwd(Args a) {
    extern __shared__ __attribute__((aligned(16))) unsigned char lds_raw[];
    LAS unsigned char* lds = (LAS unsigned char*)lds_raw;
    const int tid0 = threadIdx.x;
    const int G = gridDim.x; const int bx = blockIdx.x; const int vcu = (G % 8 == 0) ? (bx % 8) * (G / 8) + bx / 8 : bx;
    unsigned char* ws = a.ws; gu32* ctl = (gu32*)(ws + WS_CTL);
    for (int u = tid0; u < (LDS_BYTES - LDSCTL_OFF) / 4; u += NWAVES * 64) ((LAS unsigned*)(lds + LDSCTL_OFF))[u] = 0u;
    __syncthreads();
    volatile LAS unsigned* MISC = (volatile LAS unsigned*)(lds + MISC_OFF);
    XcdBarrier bar; bar.bar = (unsigned*)(ctl + CW_BAR); bar.x = 0; bar.st = nullptr;
    if (a.use_bar) bar = xcd_barrier_post((unsigned*)(ctl + CW_BAR), MISC + 8);
    const int lo = a.ph_lo, hi = a.ph_hi;
#define IN(k) (lo <= (k) && (k) < hi)
#define IDS() int tid = threadIdx.x; asm volatile("" : "+v"(tid)); const int lane = tid & 63, wave = __builtin_amdgcn_readfirstlane(tid >> 6); (void)lane; (void)wave
#define SEAM(k) do { if (IN(k) && IN((k) + 1)) xcd_barrier(bar); } while (0)
    const LAS unsigned* gtab = (const LAS unsigned*)(lds + GTAB_OFF);
    bf16* H = (bf16*)(ws + WS_H); bf16* PJ = (bf16*)(ws + WS_PJ);

    if (IN(0)) { IDS(); p0_prologue(a, lds, vcu, G, wave, lane, tid); SEAM(0); }
    if (IN(1)) {
        { pg8::DenseOrder S; S.init(H, ws + WS_WIN, T, NPJ, D, G, bx); pg8::EpiBf16S E{PJ, NPJ, 6, 8, attn_body::C2};
          pg8::gemm_phase<pg8::EpiBf16S, pg8::DenseOrder, false, true, true>(lds + RING_OFF, D, S, E, gtab); }
        { pg8::DenseOrder S; S.init(ws + WS_P16, ws + WS_WP, T, D, PLE, G, bx); pg8::EpiBf16S E{(bf16*)(ws + WS_PP), D, 0, 0, 1.f};
          pg8::gemm_phase<pg8::EpiBf16S, pg8::DenseOrder, false, true, true>(lds + RING_OFF, PLE, S, E, gtab); }
        SEAM(1);
    }
    if (IN(2)) {
        IDS();
        for (int unit = vcu; unit < 256; unit += G) ssd_state_unit(a, lds, unit, tid, wave, lane);
        const attn_body::AttnTensors AT{(const attn_body::bf16*)PJ, (attn_body::bf16*)(ws + WS_O)};
        const attn_body::StaticOrder S(vcu);
        attn_body::attn_phase<attn_body::StaticOrder>((char*)lds_raw + RING_OFF, AT, S);
        SEAM(2);
    }
    if (IN(3)) {
        IDS();
        for (int unit = vcu; unit < 256; unit += G) ssd_out_unit(a, lds, unit, tid, wave, lane);
        attn_post(a, vcu, G, wave, lane);
        SEAM(3);
    }
    if (IN(4)) {
        pg8::DenseOrder S; S.init(ws + WS_YC, ws + WS_WOUT, T, D, D, G, bx); pg8::EpiResF32 E{a.x, (float*)(ws + WS_X1), D};
        pg8::gemm_phase<pg8::EpiResF32, pg8::DenseOrder, false, false, true>(lds + RING_OFF, D, S, E, gtab);
        SEAM(4);
    }
    if (IN(5)) { IDS(); p5_router(a, lds, vcu, G, wave, lane, tid); SEAM(5); }
    if (IN(6)) {
        IDS(); moe_setup(a, lds, tid);
        const LAS int* mts = (const LAS int*)(lds + MTS_OFF); const int NN = FF2 / 256, U = mts[NE] * NN;
        const int u0 = (int)((long)vcu * U / G), u1 = (int)((long)(vcu + 1) * U / G);
        moe_gtab(a, lds, tid, u0, u1, NN);
        pg8::MoeOrder S{mts, (const char*)H, (const char*)(ws + WS_WUP), (size_t)256 * D * 2, (size_t)FF2 * D * 2, NN, u0, u1, 1};
        pg8::EpiMoeUp E{(bf16*)(ws + WS_ACT), a.b_up};
        pg8::gemm_phase<pg8::EpiMoeUp, pg8::MoeOrder, true, true, true>(lds + RING_OFF, D, S, E, gtab);
        SEAM(6);
    }
    if (IN(7)) {
        IDS(); moe_setup(a, lds, tid);
        const LAS int* mts = (const LAS int*)(lds + MTS_OFF); const int NN = D / 256, U = mts[NE] * NN;
        const int u0 = (int)((long)vcu * U / G), u1 = (int)((long)(vcu + 1) * U / G);
        pg8::MoeOrder S{mts, (const char*)(ws + WS_ACT), (const char*)(ws + WS_WDN), (size_t)256 * D * 2, (size_t)D * D * 2, NN, u0, u1, 0};
        pg8::EpiMoeDown E{(bf16*)(ws + WS_YS), a.b_down, (const float*)(ws + WS_ROWGATE)};
        pg8::gemm_phase<pg8::EpiMoeDown, pg8::MoeOrder, false, true, true>(lds + RING_OFF, D, S, E, gtab);
        SEAM(7);
    }
    if (IN(8)) { IDS(); moe_setup(a, lds, tid); p8_combine(a, lds, vcu, G, wave, lane); SEAM(8); }
    if (IN(9)) {
        pg8::DenseOrder S; S.init(H, ws + WS_WG, T, D, D, G, bx); pg8::EpiPle E{(const float*)(ws + WS_X2), (const bf16*)(ws + WS_PP), (float*)(ws + WS_X2), D};
        pg8::gemm_phase<pg8::EpiPle, pg8::DenseOrder, false, false, true>(lds + RING_OFF, D, S, E, gtab);
        SEAM(9);
    }
    if (IN(10)) { IDS(); p10_final(a, vcu, G, wave, lane); }
#undef IN
#undef IDS
#undef SEAM
}

extern "C" void kernel_launch(void* const* d_in, const int* in_sizes, int n_in, void* d_out, int out_size, void* d_ws, size_t ws_size, hipStream_t stream) {
    static int grid = 0;
    if (grid == 0) {
        int dev = 0, cus = 0, per_cu = 0;
        if (n_in != 27 || out_size != T * D || ws_size < WS_END) { fprintf(stderr, "kernel_launch: unexpected shapes (n_in %d out %d ws %zu)\n", n_in, out_size, ws_size); grid = -1; return; }
        if (hipGetDevice(&dev) != hipSuccess || hipDeviceGetAttribute(&cus, hipDeviceAttributeMultiprocessorCount, dev) != hipSuccess) { grid = -1; return; }
        if (hipFuncSetAttribute((const void*)mk_fwd, hipFuncAttributeMaxDynamicSharedMemorySize, LDS_BYTES) != hipSuccess) { fprintf(stderr, "kernel_launch: hipFuncSetAttribute failed\n"); grid = -1; return; }
        if (hipOccupancyMaxActiveBlocksPerMultiprocessor(&per_cu, (const void*)mk_fwd, NWAVES * 64, LDS_BYTES) != hipSuccess || per_cu < 1) { fprintf(stderr, "kernel_launch: occupancy query says %d blocks per CU\n", per_cu); (void)hipGetLastError(); grid = -1; return; }
        grid = cus;
    }
    if (grid < 0) return;
    if (hipMemsetAsync((char*)d_ws + WS_CTL, 0, CTL_ZERO_BYTES, stream) != hipSuccess) return;
    Args a{};
    const float** ap = (const float**)&a;
    for (int i = 0; i < 27; ++i) ap[i] = (const float*)d_in[i];
    a.out = (float*)d_out; a.ws = (unsigned char*)d_ws; a.use_bar = 0; a.pad = 0;
    a.use_bar = 1; a.ph_lo = 0; a.ph_hi = NPHASE;
    hipLaunchKernelGGL(mk_fwd, dim3(grid), dim3(NWAVES * 64), LDS_BYTES, stream, a);
}
```

```cpp
#include <hip/hip_runtime.h>
#include <cstdio>
#include <cstdint>
namespace pg8 {
#define PG8_LAS __attribute__((address_space(3)))
typedef unsigned short bf16_t;
typedef short bf16x8 __attribute__((ext_vector_type(8)));
typedef float f32x4 __attribute__((ext_vector_type(4)));
typedef unsigned u32x4 __attribute__((ext_vector_type(4)));
constexpr int BM = 256, BK = 64, HALF = 128, HTB = HALF * BK * 2  , STAGE_BYTES = 8 * HTB, NXCD = 8, WGM = 8;

__host__ __device__ __forceinline__ int lds_byte(int r, int c) { const int st = (r >> 4) * 2 + (c >> 5), rr = r & 15, cc = c & 31, ob = rr * 64 + cc * 2; return st * 1024 + (ob ^ (((ob >> 9) & 1) << 5)); }
__host__ __device__ __forceinline__ void stage_rc(int b, int& R, int& C) { const int st = b / 1024, sb = b % 1024, swz = sb ^ (((sb >> 9) & 1) << 5); R = (st >> 1) * 16 + swz / 64; C = (st & 1) * 32 + (swz % 64) / 2; }
__host__ __device__ __forceinline__ int perm32(int rho) { const int n = rho >> 4, i = rho & 15; return 8 * (i >> 2) + 4 * n + (i & 3); }


struct Unit { int pm, pn, e, r0; };
__device__ __forceinline__ unsigned cvt_pk_bf16(float lo, float hi) { unsigned r; asm volatile("v_cvt_pk_bf16_f32 %0, %1, %2" : "=v"(r) : "v"(lo), "v"(hi)); return r; }

struct DenseOrder {
    const char* A; const char* Bt; size_t tstep; int nM, nN, nwg, G, c;
    __device__ __forceinline__ void init(const void* A_, const void* Bt_, int M, int N, int K, int G_, int c_) { A = (const char*)A_; Bt = (const char*)Bt_; tstep = (size_t)BM * K * 2; nM = M / BM; nN = N / BM; nwg = nM * nN; G = G_; c = c_; }
    __device__ __forceinline__ bool next(int i, Unit& u) const {
        const long L = (long)i * G + c; if (L >= nwg) return false;
        int wgid = (int)L; { const int q = nwg / NXCD, r = nwg % NXCD, xcd = wgid % NXCD, off = wgid / NXCD; wgid = (xcd < r ? xcd * (q + 1) : r * (q + 1) + (xcd - r) * q) + off; }
        const int nig = WGM * nN, gid = wgid / nig, fm = gid * WGM, gsz = (nM - fm) < WGM ? (nM - fm) : WGM;
        u.pm = __builtin_amdgcn_readfirstlane(fm + ((wgid % nig) % gsz)); u.pn = __builtin_amdgcn_readfirstlane((wgid % nig) / gsz); u.e = 0; u.r0 = 0; return true;
    }
    __device__ __forceinline__ const char* a_ptr(const Unit& u) const { return A + (size_t)u.pm * tstep; }
    __device__ __forceinline__ const char* b_ptr(const Unit& u) const { return Bt + (size_t)u.pn * tstep; }
    __device__ __forceinline__ void a_ready(const Unit&) const {}
    __device__ __forceinline__ void done(const Unit&) const {}
};
struct MoeOrder {
    const PG8_LAS int* mts; const char* A; const char* Bt; size_t tstep, bexp; int NN, u0, u1, gather;
    __device__ __forceinline__ bool next(int i, Unit& u) const {
        const int idx = u0 + i; if (idx >= u1) return false;
        const int mt = __builtin_amdgcn_readfirstlane(idx / NN); u.pn = idx - mt * NN; u.pm = mt;
        int e = 0;
        for (int k = 1; k < 32; ++k) e += (__builtin_amdgcn_readfirstlane(mts[k]) <= mt) ? 1 : 0;
        u.e = e; u.r0 = (mt - __builtin_amdgcn_readfirstlane(mts[e])) * BM; return true;
    }
    __device__ __forceinline__ const char* a_ptr(const Unit& u) const { return gather ? A : A + (size_t)u.pm * tstep; }
    __device__ __forceinline__ const char* b_ptr(const Unit& u) const { return Bt + (size_t)u.e * bexp + (size_t)u.pn * tstep; }
    __device__ __forceinline__ void a_ready(const Unit&) const {}
    __device__ __forceinline__ void done(const Unit&) const {}
};

struct EpiBf16S {
    static constexpr bool PERM = true, AFTER_DRAIN = false;
    bf16_t* O; int ldc; int st0, st1; float scale;
    __device__ __forceinline__ void operator()(const f32x4 (&acc)[2][2][4][2], const Unit& u, int wr, int wc, int fr, int fq) const {
        const int row0 = u.pm * BM + wr * 64 + fr, col0 = u.pn * BM + wc * 32 + 8 * fq;
        const float sc = (u.pn >= st0 && u.pn < st1) ? scale : 1.f;
#pragma unroll
        for (int ai = 0; ai < 2; ++ai)
#pragma unroll
            for (int m = 0; m < 4; ++m) { bf16_t* rowp = O + (size_t)(row0 + ai * HALF + m * 16) * ldc + col0;
#pragma unroll
                for (int bj = 0; bj < 2; ++bj) { const f32x4 v0 = acc[ai][bj][m][0] * sc, v1 = acc[ai][bj][m][1] * sc;
                    u32x4 w; w.x = cvt_pk_bf16(v0[0], v0[1]); w.y = cvt_pk_bf16(v0[2], v0[3]); w.z = cvt_pk_bf16(v1[0], v1[1]); w.w = cvt_pk_bf16(v1[2], v1[3]);
                    *(u32x4*)(rowp + bj * HALF) = w; } }
    }
};
struct EpiResF32 {
    static constexpr bool PERM = false, AFTER_DRAIN = false;
    const float* base; float* out; int ldc;
    __device__ __forceinline__ void operator()(const f32x4 (&acc)[2][2][4][2], const Unit& u, int wr, int wc, int fr, int fq) const {
        const int row0 = u.pm * BM + wr * 64 + fr, col0 = u.pn * BM + wc * 32 + 4 * fq;
#pragma unroll
        for (int ai = 0; ai < 2; ++ai)
#pragma unroll
            for (int m = 0; m < 4; ++m) { const size_t off = (size_t)(row0 + ai * HALF + m * 16) * ldc + col0;
#pragma unroll
                for (int bj = 0; bj < 2; ++bj)
#pragma unroll
                    for (int n = 0; n < 2; ++n) { const f32x4 b = *(const f32x4*)(base + off + bj * HALF + n * 16); *(f32x4*)(out + off + bj * HALF + n * 16) = b + acc[ai][bj][m][n]; } }
    }
};
__device__ __forceinline__ float sigm_fast(float v) { return __builtin_amdgcn_rcpf(1.f + __builtin_amdgcn_exp2f(-1.4426950408889634f * v)); }
struct EpiPle {
    static constexpr bool PERM = false, AFTER_DRAIN = false;
    const float* base; const bf16_t* pp; float* out; int ldc;
    __device__ __forceinline__ void operator()(const f32x4 (&acc)[2][2][4][2], const Unit& u, int wr, int wc, int fr, int fq) const {
        typedef unsigned u32x2 __attribute__((ext_vector_type(2)));
        const int row0 = u.pm * BM + wr * 64 + fr, col0 = u.pn * BM + wc * 32 + 4 * fq;
#pragma unroll
        for (int ai = 0; ai < 2; ++ai)
#pragma unroll
            for (int m = 0; m < 4; ++m) { const size_t off = (size_t)(row0 + ai * HALF + m * 16) * ldc + col0;
#pragma unroll
                for (int bj = 0; bj < 2; ++bj)
#pragma unroll
                    for (int n = 0; n < 2; ++n) { const size_t o2 = off + bj * HALF + n * 16; const f32x4 b = *(const f32x4*)(base + o2); const u32x2 pw = *(const u32x2*)(pp + o2); const f32x4 a = acc[ai][bj][m][n];
                        f32x4 r; r[0] = b[0] + __uint_as_float(pw.x << 16) * sigm_fast(a[0]); r[1] = b[1] + __uint_as_float(pw.x & 0xffff0000u) * sigm_fast(a[1]);
                        r[2] = b[2] + __uint_as_float(pw.y << 16) * sigm_fast(a[2]); r[3] = b[3] + __uint_as_float(pw.y & 0xffff0000u) * sigm_fast(a[3]);
                        *(f32x4*)(out + o2) = r; } }
    }
};
struct EpiMoeUp {
    static constexpr bool PERM = true, AFTER_DRAIN = false;
    bf16_t* act; const float* bias;
    __device__ __forceinline__ void operator()(const f32x4 (&acc)[2][2][4][2], const Unit& u, int wr, int wc, int fr, int fq) const {
        typedef unsigned u32x2 __attribute__((ext_vector_type(2)));
        const int row0 = u.pm * BM + wr * 64 + fr, col0 = u.pn * BM + wc * 32 + 8 * fq;
        const float* bp = bias + (size_t)u.e * 2048 + col0;
        f32x4 bv[2][2];
#pragma unroll
        for (int bj = 0; bj < 2; ++bj)
#pragma unroll
            for (int n = 0; n < 2; ++n) bv[bj][n] = *(const f32x4*)(bp + bj * HALF + 4 * n);
#pragma unroll
        for (int ai = 0; ai < 2; ++ai)
#pragma unroll
            for (int m = 0; m < 4; ++m) { bf16_t* rowp = act + (size_t)(row0 + ai * HALF + m * 16) * 1024 + (col0 >> 1);
#pragma unroll
                for (int bj = 0; bj < 2; ++bj) { const f32x4 v0 = acc[ai][bj][m][0] + bv[bj][0], v1 = acc[ai][bj][m][1] + bv[bj][1];
                    float o[4];
#pragma unroll
                    for (int q = 0; q < 4; ++q) { const float g = fminf(q < 2 ? v0[2 * q] : v1[2 * q - 4], 7.f); const float up = fminf(fmaxf(q < 2 ? v0[2 * q + 1] : v1[2 * q - 3], -7.f), 7.f);
                        o[q] = (up + 1.f) * g * sigm_fast(1.702f * g); }
                    u32x2 w; w.x = cvt_pk_bf16(o[0], o[1]); w.y = cvt_pk_bf16(o[2], o[3]);
                    *(u32x2*)(rowp + bj * (HALF / 2)) = w; } }
    }
};
struct EpiMoeDown {
    static constexpr bool PERM = true, AFTER_DRAIN = false;
    bf16_t* ys; const float* bias; const float* row_gate;
    __device__ __forceinline__ void operator()(const f32x4 (&acc)[2][2][4][2], const Unit& u, int wr, int wc, int fr, int fq) const {
        const int lrow0 = wr * 64 + fr, col0 = u.pn * BM + wc * 32 + 8 * fq;
        const float* bp = bias + (size_t)u.e * 1024 + col0; const float* gp = row_gate + (size_t)u.e * 16384 + u.r0;
        f32x4 bv[2][2];
#pragma unroll
        for (int bj = 0; bj < 2; ++bj)
#pragma unroll
            for (int n = 0; n < 2; ++n) bv[bj][n] = *(const f32x4*)(bp + bj * HALF + 4 * n);
#pragma unroll
        for (int ai = 0; ai < 2; ++ai)
#pragma unroll
            for (int m = 0; m < 4; ++m) { const int lr = lrow0 + ai * HALF + m * 16; const float g = gp[lr]; bf16_t* rowp = ys + (size_t)(u.pm * BM + lr) * 1024 + col0;
#pragma unroll
                for (int bj = 0; bj < 2; ++bj) { const f32x4 v0 = (acc[ai][bj][m][0] + bv[bj][0]) * g, v1 = (acc[ai][bj][m][1] + bv[bj][1]) * g;
                    u32x4 w; w.x = cvt_pk_bf16(v0[0], v0[1]); w.y = cvt_pk_bf16(v0[2], v0[3]); w.z = cvt_pk_bf16(v1[0], v1[1]); w.w = cvt_pk_bf16(v1[2], v1[3]);
                    *(u32x4*)(rowp + bj * HALF) = w; } }
    }
};

__device__ __forceinline__ unsigned pk4_fp8(float a, float b, float c, float d) { unsigned u = __builtin_amdgcn_cvt_pk_fp8_f32(a, b, 0u, false); return __builtin_amdgcn_cvt_pk_fp8_f32(c, d, u, true); }
constexpr float W8_SCALE = 64.f, W8_INV = 1.f / 64.f;
struct EpiMoeUp8 {
    static constexpr bool PERM = true, AFTER_DRAIN = false;
    unsigned char* act; const float* bias;
    __device__ __forceinline__ void operator()(const f32x4 (&acc)[2][2][4][2], const Unit& u, int wr, int wc, int fr, int fq) const {
        const int row0 = u.pm * BM + wr * 64 + fr, col0 = u.pn * BM + wc * 32 + 8 * fq;
        const float* bp = bias + (size_t)u.e * 2048 + col0;
        f32x4 bv[2][2];
#pragma unroll
        for (int bj = 0; bj < 2; ++bj)
#pragma unroll
            for (int n = 0; n < 2; ++n) bv[bj][n] = *(const f32x4*)(bp + bj * HALF + 4 * n);
#pragma unroll
        for (int ai = 0; ai < 2; ++ai)
#pragma unroll
            for (int m = 0; m < 4; ++m) { unsigned char* rowp = act + (size_t)(row0 + ai * HALF + m * 16) * 1024 + (col0 >> 1);
#pragma unroll
                for (int bj = 0; bj < 2; ++bj) { const f32x4 v0 = acc[ai][bj][m][0] * W8_INV + bv[bj][0], v1 = acc[ai][bj][m][1] * W8_INV + bv[bj][1];
                    float o[4];
#pragma unroll
                    for (int q = 0; q < 4; ++q) { const float g = fminf(q < 2 ? v0[2 * q] : v1[2 * q - 4], 7.f); const float up = fminf(fmaxf(q < 2 ? v0[2 * q + 1] : v1[2 * q - 3], -7.f), 7.f);
                        o[q] = (up + 1.f) * g * sigm_fast(1.702f * g); }
                    *(unsigned*)(rowp + bj * (HALF / 2)) = pk4_fp8(o[0], o[1], o[2], o[3]); } }
    }
};
struct EpiMoeDown8 {
    static constexpr bool PERM = true, AFTER_DRAIN = false;
    bf16_t* ys; const float* bias; const float* row_gate;
    __device__ __forceinline__ void operator()(const f32x4 (&acc)[2][2][4][2], const Unit& u, int wr, int wc, int fr, int fq) const {
        int lrow0 = wr * 64 + fr; asm volatile("" : "+v"(lrow0));
        const int col0 = u.pn * BM + wc * 32 + 8 * fq;
        const float* bp = bias + (size_t)u.e * 1024 + col0; const float* gp = row_gate + (size_t)u.e * 16384 + u.r0;
#pragma unroll
        for (int bj = 0; bj < 2; ++bj) {
            const f32x4 b0 = *(const f32x4*)(bp + bj * HALF), b1 = *(const f32x4*)(bp + bj * HALF + 4);
#pragma unroll
            for (int ai = 0; ai < 2; ++ai)
#pragma unroll
                for (int m = 0; m < 4; ++m) { const int lr = lrow0 + ai * HALF + m * 16; const float g = gp[lr], g64 = g * W8_INV; bf16_t* rowp = ys + (size_t)(u.pm * BM + lr) * 1024 + col0 + bj * HALF;
                    const f32x4 v0 = acc[ai][bj][m][0] * g64 + b0 * g, v1 = acc[ai][bj][m][1] * g64 + b1 * g;
                    u32x4 w; w.x = cvt_pk_bf16(v0[0], v0[1]); w.y = cvt_pk_bf16(v0[2], v0[3]); w.z = cvt_pk_bf16(v1[0], v1[1]); w.w = cvt_pk_bf16(v1[2], v1[3]);
                    *(u32x4*)rowp = w; }
            asm volatile("" ::: "memory");
        }
    }
};

typedef int i32x4 __attribute__((ext_vector_type(4))); typedef int i32x8 __attribute__((ext_vector_type(8)));
__device__ __forceinline__ i32x8 cat8(bf16x8 a, bf16x8 b) { const i32x4 x = __builtin_bit_cast(i32x4, a), y = __builtin_bit_cast(i32x4, b); return __builtin_shufflevector(x, y, 0, 1, 2, 3, 4, 5, 6, 7); }
template <class Epi, class Sched, bool GATHER = false, bool ALIGN_EPI = false, bool SP2 = false, bool F8 = false>
__device__ __forceinline__ void gemm_phase(PG8_LAS unsigned char* lds, const int K, const Sched& S, const Epi& E, const PG8_LAS unsigned* gtab) {
    const int tid = threadIdx.x, wid = __builtin_amdgcn_readfirstlane(tid >> 6), lane = tid & 63, wr = wid >> 2, wc = wid & 3, fr = lane & 15, fq = lane >> 4;
    const int nt = F8 ? K / (2 * BK) : K / BK;
    unsigned voffA[2][2], voffB[2];
#pragma unroll
    for (int i = 0; i < 2; ++i) { int R, C; stage_rc(tid * 16 + i * 8192, R, C); const int Rb = Epi::PERM ? ((R & ~31) + perm32(R & 31)) : R;
        const unsigned pb = F8 ? (unsigned)K : 2u * (unsigned)K;
        voffA[0][i] = (unsigned)R * pb + (unsigned)C * 2u; voffA[1][i] = voffA[0][i]; voffB[i] = (unsigned)Rb * pb + (unsigned)C * 2u; }
#define PG8_GLOAD(UI) do { _Pragma("unroll") for (int _i = 0; _i < 2; ++_i) { int R_, C_; stage_rc(tid * 16 + _i * 8192, R_, C_); \
        voffA[0][_i] = gtab[(UI) * 256 + R_] + (unsigned)C_ * 2u; voffA[1][_i] = gtab[(UI) * 256 + HALF + R_] + (unsigned)C_ * 2u; } } while (0)
    const size_t kstep = (size_t)(BK * 2);
    const size_t hstep = (size_t)HALF * K * (F8 ? 1 : 2);
    const size_t hstA = GATHER ? (size_t)0 : hstep;
    const size_t tstep = 2 * hstep;
    const unsigned ldsw = (unsigned)wid * 1024u;
    const int aoff = lds_byte(wr * 64 + fr, fq * 8), boff = lds_byte(wc * 32 + fr, fq * 8);
#define PG8_SA(b, h) (((b) * 2 + (h)) * HTB)
#define PG8_SB(b, h) ((4 + (b) * 2 + (h)) * HTB)
#define PG8_STAGE(bufoff, gbase, voff) do { _Pragma("unroll") for (int _i = 0; _i < 2; ++_i) \
        __builtin_amdgcn_global_load_lds((const unsigned*)((const char*)(gbase) + (voff)[_i]), (PG8_LAS unsigned*)(lds + (bufoff) + ldsw + _i * 8192), 16, 0, 0); } while (0)
#define PG8_LDA(dst, b, h) do { _Pragma("unroll") for (int m = 0; m < 4; ++m) dst[m] = cat8(*(const PG8_LAS bf16x8*)(lds + PG8_SA(b, h) + aoff + m * 2048), *(const PG8_LAS bf16x8*)(lds + PG8_SA(b, h) + aoff + m * 2048 + 1024)); } while (0)
#define PG8_LDB(dst, b, h) do { _Pragma("unroll") for (int n = 0; n < 2; ++n) dst[n] = cat8(*(const PG8_LAS bf16x8*)(lds + PG8_SB(b, h) + boff + n * 2048), *(const PG8_LAS bf16x8*)(lds + PG8_SB(b, h) + boff + n * 2048 + 1024)); } while (0)
#define PG8_LO(v) __builtin_bit_cast(bf16x8, __builtin_shufflevector(v, v, 0, 1, 2, 3))
#define PG8_HI(v) __builtin_bit_cast(bf16x8, __builtin_shufflevector(v, v, 4, 5, 6, 7))
#define PG8_MMA(ai, bj, At, Bt) do { __builtin_amdgcn_s_setprio(1); _Pragma("unroll") for (int m = 0; m < 4; ++m) _Pragma("unroll") for (int n = 0; n < 2; ++n) { \
        if constexpr (F8) { acc[ai][bj][m][n] = __builtin_amdgcn_mfma_scale_f32_16x16x128_f8f6f4(Bt[n], At[m], acc[ai][bj][m][n], 0, 0, 0, 0x7F7F7F7F, 0, 0x7F7F7F7F); } \
        else { acc[ai][bj][m][n] = __builtin_amdgcn_mfma_f32_16x16x32_bf16(PG8_LO(Bt[n]), PG8_LO(At[m]), acc[ai][bj][m][n], 0, 0, 0); \
               acc[ai][bj][m][n] = __builtin_amdgcn_mfma_f32_16x16x32_bf16(PG8_HI(Bt[n]), PG8_HI(At[m]), acc[ai][bj][m][n], 0, 0, 0); } } __builtin_amdgcn_s_setprio(0); } while (0)
#define PG8_WAIT_V(n) asm volatile("s_waitcnt vmcnt(" #n ")" ::: "memory")
#define PG8_WAIT_L(n) asm volatile("s_waitcnt lgkmcnt(" #n ")" ::: "memory")
#define PG8_BAR __builtin_amdgcn_s_barrier()
#define PG8_SCHED __builtin_amdgcn_sched_barrier(0)
    Unit cur, nxt; int ui = 0;
    if (!S.next(0, cur)) return;
    f32x4 acc[2][2][4][2];
#pragma unroll
    for (int a = 0; a < 2; ++a)
#pragma unroll
        for (int b = 0; b < 2; ++b)
#pragma unroll
            for (int m = 0; m < 4; ++m)
#pragma unroll
                for (int n = 0; n < 2; ++n) acc[a][b][m][n] = (f32x4){0.f, 0.f, 0.f, 0.f};
    i32x8 At[4], B0[2], B1[2];
    const char* cA = S.a_ptr(cur); const char* cB = S.b_ptr(cur);
    if constexpr (GATHER) PG8_GLOAD(0);
    S.a_ready(cur);
    if constexpr (SP2) {
        PG8_STAGE(PG8_SB(0, 0), cB, voffB); PG8_STAGE(PG8_SB(0, 1), cB + hstep, voffB); PG8_STAGE(PG8_SA(0, 0), cA, voffA[0]); PG8_STAGE(PG8_SA(0, 1), cA + hstA, voffA[1]);
        if (wr == 1) PG8_BAR;
        PG8_WAIT_V(2); PG8_BAR;
        PG8_STAGE(PG8_SB(1, 0), cB + kstep, voffB); PG8_STAGE(PG8_SA(1, 0), cA + kstep, voffA[0]); PG8_STAGE(PG8_SB(1, 1), cB + hstep + kstep, voffB);
        PG8_WAIT_V(6); PG8_BAR;
    } else {
        PG8_STAGE(PG8_SB(0, 0), cB, voffB); PG8_STAGE(PG8_SA(0, 0), cA, voffA[0]); PG8_STAGE(PG8_SB(0, 1), cB + hstep, voffB); PG8_STAGE(PG8_SA(0, 1), cA + hstA, voffA[1]);
        if (wr == 1) PG8_BAR;
        PG8_WAIT_V(4); PG8_BAR;
        PG8_STAGE(PG8_SB(1, 0), cB + kstep, voffB); PG8_STAGE(PG8_SA(1, 0), cA + kstep, voffA[0]); PG8_STAGE(PG8_SB(1, 1), cB + hstep + kstep, voffB);
        PG8_WAIT_V(6); PG8_BAR;
    }
    for (;;) {
        const bool has_next = S.next(ui + 1, nxt);
        const char* nA = has_next ? S.a_ptr(nxt) : cA; const char* nB = has_next ? S.b_ptr(nxt) : cB;
#pragma unroll 1
        for (int t = 0; t < nt; t += 2) {
            const bool last = (t == nt - 2);
            const char* a1 = cA + (size_t)(t + 1) * kstep;
            const char* a2 = last ? nA : cA + (size_t)(t + 2) * kstep; const char* b2 = last ? nB : cB + (size_t)(t + 2) * kstep;
            const char* a3 = a2 + kstep; const char* b3 = b2 + kstep;
            if (last && has_next) S.a_ready(nxt);
            if constexpr (SP2) {
            PG8_LDB(B0, 0, 0); PG8_LDB(B1, 0, 1); PG8_SCHED; PG8_LDA(At, 0, 0); PG8_STAGE(PG8_SA(1, 1), a1 + hstA, voffA[1]); if constexpr (GATHER) { if (last && has_next) PG8_GLOAD(ui + 1); }
            PG8_WAIT_V(8); PG8_WAIT_L(0); PG8_BAR; PG8_MMA(0, 0, At, B0); PG8_MMA(0, 1, At, B1); PG8_BAR; PG8_SCHED;
            PG8_LDA(At, 0, 1); PG8_STAGE(PG8_SB(0, 0), b2, voffB); PG8_STAGE(PG8_SB(0, 1), b2 + hstep, voffB); PG8_STAGE(PG8_SA(0, 0), a2, voffA[0]);
            PG8_WAIT_V(8); PG8_WAIT_L(0); PG8_BAR; PG8_MMA(1, 0, At, B0); PG8_MMA(1, 1, At, B1); PG8_BAR; PG8_SCHED;
            PG8_LDB(B0, 1, 0); PG8_LDB(B1, 1, 1); PG8_SCHED; PG8_LDA(At, 1, 0); PG8_STAGE(PG8_SA(0, 1), a2 + hstA, voffA[1]);
            PG8_WAIT_V(8); PG8_WAIT_L(0); PG8_BAR; PG8_MMA(0, 0, At, B0); PG8_MMA(0, 1, At, B1); PG8_BAR; PG8_SCHED;
            PG8_LDA(At, 1, 1); PG8_STAGE(PG8_SB(1, 0), b3, voffB); PG8_STAGE(PG8_SB(1, 1), b3 + hstep, voffB); PG8_STAGE(PG8_SA(1, 0), a3, voffA[0]);
            PG8_WAIT_V(8); PG8_WAIT_L(0); PG8_BAR; PG8_MMA(1, 0, At, B0); PG8_MMA(1, 1, At, B1); PG8_BAR; PG8_SCHED;
            } else {
            PG8_LDB(B0, 0, 0); PG8_SCHED; PG8_LDA(At, 0, 0); PG8_STAGE(PG8_SA(1, 1), a1 + hstA, voffA[1]); if constexpr (GATHER) { if (last && has_next) PG8_GLOAD(ui + 1); }
            PG8_WAIT_L(8); PG8_BAR; PG8_WAIT_L(0); PG8_MMA(0, 0, At, B0); PG8_BAR; PG8_SCHED;
            PG8_LDB(B1, 0, 1); PG8_STAGE(PG8_SB(0, 0), b2, voffB);
            PG8_BAR; PG8_WAIT_L(0); PG8_MMA(0, 1, At, B1); PG8_BAR;
            PG8_LDA(At, 0, 1); PG8_STAGE(PG8_SA(0, 0), a2, voffA[0]);
            PG8_BAR; PG8_WAIT_L(0); PG8_MMA(1, 0, At, B0); PG8_BAR; PG8_SCHED;
            PG8_STAGE(PG8_SB(0, 1), b2 + hstep, voffB);
            PG8_WAIT_V(6); PG8_BAR; PG8_MMA(1, 1, At, B1); PG8_BAR;
            PG8_LDB(B0, 1, 0); PG8_SCHED; PG8_LDA(At, 1, 0); PG8_STAGE(PG8_SA(0, 1), a2 + hstA, voffA[1]);
            PG8_WAIT_L(8); PG8_BAR; PG8_WAIT_L(0); PG8_MMA(0, 0, At, B0); PG8_BAR; PG8_SCHED;
            PG8_LDB(B1, 1, 1); PG8_STAGE(PG8_SB(1, 0), b3, voffB);
            PG8_BAR; PG8_WAIT_L(0); PG8_MMA(0, 1, At, B1); PG8_BAR;
            PG8_LDA(At, 1, 1); PG8_STAGE(PG8_SA(1, 0), a3, voffA[0]);
            PG8_BAR; PG8_WAIT_L(0); PG8_MMA(1, 0, At, B0); PG8_BAR; PG8_SCHED;
            PG8_STAGE(PG8_SB(1, 1), b3 + hstep, voffB);
            PG8_WAIT_V(6); PG8_BAR; PG8_MMA(1, 1, At, B1); PG8_BAR;
            }
        }
        if constexpr (ALIGN_EPI) { if (wr == 0) PG8_BAR; }
        if constexpr (!Epi::AFTER_DRAIN) { E(acc, cur, wr, wc, fr, fq); S.done(cur); }
        if (!has_next) break;
#pragma unroll
        for (int a = 0; a < 2; ++a)
#pragma unroll
            for (int b = 0; b < 2; ++b)
#pragma unroll
                for (int m = 0; m < 4; ++m)
#pragma unroll
                    for (int n = 0; n < 2; ++n) acc[a][b][m][n] = (f32x4){0.f, 0.f, 0.f, 0.f};
        cur = nxt; cA = nA; cB = nB; ++ui;
        if constexpr (ALIGN_EPI) { if (wr == 1) PG8_BAR; }
    }
    PG8_WAIT_V(0);
    if constexpr (!ALIGN_EPI) { if (wr == 0) PG8_BAR; }
    PG8_BAR;
    if constexpr (Epi::AFTER_DRAIN) { E.fused(acc, cur, wr, wc, fr, fq, lds, wid, lane); S.done(cur); }
#undef PG8_SA
#undef PG8_SB
#undef PG8_STAGE
#undef PG8_LDA
#undef PG8_LDB
#undef PG8_LO
#undef PG8_HI
#undef PG8_MMA
#undef PG8_WAIT_V
#undef PG8_WAIT_L
#undef PG8_BAR
#undef PG8_SCHED
#undef PG8_GLOAD
}
}
#include <hip/hip_bf16.h>
#include <cmath>
namespace attn_body {
using bf16=__hip_bfloat16;
using bf16x8=__attribute__((ext_vector_type(8)))short;
using s16x4=__attribute__((ext_vector_type(4)))short;
using f32x16=__attribute__((ext_vector_type(16)))float;
using u32x4=__attribute__((ext_vector_type(4)))unsigned;
constexpr int BATCH=8,NHEAD=16,SEQ=2048,D=64,DMI=3072,DMO=1024;
constexpr int NW=8,QBLK=32,QB=QBLK*NW,KVBLK=64,NQB=SEQ/QB;
constexpr int ATTN_UNIT_ROWS=QB;
__device__ __forceinline__ int crow(int r,int hi){return (r&3)+8*(r>>2)+4*hi;}
#define SBAR() __builtin_amdgcn_sched_barrier(0)
__device__ __forceinline__ void cmask(f32x16&p0,f32x16&p1,int jb,int qrel,int hi){
  const float NEG=-INFINITY; int kb=64*jb+4*hi;
  #pragma unroll
  for(int r=0;r<16;++r){int kv=kb+(r&3)+8*(r>>2); if(kv>qrel)p0[r]=NEG; if(kv+32>qrel)p1[r]=NEG;}
}

constexpr int NSLOT=3, SLOTB=8192;
constexpr int LDS_K=0, LDS_V=NSLOT*SLOTB, LDS_WS=2*NSLOT*SLOTB, LDS_OST=LDS_WS+NW*64*4, LDS_BYTES=LDS_OST+NW*4096;
constexpr float C2=0.125f*1.4426950408889634f;
__device__ __forceinline__ void glds16(const void*gsrc,unsigned lds_dst){unsigned keep;
  asm volatile("s_mov_b32 %0, m0\n\ts_mov_b32 m0, %2\n\ts_nop 0\n\tglobal_load_lds_dwordx4 %1, off\n\ts_mov_b32 m0, %0":"=&s"(keep):"v"(gsrc),"s"(lds_dst):"memory");}
__device__ __forceinline__ float max3f(float a,float b,float c){float r;asm("v_max3_f32 %0, %1, %2, %3":"=v"(r):"v"(a),"v"(b),"v"(c));return r;}
__device__ __forceinline__ float max2f(float a,float b){float r;asm("v_max_f32_e32 %0, %1, %2":"=v"(r):"v"(a),"v"(b));return r;}
__device__ __forceinline__ float fadd_s(float a,float b){float r;asm("v_add_f32_e32 %0, %1, %2":"=v"(r):"v"(a),"v"(b));return r;}
__device__ __forceinline__ float fsub_s(float a,float b){float r;asm("v_sub_f32_e32 %0, %1, %2":"=v"(r):"v"(a),"v"(b));return r;}
typedef float f32x2_t __attribute__((ext_vector_type(2))); typedef __bf16 bf16x2_t __attribute__((ext_vector_type(2)));
__device__ __forceinline__ unsigned cvtpk_s(float lo,float hi){f32x2_t v={lo,hi};bf16x2_t b=__builtin_convertvector(v,bf16x2_t);return __builtin_bit_cast(unsigned,b);}
#define WAIT_BAR(N) asm volatile("s_waitcnt vmcnt(" #N ") lgkmcnt(0)\n\ts_barrier":::"memory")

__device__ __forceinline__ void qkt(f32x16&p0,f32x16&p1,const char*Kslot,const bf16x8*qr,const f32x16&negm,int r32,int hi){
  const char*kb=Kslot+hi*1024+r32*16;
  #pragma unroll
  for(int d0=0;d0<4;++d0){
    const bf16x8 b0=*reinterpret_cast<const bf16x8*>(kb+d0*2048);
    const bf16x8 b1=*reinterpret_cast<const bf16x8*>(kb+d0*2048+512);
    if(d0==0){p0=__builtin_amdgcn_mfma_f32_32x32x16_bf16(b0,qr[0],negm,0,0,0);p1=__builtin_amdgcn_mfma_f32_32x32x16_bf16(b1,qr[0],negm,0,0,0);}
    else{p0=__builtin_amdgcn_mfma_f32_32x32x16_bf16(b0,qr[d0],p0,0,0,0);p1=__builtin_amdgcn_mfma_f32_32x32x16_bf16(b1,qr[d0],p1,0,0,0);}}
}
typedef __attribute__((address_space(3))) const char* lds_cptr;
typedef short v4i16_t __attribute__((ext_vector_type(4)));
__device__ __forceinline__ void kload8(bf16x8*kf,lds_cptr kp){
  kf[0]=*(const __attribute__((address_space(3))) bf16x8*)(kp);      kf[1]=*(const __attribute__((address_space(3))) bf16x8*)(kp+512);
  kf[2]=*(const __attribute__((address_space(3))) bf16x8*)(kp+2048); kf[3]=*(const __attribute__((address_space(3))) bf16x8*)(kp+2560);
  kf[4]=*(const __attribute__((address_space(3))) bf16x8*)(kp+4096); kf[5]=*(const __attribute__((address_space(3))) bf16x8*)(kp+4608);
  kf[6]=*(const __attribute__((address_space(3))) bf16x8*)(kp+6144); kf[7]=*(const __attribute__((address_space(3))) bf16x8*)(kp+6656);
}
__device__ __forceinline__ void kload2(bf16x8*kf,lds_cptr kp,int j){ kf[2*j]=*(const __attribute__((address_space(3))) bf16x8*)(kp+j*2048); kf[2*j+1]=*(const __attribute__((address_space(3))) bf16x8*)(kp+j*2048+512); }
__device__ __forceinline__ s16x4 vtr(lds_cptr p){ return __builtin_bit_cast(s16x4,__builtin_amdgcn_ds_read_tr16_b64_v4i16((__attribute__((address_space(3))) v4i16_t*)p)); }
__device__ __forceinline__ float rowmax(const f32x16&p0,const f32x16&p1){
  float a=max3f(p0[0],p0[1],p1[0]),b=max3f(p0[2],p0[3],p1[1]);a=max3f(a,p1[2],p1[3]);
  #pragma unroll
  for(int r=4;r<16;r+=4){a=max3f(a,p0[r],p0[r+1]);b=max3f(b,p0[r+2],p0[r+3]);a=max3f(a,p1[r],p1[r+1]);b=max3f(b,p1[r+2],p1[r+3]);}
  const float m=max2f(a,b);
  auto rr=__builtin_amdgcn_permlane32_swap(__float_as_uint(m),__float_as_uint(m),false,false);
  return max2f(__uint_as_float(rr[0]),__uint_as_float(rr[1]));
}
__device__ __forceinline__ void pv(f32x16*o,int vb,bf16x8 pa0,bf16x8 pa1,bf16x8 pa2,bf16x8 pa3){
  #pragma unroll
  for(int d0=0;d0<2;++d0){s16x4 lo[4],hi[4];
    #pragma unroll
    for(int ks=0;ks<4;++ks){
      asm volatile("ds_read_b64_tr_b16 %0,%1 offset:%c2":"=&v"(lo[ks]):"v"(vb),"i"(d0*4096+ks*1024):"memory");
      asm volatile("ds_read_b64_tr_b16 %0,%1 offset:%c2":"=&v"(hi[ks]):"v"(vb),"i"(d0*4096+ks*1024+512):"memory");}
    asm volatile("s_waitcnt lgkmcnt(0)":::"memory");SBAR();
    #define PK(k) (bf16x8){lo[k][0],lo[k][1],lo[k][2],lo[k][3],hi[k][0],hi[k][1],hi[k][2],hi[k][3]}
    o[d0]=__builtin_amdgcn_mfma_f32_32x32x16_bf16(pa0,PK(0),o[d0],0,0,0);
    o[d0]=__builtin_amdgcn_mfma_f32_32x32x16_bf16(pa1,PK(1),o[d0],0,0,0);
    o[d0]=__builtin_amdgcn_mfma_f32_32x32x16_bf16(pa2,PK(2),o[d0],0,0,0);
    o[d0]=__builtin_amdgcn_mfma_f32_32x32x16_bf16(pa3,PK(3),o[d0],0,0,0);
    #undef PK
  }
}

#ifndef ATTN_STORE16
#define ATTN_STORE16(p,v) (*(u32x4*)(p)=(v))
#endif
template<int THRL> __device__ __forceinline__ void attn_unit(int b,int qb,const bf16*Q,const bf16*__restrict__ K,const bf16*__restrict__ V,bf16*O,char*shm){
  const int tid=threadIdx.x,lane=tid&63,r32=lane&31,hi=lane>>5; const int wid=__builtin_amdgcn_readfirstlane(tid>>6);
  const long rowbase=(long)b*SEQ; const int q0=qb*QB;
  const bf16*Qw=Q+(rowbase+q0+wid*QBLK)*DMI;
  const bf16*Kh=K+rowbase*DMI,*Vh=V+rowbase*DMI;
  const unsigned lds0=(unsigned)(uintptr_t)shm;
  float*wsf=(float*)(shm+LDS_WS)+wid*64;
  const bf16*ksrc=Kh+(long)lane*DMI+wid*8;
  const bf16*vsrc=Vh+(long)(16*(wid&3)+(lane>>2))*DMI+(wid>>2)*32+(lane&3)*8;
  const unsigned kdst=lds0+LDS_K+wid*1024, vdst=lds0+LDS_V+wid*1024;
  #define DMA_K(t,slot) glds16(ksrc+(long)(t)*KVBLK*DMI,(unsigned)__builtin_amdgcn_readfirstlane(kdst+(slot)))
  #define DMA_V(t,slot) glds16(vsrc+(long)(t)*KVBLK*DMI,(unsigned)__builtin_amdgcn_readfirstlane(vdst+(slot)))
  const int vb0=(int)(lds0+LDS_V)+((lane>>4)&1)*32+(lane&3)*8+(4*hi+((lane&15)>>2))*64;
  const char*Kbase=shm+LDS_K; bf16x8 kf[8];
  const lds_cptr shm3=(lds_cptr)shm; const lds_cptr kp0=shm3+LDS_K+hi*1024+r32*16; const lds_cptr vp0=shm3+LDS_V+((lane>>4)&1)*32+(lane&3)*8+(4*hi+((lane&15)>>2))*64;
  const int NT=(q0+QB)/KVBLK;
  DMA_K(0,0);DMA_V(0,0);DMA_K(1,SLOTB);
  bf16x8 qr[4];
  #pragma unroll
  for(int d0=0;d0<4;++d0)qr[d0]=*reinterpret_cast<const bf16x8*>(&Qw[(long)r32*DMI+d0*16+hi*8]);
  float mhat=0.f,l_reg=0.f;f32x16 o[2];o[0]=f32x16{};o[1]=f32x16{};f32x16 negm=f32x16{};asm volatile("":"+v"(negm));
  const int qrel=wid*QBLK+r32;
  #define CMASK(P0,P1,t) do{int jb_=(t)-(NT-4); if(jb_>=0)cmask(P0,P1,jb_,qrel,hi);}while(0)
  bool resc=false;
  #define START(P0,P1) do{ const float rm=rowmax(P0,P1); resc=false; \
    { const float dl=rm; mhat=fadd_s(mhat,dl); \
      _Pragma("unroll") for(int r=0;r<16;++r){P0[r]=fsub_s(P0[r],dl);P1[r]=fsub_s(P1[r],dl);} \
      _Pragma("unroll") for(int r=0;r<16;++r)negm[r]=-mhat; asm volatile("":"+v"(negm)); } \
    _Pragma("unroll") for(int r=0;r<16;++r)P0[r]=__builtin_amdgcn_exp2f(P0[r]); }while(0)
  #define RESC() do{ if(resc){ asm volatile("s_waitcnt lgkmcnt(0)":::"memory"); \
      _Pragma("unroll") for(int d_=0;d_<2;++d_) _Pragma("unroll") for(int r=0;r<16;++r)o[d_][r]*=wsf[crow(r,hi)]; } }while(0)
  f32x16 pA0,pA1,pB0,pB1;
  int sl_prev=0,sl_cur=0,sl_next=SLOTB;
  #define ROT() do{sl_prev=sl_cur;sl_cur=sl_next;sl_next=(sl_next==(NSLOT-1)*SLOTB)?0:sl_next+SLOTB;}while(0)
  DMA_K(2,2*SLOTB);
  WAIT_BAR(3);
  qkt(pA0,pA1,Kbase,qr,negm,r32,hi);asm volatile("s_nop 15\n\ts_nop 7":"+v"(pA0),"+v"(pA1));CMASK(pA0,pA1,0);
  START(pA0,pA1);
  _Pragma("unroll") for(int r=0;r<16;++r)pA1[r]=__builtin_amdgcn_exp2f(pA1[r]);
  WAIT_BAR(0);
  DMA_K(3,0);DMA_V(1,SLOTB);
  ROT();
  kload8(kf,kp0+sl_cur);
  WAIT_BAR(2);
  s16x4 vlo[8],vhi[8]; u32x4 pw0,pw1,pw2,pw3;
  #define PKW(P,B) cvtpk_s(P[B],P[B+1])
  #define PAF(k) __builtin_bit_cast(bf16x8,pw##k)
  #define VFR(i) (bf16x8){vlo[i][0],vlo[i][1],vlo[i][2],vlo[i][3],vhi[i][0],vhi[i][1],vhi[i][2],vhi[i][3]}
  #define PIN(x) asm volatile("":"+v"(x))
  #define MX3(a,b,c) __builtin_fmaxf(__builtin_fmaxf((a),(b)),(c))
  #define GAPA(MF,A0,A1,A2,A3,W0,W1,PW) do{ MF; sacc+=A0; sacc+=A1; sacc+=A2; sacc+=A3; PIN(sacc); W0; W1; PIN(PW); SBAR(); }while(0)
  #define EX(v) __builtin_amdgcn_exp2f(v)
  #define GAPB(MF,X,B) do{ MF; X[B]=EX(X[B]); X[B+1]=EX(X[B+1]); X[B+2]=EX(X[B+2]); X[B+3]=EX(X[B+3]); PIN(X); SBAR(); }while(0)
  #define VRD(i) do{ vlo[i]=vtr(vp_+(((i)>>2)*4096+((i)&3)*1024)); vhi[i]=vtr(vp_+(((i)>>2)*4096+((i)&3)*1024+512)); }while(0)
  #define KRD(G,j) do{ if(G){ kload2(kf,kp0+sl_next,j); SBAR(); } }while(0)
  #define STEP(C0,C1,P0,P1,t,GK,GV,GL) do{ SBAR(); \
    const lds_cptr vp_=vp0+sl_prev; \
    VRD(0); SBAR(); float sacc=(P0[0]+P0[1]); \
    GAPA(C0=__builtin_amdgcn_mfma_f32_32x32x16_bf16(kf[0],qr[0],negm,0,0,0), P0[2],P0[3],P0[4],P0[5],     pw0[0]=PKW(P0,0), pw0[1]=PKW(P0,2), pw0); \
    VRD(4); SBAR(); GAPA(C1=__builtin_amdgcn_mfma_f32_32x32x16_bf16(kf[1],qr[0],negm,0,0,0), P0[6],P0[7],P0[8],P0[9],     pw0[2]=PKW(P0,4), pw0[3]=PKW(P0,6), pw0); \
    VRD(1); SBAR(); GAPA(C0=__builtin_amdgcn_mfma_f32_32x32x16_bf16(kf[2],qr[1],C0,0,0,0),   P0[10],P0[11],P0[12],P0[13], pw1[0]=PKW(P0,8), pw1[1]=PKW(P0,10), pw1); \
    VRD(5); SBAR(); GAPA(C1=__builtin_amdgcn_mfma_f32_32x32x16_bf16(kf[3],qr[1],C1,0,0,0),   P0[14],P0[15],P1[0],P1[1],   pw1[2]=PKW(P0,12),pw1[3]=PKW(P0,14), pw1); \
    VRD(2); SBAR(); GAPA(C0=__builtin_amdgcn_mfma_f32_32x32x16_bf16(kf[4],qr[2],C0,0,0,0),   P1[2],P1[3],P1[4],P1[5],     pw2[0]=PKW(P1,0), pw2[1]=PKW(P1,2), pw2); \
    VRD(6); SBAR(); GAPA(C1=__builtin_amdgcn_mfma_f32_32x32x16_bf16(kf[5],qr[2],C1,0,0,0),   P1[6],P1[7],P1[8],P1[9],     pw2[2]=PKW(P1,4), pw2[3]=PKW(P1,6), pw2); \
    VRD(3); SBAR(); GAPA(C0=__builtin_amdgcn_mfma_f32_32x32x16_bf16(kf[6],qr[3],C0,0,0,0),   P1[10],P1[11],P1[12],P1[13], pw3[0]=PKW(P1,8), pw3[1]=PKW(P1,10), pw3); \
    VRD(7); SBAR(); GAPA(C1=__builtin_amdgcn_mfma_f32_32x32x16_bf16(kf[7],qr[3],C1,0,0,0),   P1[14],P1[15],0.f,0.f,       pw3[2]=PKW(P1,12),pw3[3]=PKW(P1,14), pw3); \
    l_reg+=sacc; \
    if(GK){DMA_K((t)+3,sl_cur);} if(GV){DMA_V((t)+1,sl_next);} \
    CMASK(C0,C1,t); \
    { float a=MX3(C0[0],C0[1],C1[0]),b=MX3(C0[2],C0[3],C1[1]); a=MX3(a,C1[2],C1[3]); \
      _Pragma("unroll") for(int r=4;r<16;r+=4){a=MX3(a,C0[r],C0[r+1]);b=MX3(b,C0[r+2],C0[r+3]);a=MX3(a,C1[r],C1[r+1]);b=MX3(b,C1[r+2],C1[r+3]);} \
      float rm=__builtin_fmaxf(a,b); { auto rr=__builtin_amdgcn_permlane32_swap(__float_as_uint(rm),__float_as_uint(rm),false,false); rm=__builtin_fmaxf(__uint_as_float(rr[0]),__uint_as_float(rr[1])); } \
      resc=false; \
      if(__builtin_expect(__any(rm>(float)THRL),0)){ const float dl=__builtin_fmaxf(rm,0.f); mhat+=dl; \
        _Pragma("unroll") for(int r=0;r<16;++r){C0[r]-=dl;C1[r]-=dl;} \
        _Pragma("unroll") for(int r=0;r<16;++r)negm[r]=-mhat; asm volatile("":"+v"(negm)); \
        const float f=__builtin_amdgcn_exp2f(-dl); l_reg*=f; if(hi==0)wsf[r32]=f; resc=true; } } \
    SBAR(); \
    GAPB(o[0]=__builtin_amdgcn_mfma_f32_32x32x16_bf16(PAF(0),VFR(0),o[0],0,0,0), C0,0); \
    GAPB(o[1]=__builtin_amdgcn_mfma_f32_32x32x16_bf16(PAF(0),VFR(4),o[1],0,0,0), C0,4); \
    KRD(GL,0); GAPB(o[0]=__builtin_amdgcn_mfma_f32_32x32x16_bf16(PAF(1),VFR(1),o[0],0,0,0), C0,8); \
    KRD(GL,1); GAPB(o[1]=__builtin_amdgcn_mfma_f32_32x32x16_bf16(PAF(1),VFR(5),o[1],0,0,0), C0,12); \
    KRD(GL,2); GAPB(o[0]=__builtin_amdgcn_mfma_f32_32x32x16_bf16(PAF(2),VFR(2),o[0],0,0,0), C1,0); \
    KRD(GL,3); GAPB(o[1]=__builtin_amdgcn_mfma_f32_32x32x16_bf16(PAF(2),VFR(6),o[1],0,0,0), C1,4); \
    GAPB(o[0]=__builtin_amdgcn_mfma_f32_32x32x16_bf16(PAF(3),VFR(3),o[0],0,0,0), C1,8); \
    GAPB(o[1]=__builtin_amdgcn_mfma_f32_32x32x16_bf16(PAF(3),VFR(7),o[1],0,0,0), C1,12); \
    }while(0)
  int t=1;
  #undef CMASK
  #define CMASK(P0,P1,t) do{}while(0)
  for(;t+5<NT;t+=2){
    STEP(pB0,pB1,pA0,pA1,t,true,true,true);     WAIT_BAR(2); RESC(); ROT();
    STEP(pA0,pA1,pB0,pB1,t+1,true,true,true);   WAIT_BAR(2); RESC(); ROT();
  }
  #undef CMASK
  #define CMASK(P0,P1,t) do{int jb_=(t)-(NT-4); if(jb_>=0)cmask(P0,P1,jb_,qrel,hi);}while(0)
  #define ENDW(tt) do{ if((tt)+3<NT){WAIT_BAR(2);} else if((tt)+2<NT){WAIT_BAR(1);} else {WAIT_BAR(0);} }while(0)
  for(;t+1<NT;t+=2){
    STEP(pB0,pB1,pA0,pA1,t,(t+3<NT),(t+1<NT),(t+1<NT));       ENDW(t);   RESC(); ROT();
    STEP(pA0,pA1,pB0,pB1,t+1,(t+4<NT),(t+2<NT),(t+2<NT));     ENDW(t+1); RESC(); ROT();
  }
  STEP(pB0,pB1,pA0,pA1,NT-1,false,false,false); RESC();
  { float sacc=pB0[0]+pB0[1]; _Pragma("unroll") for(int r=2;r<16;++r)sacc+=pB0[r]; _Pragma("unroll") for(int r=0;r<16;++r)sacc+=pB1[r]; l_reg+=sacc;
    pw0=(u32x4){PKW(pB0,0),PKW(pB0,2),PKW(pB0,4),PKW(pB0,6)};pw1=(u32x4){PKW(pB0,8),PKW(pB0,10),PKW(pB0,12),PKW(pB0,14)};pw2=(u32x4){PKW(pB1,0),PKW(pB1,2),PKW(pB1,4),PKW(pB1,6)};pw3=(u32x4){PKW(pB1,8),PKW(pB1,10),PKW(pB1,12),PKW(pB1,14)};
    SBAR(); pv(o,vb0+sl_cur,PAF(0),PAF(1),PAF(2),PAF(3)); }
  #undef PKW
  #undef PAF
  #undef VFR
  #undef PIN
  #undef MX3
  #undef GAPA
  #undef GAPB
  #undef EX
  #undef VRD
  #undef KRD
  #undef STEP
  #undef ENDW
  {auto rr=__builtin_amdgcn_permlane32_swap(__float_as_uint(l_reg),__float_as_uint(l_reg),false,false);l_reg=__uint_as_float(rr[0])+__uint_as_float(rr[1]);}
  if(hi==0)wsf[32+r32]=l_reg;asm volatile("s_waitcnt lgkmcnt(0)":::"memory");
  float rli[16];
  #pragma unroll
  for(int r=0;r<16;++r)rli[r]=__builtin_amdgcn_rcpf(wsf[32+crow(r,hi)]);
  bf16*Ow=O+(rowbase+q0+wid*QBLK)*DMO;
  { bf16*stg=(bf16*)(shm+LDS_OST)+wid*2048;
    #pragma unroll
    for(int r=0;r<16;++r){const int orow=crow(r,hi);
      #pragma unroll
      for(int d0=0;d0<2;++d0)stg[orow*64+d0*32+r32]=__float2bfloat16(o[d0][r]*rli[r]);}
    asm volatile("s_waitcnt lgkmcnt(0)":::"memory");
    #pragma unroll
    for(int i=0;i<4;++i){const int row=i*8+(lane>>3),ch=lane&7; const u32x4 v=*(const u32x4*)(stg+row*64+ch*8); ATTN_STORE16(Ow+(long)row*DMO+ch*8,v);} }
  asm volatile("s_waitcnt lgkmcnt(0)\n\ts_barrier":::"memory");
  #undef DMA_K
  #undef DMA_V
  #undef CMASK
  #undef START
  #undef RESC
  #undef ROT
}
constexpr int ATTN_LDS_BYTES=LDS_BYTES;
struct AttnTensors { const bf16* PJ; bf16* O; };
struct AttnUnit { int bh; int qb; };
constexpr int QCOL=1536, KCOL=2048, VCOL=2560;
struct StaticOrder {
  int vcu;
  __device__ __forceinline__ explicit StaticOrder(int v):vcu(v){}
  __device__ __forceinline__ bool next(int i,AttnUnit&u)const{ if(i>=4||vcu>=256)return false; const int s=2*(vcu&1)+(i>>1); u.bh=vcu>>1; u.qb=(i&1)?7-s:s; return true; }
  __device__ __forceinline__ void a_ready(const AttnUnit&)const{}
  __device__ __forceinline__ void done(const AttnUnit&)const{}
};
template<class Sched,int THRL=8> __device__ __forceinline__ void attn_phase(char*lds,const AttnTensors&T,const Sched&S){
  AttnUnit u;
  for(int i=0;S.next(i,u);++i){ S.a_ready(u);
    const int b=u.bh>>4, vh=u.bh&15, hd=vh>>2, j=(vh>>1)&1, half=vh&1;
    attn_unit<THRL>(b,u.qb,T.PJ+QCOL+hd*128+j*64,T.PJ+KCOL+hd*128+j*64,T.PJ+VCOL+hd*128+half*64,T.O+vh*64,lds); S.done(u); }
}
#undef SBAR
#undef WAIT_BAR
}
#define GAS __attribute__((address_space(1)))
#define LAS __attribute__((address_space(3)))
typedef unsigned short bf16;
typedef unsigned v4u __attribute__((ext_vector_type(4)));
typedef float f32x4 __attribute__((ext_vector_type(4)));
typedef short bf16x8 __attribute__((ext_vector_type(8)));
typedef GAS unsigned gu32;
typedef GAS unsigned long long gu64;
#define RLX_AGENT __ATOMIC_RELAXED, __HIP_MEMORY_SCOPE_AGENT
#define LDS_WAIT() asm volatile("s_waitcnt lgkmcnt(0)" ::: "memory")
#define VM_WAIT() asm volatile("s_waitcnt vmcnt(0)" ::: "memory")
__device__ __forceinline__ unsigned long long rt() { return __builtin_amdgcn_s_memrealtime(); }
__device__ __forceinline__ unsigned f2bf(float f) { unsigned u = __builtin_bit_cast(unsigned, f); return (u + 0x7fffu + ((u >> 16) & 1u)) >> 16; }
__device__ __forceinline__ unsigned pk2(float lo, float hi) { return f2bf(lo) | (f2bf(hi) << 16); }

#define XB_TMO      128
#define XB_XCNT(j)  (256  + 64 * (j))
#define XB_XSUB(j)  (1280 + 64 * (j))
#define XB_XGEN(j)  (2304 + 64 * (j))
#define XB_TOP      3328
#define XB_TOPGEN   3392
#define XCD_BAR_WORDS 3456
#define XB_SPIN_CAP (1u << 18)

__device__ __forceinline__ unsigned xb_ld(unsigned* p)              { return __hip_atomic_load(p, __ATOMIC_RELAXED, __HIP_MEMORY_SCOPE_AGENT); }
__device__ __forceinline__ unsigned xb_add(unsigned* p, unsigned v) { return __hip_atomic_fetch_add(p, v, __ATOMIC_RELAXED, __HIP_MEMORY_SCOPE_AGENT); }
__device__ __forceinline__ unsigned xb_xcc_id() { return (unsigned)__builtin_amdgcn_s_getreg((3 << 11) | 20) & 0xFu; }
#define XB_SPIN(cond, bar) do { unsigned _sp = 0; while (cond) { __builtin_amdgcn_s_sleep(1); \
    if ((++_sp & 255u) == 0u) { if (xb_ld(&(bar)[XB_TMO])) break; if (_sp > XB_SPIN_CAP) { atomicAdd(&(bar)[XB_TMO], 1u); break; } } } } while (0)

struct XcdBarrier {
    unsigned* bar; unsigned x;
    volatile LAS unsigned* st;
};

__device__ __forceinline__ XcdBarrier xcd_barrier_post(unsigned* bar, volatile LAS unsigned* st) {
    XcdBarrier b; b.bar = bar; b.x = xb_xcc_id(); b.st = st;
    if (threadIdx.x == 0) (void)xb_add(&bar[XB_XCNT(b.x)], 1u);
    return b;
}
__device__ __forceinline__ void xcd_barrier_complete(unsigned* bar, unsigned x, unsigned& nloc, unsigned& nx) {
    const unsigned G = gridDim.x * gridDim.y * gridDim.z;
    unsigned sum, cnt, mine, sp = 0u;
    for (;;) {
        sum = 0u; cnt = 0u; mine = 0u;
#pragma unroll
        for (unsigned j = 0; j < 16; ++j) { const unsigned c = xb_ld(&bar[XB_XCNT(j)]); sum += c; cnt += (c > 0u) ? 1u : 0u; mine = (j == x) ? c : mine; }
        if (sum == G) break;
        __builtin_amdgcn_s_sleep(1);
        if ((++sp & 255u) == 0u) { if (xb_ld(&bar[XB_TMO])) break; if (sp > XB_SPIN_CAP) { atomicAdd(&bar[XB_TMO], 1u); break; } }
    }
    nloc = mine > 0u ? mine : 1u; nx = cnt > 0u ? cnt : 1u;
}

__device__ __forceinline__ void xcd_barrier(const XcdBarrier& b) {
    asm volatile("s_waitcnt vmcnt(0)" ::: "memory");
    __syncthreads();
    if (threadIdx.x == 0) {
        unsigned* bar = b.bar;
        __builtin_amdgcn_s_waitcnt(0);
        unsigned nloc = b.st[0], nx = b.st[1];
        if (nloc == 0u) { xcd_barrier_complete(bar, b.x, nloc, nx); b.st[0] = nloc; b.st[1] = nx; }
        const unsigned old = xb_add(&bar[XB_XSUB(b.x)], 1u);
        const unsigned gen = old / nloc;
        if (old + 1u == (gen + 1u) * nloc) {
            __builtin_amdgcn_fence(__ATOMIC_RELEASE, "agent");
            asm volatile("s_waitcnt vmcnt(0)" ::: "memory");
            const unsigned og = xb_add(&bar[XB_TOP], 1u);
            const unsigned tg = og / nx;
            if (og + 1u == (tg + 1u) * nx) xb_add(&bar[XB_TOPGEN], 1u);
            else XB_SPIN(xb_ld(&bar[XB_TOPGEN]) == tg, bar);
            __builtin_amdgcn_fence(__ATOMIC_ACQUIRE, "agent");
            xb_add(&bar[XB_XGEN(b.x)], 1u);
            asm volatile("s_waitcnt vmcnt(0)" ::: "memory");
        } else {
            XB_SPIN(xb_ld(&bar[XB_XGEN(b.x)]) == gen, bar);
            __builtin_amdgcn_fence(__ATOMIC_ACQUIRE, "agent");
            asm volatile("s_waitcnt vmcnt(0)" ::: "memory");
        }
    }
    __syncthreads();
}
constexpr int NWAVES = 8;
constexpr int Bsz = 8, SEQ = 2048, D = 1024, T = Bsz * SEQ;
constexpr int INP = 3080, NPJ = 3072, OFF_DT = 1536, OFF_Q2 = 1544;
constexpr int NE = 32, CAP = T, PLE = 256, FF2 = 2048;
constexpr int PADROWS = 4 * T + NE * 256;
constexpr float LAM_INIT = 0.2f, EPS = 1e-6f;
constexpr size_t MiB = 1u << 20;
constexpr size_t WS_CTL = 0, CTL_ZERO_BYTES = 1 * MiB;
constexpr size_t WS_ROWTOK = 1 * MiB, WS_ROWGATE = 3 * MiB, WS_SLOT = 5 * MiB, WS_DT = 6 * MiB, WS_WR = 7 * MiB;
constexpr size_t WS_WIN = 8 * MiB, WS_WOUT = 14 * MiB, WS_WG = 16 * MiB, WS_WP = 18 * MiB, WS_WUP = 20 * MiB, WS_WDN = 148 * MiB;
constexpr size_t WS_H = 212 * MiB, WS_PJ = 244 * MiB, WS_O = 340 * MiB, WS_YC = 372 * MiB, WS_X1 = 404 * MiB, WS_X2 = 468 * MiB, WS_PP = 532 * MiB, WS_P16 = 564 * MiB;
constexpr size_t WS_ACT = 572 * MiB, WS_YS = 716 * MiB, WS_TMP = 860 * MiB, WS_H8 = 960 * MiB, WS_END = 976 * MiB;
static_assert(WS_ACT + (size_t)PADROWS * 1024 * 2 <= WS_YS && WS_YS + (size_t)PADROWS * 1024 * 2 <= WS_TMP, "d_ws map");
constexpr int CW_TMO = 0, CW_CODE = 1, CW_CNT = 64  , CW_BAR = 4096;
constexpr int RING_OFF = 0, RING_BYTES = 131072, LDSCTL_OFF = RING_BYTES, MISC_OFF = LDSCTL_OFF + 320, MTS_OFF = LDSCTL_OFF + 512, GTAB_OFF = LDSCTL_OFF + 1024, GTAB_UNITS = 10;
constexpr int LDS_BYTES = 147456;
static_assert(GTAB_OFF + GTAB_UNITS * 1024 <= LDS_BYTES, "LDS map");
__device__ __forceinline__ float wave_sum(float v) {
#pragma unroll
    for (int o = 1; o < 64; o <<= 1) v += __shfl_xor(v, o);
    return v;
}
__device__ __forceinline__ float bf2f(bf16 u) { return __uint_as_float((unsigned)u << 16); }
typedef unsigned u32x2 __attribute__((ext_vector_type(2)));

struct Args {
    const float *x, *p, *g_mix, *w_in, *conv_w, *conv_b, *dt_bias, *a_log, *d_skip, *ssd_norm_w, *lq1, *lk1, *lq2, *lk2, *subln_w, *w_out, *g_ffn, *w_router, *b_router,
                *w_up, *b_up, *w_down, *b_down, *g_ple, *w_ple_gate, *w_ple_proj, *g_final;
    float* out; unsigned char* ws; int ph_lo, ph_hi, bar_li, dry;
};

__device__ __forceinline__ void tr_item(const float* W, int ldw, int K, bf16* WT, int n0, int k0, int nrow0, LAS unsigned* scr, int lane) {
    const int n4 = (lane & 15) * 4, kr = lane >> 4;
    const float* src = W + (size_t)(k0 + kr * 2) * ldw + n0 + n4;
#pragma unroll
    for (int it = 0; it < 8; ++it) {
        const f32x4 a = *(const GAS f32x4*)(src + (size_t)(it * 8) * ldw);
        const f32x4 b = *(const GAS f32x4*)(src + (size_t)(it * 8 + 1) * ldw);
        const int kp = it * 4 + kr;
        scr[(n4 + 0) * 33 + kp] = pk2(a.x, b.x); scr[(n4 + 1) * 33 + kp] = pk2(a.y, b.y); scr[(n4 + 2) * 33 + kp] = pk2(a.z, b.z); scr[(n4 + 3) * 33 + kp] = pk2(a.w, b.w);
    }
    LDS_WAIT(); asm volatile("" ::: "memory");
    const int c = lane & 7;
#pragma unroll
    for (int it = 0; it < 8; ++it) { const int n = (lane >> 3) + 8 * it; const LAS unsigned* s = scr + n * 33 + c * 4;
        v4u o; o.x = s[0]; o.y = s[1]; o.z = s[2]; o.w = s[3];
        *(GAS v4u*)(WT + (size_t)(nrow0 + n) * K + k0 + 8 * c) = o; }
    LDS_WAIT(); asm volatile("" ::: "memory");
}
__device__ __forceinline__ void tr_item8(const float* W, int ldw, int K, unsigned char* WT, int n0, int k0, int nrow0, float scale, LAS unsigned* scr, int lane) {
    const int n4 = (lane & 15) * 4, kq = lane >> 4;
    const float* src = W + (size_t)(k0 + kq * 4) * ldw + n0 + n4;
#pragma unroll
    for (int it = 0; it < 4; ++it) {
        const f32x4 r0 = *(const GAS f32x4*)(src + (size_t)(it * 16) * ldw) * scale, r1 = *(const GAS f32x4*)(src + (size_t)(it * 16 + 1) * ldw) * scale;
        const f32x4 r2 = *(const GAS f32x4*)(src + (size_t)(it * 16 + 2) * ldw) * scale, r3 = *(const GAS f32x4*)(src + (size_t)(it * 16 + 3) * ldw) * scale;
        const int kp = it * 4 + kq;
        scr[(n4 + 0) * 17 + kp] = pg8::pk4_fp8(r0.x, r1.x, r2.x, r3.x); scr[(n4 + 1) * 17 + kp] = pg8::pk4_fp8(r0.y, r1.y, r2.y, r3.y);
        scr[(n4 + 2) * 17 + kp] = pg8::pk4_fp8(r0.z, r1.z, r2.z, r3.z); scr[(n4 + 3) * 17 + kp] = pg8::pk4_fp8(r0.w, r1.w, r2.w, r3.w);
    }
    LDS_WAIT(); asm volatile("" ::: "memory");
    const int c = lane & 3;
#pragma unroll
    for (int it = 0; it < 4; ++it) { const int n = (lane >> 2) + 16 * it; const LAS unsigned* s = scr + n * 17 + c * 4;
        v4u o; o.x = s[0]; o.y = s[1]; o.z = s[2]; o.w = s[3];
        *(GAS v4u*)(WT + (size_t)(nrow0 + n) * K + k0 + 16 * c) = o; }
    LDS_WAIT(); asm volatile("" ::: "memory");
}
__device__ __forceinline__ void p0_prologue(const Args& a, LAS unsigned char* lds, int vcu, int G, int wave, int lane, int tid) {
    unsigned char* ws = a.ws;
    bf16* Win_t = (bf16*)(ws + WS_WIN); bf16* Wout_t = (bf16*)(ws + WS_WOUT); bf16* Wg_t = (bf16*)(ws + WS_WG); bf16* Wp_t = (bf16*)(ws + WS_WP); unsigned char* Wup8 = ws + WS_WUP; unsigned char* Wdn8 = ws + WS_WDN;
    LAS unsigned* scr = (LAS unsigned*)(lds + RING_OFF + wave * 8704);
    const int gw = vcu * NWAVES + wave, NGW = G * NWAVES;
    constexpr int I_IN = 16 * 24, I_SQ = 16 * 16, I_PP = 4 * 16, I_UP = 32 * 16 * 32, I_DN = 32 * 16 * 16;
    constexpr int NITEMS = 2 * I_IN + 2 * I_SQ + I_PP + I_UP + I_DN;
    for (int it = gw; it < NITEMS; it += NGW) {
        int r = it;
        if (r < I_UP) { const int e = r >> 9, q = r & 511; tr_item8(a.w_up + (size_t)e * D * FF2, FF2, D, Wup8 + (size_t)e * FF2 * D, (q & 31) * 64, (q >> 5) * 64, (q & 31) * 64, pg8::W8_SCALE, scr, lane); continue; } r -= I_UP;
        if (r < I_DN) { const int e = r >> 8, q = r & 255; tr_item8(a.w_down + (size_t)e * D * D, D, D, Wdn8 + (size_t)e * D * D, (q & 15) * 64, (q >> 4) * 64, (q & 15) * 64, pg8::W8_SCALE, scr, lane); continue; } r -= I_DN;
        if (r < I_IN) { tr_item(a.w_in, INP, D, Win_t, (r % 24) * 64, (r / 24) * 64, (r % 24) * 64, scr, lane); continue; } r -= I_IN;
        if (r < I_IN) { tr_item(a.w_in + OFF_Q2, INP, D, Win_t, (r % 24) * 64, (r / 24) * 64, 1536 + (r % 24) * 64, scr, lane); continue; } r -= I_IN;
        if (r < I_SQ) { tr_item(a.w_out, D, D, Wout_t, (r & 15) * 64, (r >> 4) * 64, (r & 15) * 64, scr, lane); continue; } r -= I_SQ;
        if (r < I_SQ) { tr_item(a.w_ple_gate, D, D, Wg_t, (r & 15) * 64, (r >> 4) * 64, (r & 15) * 64, scr, lane); continue; } r -= I_SQ;
        tr_item(a.w_ple_proj, D, PLE, Wp_t, (r & 15) * 64, (r >> 4) * 64, (r & 15) * 64, scr, lane);
    }
    { bf16* Wr_t = (bf16*)(ws + WS_WR); const int gt = vcu * (NWAVES * 64) + tid, NT_ = G * NWAVES * 64;
      for (int i = gt; i < NE * D; i += NT_) { const int n = i >> 10, k = i & 1023; Wr_t[i] = (bf16)f2bf(a.w_router[k * NE + n]); } }
    bf16* H = (bf16*)(ws + WS_H); float* DT = (float*)(ws + WS_DT);
    for (int m = gw; m < T; m += NGW) {
        const GAS f32x4* xr = (const GAS f32x4*)(a.x + (size_t)m * D) + lane;
        f32x4 v[4]; float s = 0.f;
#pragma unroll
        for (int j = 0; j < 4; ++j) { v[j] = xr[64 * j]; s += (v[j].x * v[j].x + v[j].y * v[j].y) + (v[j].z * v[j].z + v[j].w * v[j].w); }
        const float rs = 1.f / sqrtf(wave_sum(s) * (1.f / D) + EPS);
        GAS u32x2* o8 = (GAS u32x2*)(H + (size_t)m * D) + lane;
        float d[8];
#pragma unroll
        for (int h = 0; h < 8; ++h) d[h] = 0.f;
#pragma unroll
        for (int j = 0; j < 4; ++j) { const f32x4 gg = ((const GAS f32x4*)a.g_mix)[lane + 64 * j]; v[j] = v[j] * rs * gg;
            u32x2 w; w.x = pk2(v[j].x, v[j].y); w.y = pk2(v[j].z, v[j].w); o8[64 * j] = w;
#pragma unroll
            for (int i = 0; i < 4; ++i) { const float* wr = a.w_in + (size_t)(4 * lane + 256 * j + i) * INP + OFF_DT; const f32x4 w0 = *(const GAS f32x4*)wr, w1 = *(const GAS f32x4*)(wr + 4); const float hv = v[j][i];
                d[0] += hv * w0.x; d[1] += hv * w0.y; d[2] += hv * w0.z; d[3] += hv * w0.w; d[4] += hv * w1.x; d[5] += hv * w1.y; d[6] += hv * w1.z; d[7] += hv * w1.w; } }
#pragma unroll
        for (int h = 0; h < 8; ++h) d[h] = wave_sum(d[h]);
        if (lane < 8) { float mine = d[0];
#pragma unroll
            for (int h = 1; h < 8; ++h) mine = (lane == h) ? d[h] : mine;
            const float raw = mine + a.dt_bias[lane]; DT[(size_t)m * 8 + lane] = raw > 20.f ? raw : log1pf(expf(raw)); }
    }
    { bf16* P16 = (bf16*)(ws + WS_P16); const int gt = vcu * (NWAVES * 64) + tid, NT_ = G * NWAVES * 64;
      for (int i = gt; i < T * PLE / 8; i += NT_) { const f32x4 v0 = ((const GAS f32x4*)a.p)[2 * i], v1 = ((const GAS f32x4*)a.p)[2 * i + 1];
          v4u o; o.x = pk2(v0.x, v0.y); o.y = pk2(v0.z, v0.w); o.z = pk2(v1.x, v1.y); o.w = pk2(v1.z, v1.w); ((GAS v4u*)P16)[i] = o; } }
}

__device__ __forceinline__ void p5_router(const Args& a, LAS unsigned char* lds, int vcu, int G, int wave, int lane, int tid) {
    const int cnt_off = (a.dry & 1) ? 32 : 0;
    typedef float f32x16 __attribute__((ext_vector_type(16)));
    unsigned char* ws = a.ws;
    const float* X1 = (const float*)(ws + WS_X1); unsigned char* H8 = ws + WS_H8; const bf16* Wr_t = (const bf16*)(ws + WS_WR);
    int* cnt = (int*)(ws + WS_CTL) + CW_CNT + cnt_off; int* row_tok = (int*)(ws + WS_ROWTOK); float* row_gate = (float*)(ws + WS_ROWGATE); int* slot = (int*)(ws + WS_SLOT);
    for (int tile = vcu; tile < T / 64; tile += G) {
        for (int tt = 0; tt < 8; ++tt) {
            const int lr = wave * 8 + tt, m = tile * 64 + lr;
            const GAS f32x4* xr = (const GAS f32x4*)(X1 + (size_t)m * D) + lane;
            f32x4 v[4]; float s = 0.f;
#pragma unroll
            for (int j = 0; j < 4; ++j) { v[j] = xr[64 * j]; s += (v[j].x * v[j].x + v[j].y * v[j].y) + (v[j].z * v[j].z + v[j].w * v[j].w); }
            const float rs = 1.f / sqrtf(wave_sum(s) * (1.f / D) + EPS);
            GAS unsigned* o4 = (GAS unsigned*)(H8 + (size_t)m * D) + lane;
#pragma unroll
            for (int j = 0; j < 4; ++j) { const f32x4 gg = ((const GAS f32x4*)a.g_ffn)[lane + 64 * j]; const f32x4 hv = v[j] * rs * gg;
                u32x2 w; w.x = pk2(hv.x, hv.y); w.y = pk2(hv.z, hv.w); o4[64 * j] = pg8::pk4_fp8(hv.x, hv.y, hv.z, hv.w);
                const int chunk = (lane >> 1) + 32 * j;
                *(LAS u32x2*)(lds + lr * 2048 + ((chunk ^ (lr & 7)) << 4) + (lane & 1) * 8) = w; }
        }
        __syncthreads();
        const int r32 = lane & 31, hi = lane >> 5, mh = wave & 1, kq = wave >> 1;
        f32x16 acc = {};
#pragma unroll 4
        for (int st = 0; st < 16; ++st) { const int row = 32 * mh + r32, chunk = 2 * (kq * 16 + st) + hi;
            const bf16x8 af = *(const LAS bf16x8*)(lds + row * 2048 + ((chunk ^ (row & 7)) << 4));
            const bf16x8 bfr = *(const GAS bf16x8*)(Wr_t + (size_t)r32 * D + chunk * 8);
            acc = __builtin_amdgcn_mfma_f32_32x32x16_bf16(af, bfr, acc, 0, 0, 0); }
        __syncthreads();
        LAS float* part = (LAS float*)lds;
#pragma unroll
        for (int r = 0; r < 16; ++r) { const int row = (r & 3) + 8 * (r >> 2) + 4 * hi; part[(wave * 32 + row) * 33 + r32] = acc[r]; }
        if (tid < 32) ((LAS int*)(lds + 40960))[tid] = 0;
        __syncthreads();
        LAS int* lcnt = (LAS int*)(lds + 40960); LAS int* lbase = (LAS int*)(lds + 41088); LAS int* tok_e = (LAS int*)(lds + 41216); LAS int* tok_lp = (LAS int*)(lds + 42240); LAS float* tok_g = (LAS float*)(lds + 43264);
        for (int rd = 0; rd < 4; ++rd) {
            const int lt = rd * 16 + (tid >> 5), e = tid & 31, mh2 = lt >> 5, lrow = lt & 31;
            float v = a.b_router[e];
#pragma unroll
            for (int q = 0; q < 4; ++q) v += part[((q * 2 + mh2) * 32 + lrow) * 33 + e];
            float tv[4]; int ti[4];
#pragma unroll
            for (int r = 0; r < 4; ++r) { float bv = v; int bi = e;
#pragma unroll
                for (int o = 16; o > 0; o >>= 1) { const float ov = __shfl_xor(bv, o); const int oi = __shfl_xor(bi, o); if (ov > bv || (ov == bv && oi < bi)) { bv = ov; bi = oi; } }
                tv[r] = bv; ti[r] = bi; if (e == bi) v = -INFINITY; }
            if (e == 0) { float ex[4], sm = 0.f;
#pragma unroll
                for (int r = 0; r < 4; ++r) { ex[r] = expf(tv[r] - tv[0]); sm += ex[r]; }
#pragma unroll
                for (int r = 0; r < 4; ++r) { tok_e[lt * 4 + r] = ti[r]; tok_lp[lt * 4 + r] = __hip_atomic_fetch_add(lcnt + ti[r], 1, __ATOMIC_RELAXED, __HIP_MEMORY_SCOPE_WORKGROUP); tok_g[lt * 4 + r] = ex[r] / sm; } }
        }
        __syncthreads();
        if (tid < 32) { const int n = lcnt[tid]; lbase[tid] = n ? atomicAdd(&cnt[tid * 64], n) : 0; }
        __syncthreads();
        if (tid < 256) { const int lt = tid >> 2, r = tid & 3, m = tile * 64 + lt, e = tok_e[tid], pos = lbase[e] + tok_lp[tid];
            row_tok[e * CAP + pos] = m; row_gate[e * CAP + pos] = tok_g[tid]; slot[(m * 4 + r) * 2] = e; slot[(m * 4 + r) * 2 + 1] = pos; }
        __syncthreads();
    }
}

__device__ __forceinline__ void moe_setup(const Args& a, LAS unsigned char* lds, int tid) {
    LAS int* mts = (LAS int*)(lds + MTS_OFF); const int* cnt = (const int*)(a.ws + WS_CTL) + CW_CNT;
    if (tid == 0) { int s = 0; for (int e = 0; e < NE; ++e) { mts[e] = s; s += (cnt[e * 64] + 255) >> 8; } mts[NE] = s; }
    __syncthreads();
}
__device__ __forceinline__ void moe_gtab(const Args& a, LAS unsigned char* lds, int tid, int u0, int u1, int NN) {
    LAS int* mts = (LAS int*)(lds + MTS_OFF); LAS unsigned* gtab = (LAS unsigned*)(lds + GTAB_OFF);
    const int* cnt = (const int*)(a.ws + WS_CTL) + CW_CNT; const int* row_tok = (const int*)(a.ws + WS_ROWTOK);
    for (int i = 0; i < u1 - u0 && i < GTAB_UNITS; ++i) {
        const int mt = (u0 + i) / NN; int e = 0;
        for (int k = 1; k < 32; ++k) e += (mts[k] <= mt) ? 1 : 0;
        const int r0 = (mt - mts[e]) * 256, c = cnt[e * 64];
        if (tid < 256) { const int r = r0 + tid; const int tok = (r < c) ? row_tok[e * CAP + r] : 0; gtab[i * 256 + tid] = (unsigned)tok * (unsigned)D; }
    }
    __syncthreads();
}

__device__ __forceinline__ void p8_combine(const Args& a, LAS unsigned char* lds, int vcu, int G, int wave, int lane) {
    unsigned char* ws = a.ws; LAS int* mts = (LAS int*)(lds + MTS_OFF);
    const float* X1 = (const float*)(ws + WS_X1); float* X2 = (float*)(ws + WS_X2); bf16* H = (bf16*)(ws + WS_H); const bf16* YS = (const bf16*)(ws + WS_YS); const int* slot = (const int*)(ws + WS_SLOT);
    const int gw = vcu * NWAVES + wave, NGW = G * NWAVES;
    for (int m = gw; m < T; m += NGW) {
        const GAS f32x4* xr = (const GAS f32x4*)(X1 + (size_t)m * D) + lane;
        f32x4 v[4];
#pragma unroll
        for (int j = 0; j < 4; ++j) v[j] = xr[64 * j];
#pragma unroll
        for (int r = 0; r < 4; ++r) { const int e = slot[(m * 4 + r) * 2], pos = slot[(m * 4 + r) * 2 + 1]; const size_t prow = (size_t)mts[e] * 256 + pos;
            const GAS u32x2* yr = (const GAS u32x2*)(YS + prow * D) + lane;
#pragma unroll
            for (int j = 0; j < 4; ++j) { const u32x2 w = yr[64 * j]; v[j].x += __uint_as_float(w.x << 16); v[j].y += __uint_as_float(w.x & 0xffff0000u); v[j].z += __uint_as_float(w.y << 16); v[j].w += __uint_as_float(w.y & 0xffff0000u); } }
        float s = 0.f;
        GAS f32x4* xo = (GAS f32x4*)(X2 + (size_t)m * D) + lane;
#pragma unroll
        for (int j = 0; j < 4; ++j) { xo[64 * j] = v[j]; s += (v[j].x * v[j].x + v[j].y * v[j].y) + (v[j].z * v[j].z + v[j].w * v[j].w); }
        const float rs = 1.f / sqrtf(wave_sum(s) * (1.f / D) + EPS);
        GAS u32x2* o8 = (GAS u32x2*)(H + (size_t)m * D) + lane;
#pragma unroll
        for (int j = 0; j < 4; ++j) { const f32x4 gg = ((const GAS f32x4*)a.g_ple)[lane + 64 * j]; const f32x4 hv = v[j] * rs * gg; u32x2 w; w.x = pk2(hv.x, hv.y); w.y = pk2(hv.z, hv.w); o8[64 * j] = w; }
    }
}
__device__ __forceinline__ void p10_final(const Args& a, int vcu, int G, int wave, int lane) {
    const float* X3 = (const float*)(a.ws + WS_X1);
    const int gw = vcu * NWAVES + wave, NGW = G * NWAVES;
    for (int m = gw; m < T; m += NGW) {
        const GAS f32x4* xr = (const GAS f32x4*)(X3 + (size_t)m * D) + lane;
        f32x4 v[4]; float s = 0.f;
#pragma unroll
        for (int j = 0; j < 4; ++j) { v[j] = xr[64 * j]; s += (v[j].x * v[j].x + v[j].y * v[j].y) + (v[j].z * v[j].z + v[j].w * v[j].w); }
        const float rs = 1.f / sqrtf(wave_sum(s) * (1.f / D) + EPS);
        GAS f32x4* o = (GAS f32x4*)(a.out + (size_t)m * D) + lane;
#pragma unroll
        for (int j = 0; j < 4; ++j) { const f32x4 gg = ((const GAS f32x4*)a.g_final)[lane + 64 * j]; o[64 * j] = v[j] * rs * gg; }
    }
}


constexpr size_t SSD_XN = WS_TMP, SSD_XDT = WS_TMP + 16 * MiB, SSD_BN = WS_TMP + 32 * MiB, SSD_CN = WS_TMP + 40 * MiB, SSD_ST = WS_TMP + 48 * MiB, SSD_ACUM = WS_TMP + 64 * MiB, SSD_CD = WS_TMP + 65 * MiB;
static_assert(SSD_CD + 4096 <= WS_END, "ssd scratch");
typedef float f32x16 __attribute__((ext_vector_type(16)));
__device__ __forceinline__ int img_off(int row, int chunk) { return row * 272 + (chunk << 4); }
__device__ __forceinline__ float silu_fast(float v) { return v * __builtin_amdgcn_rcpf(1.f + __builtin_amdgcn_exp2f(-1.4426950408889634f * v)); }
__device__ __forceinline__ int crow16(int r, int hi) { return (r & 3) + 8 * (r >> 2) + 4 * hi; }

constexpr int SA_XT = 0, SA_BT = 69632, SA_ACUM = 104448, SA_WTS = 106496, SA_DTS = 108544;
template <int TYPE  > __device__ __forceinline__ void ssd_conv_patch(const Args& a, LAS unsigned char* lds, int unit, int g, int c, int t0, int cbl, int lb8) {
    const bf16* PJ = (const bf16*)(a.ws + WS_PJ);
    const int ch = (TYPE == 0 ? g * 256 : TYPE == 1 ? 512 + g * 128 : 768 + g * 128) + cbl * 8;
    const int l0 = lb8 * 8;
    v4u in[11];
#pragma unroll
    for (int i = 0; i < 11; ++i) { const int r = l0 - 3 + i; const bool ok = (c > 0) || (r >= 0);
        in[i] = ok ? *(const GAS v4u*)(PJ + (size_t)(t0 + r) * NPJ + 512 + ch) : (v4u){0u, 0u, 0u, 0u}; }
    f32x4 w[4][2], bia[2];
#pragma unroll
    for (int j = 0; j < 4; ++j) { w[j][0] = *(const GAS f32x4*)(a.conv_w + j * 1024 + ch); w[j][1] = *(const GAS f32x4*)(a.conv_w + j * 1024 + ch + 4); }
    bia[0] = *(const GAS f32x4*)(a.conv_b + ch); bia[1] = *(const GAS f32x4*)(a.conv_b + ch + 4);
    float wt[8], dtl[8];
    const int hl = cbl >> 3;
    if (TYPE == 0) {
#pragma unroll
        for (int li = 0; li < 8; ++li) { wt[li] = ((const LAS float*)(lds + SA_WTS))[hl * 128 + l0 + li]; dtl[li] = ((const LAS float*)(lds + SA_DTS))[hl * 128 + l0 + li]; } }
    v4u nat[8];
#pragma unroll
    for (int ep = 0; ep < 4; ++ep) {
        float o[2][8];
#pragma unroll
        for (int q = 0; q < 2; ++q) { const int e = 2 * ep + q;
            float xin[11];
#pragma unroll
            for (int i = 0; i < 11; ++i) { const unsigned wd = in[i][ep]; xin[i] = __uint_as_float(q ? (wd & 0xffff0000u) : (wd << 16)); }
            const float be = bia[e >> 2][e & 3];
#pragma unroll
            for (int li = 0; li < 8; ++li) { float acc = be;
#pragma unroll
                for (int j = 0; j < 4; ++j) acc += w[j][e >> 2][e & 3] * xin[li + j];
                o[q][li] = silu_fast(acc); }
            if (TYPE == 0) { const int pp = cbl * 8 + e;
                v4u pk; pk.x = pk2(o[q][0] * wt[0], o[q][1] * wt[1]); pk.y = pk2(o[q][2] * wt[2], o[q][3] * wt[3]); pk.z = pk2(o[q][4] * wt[4], o[q][5] * wt[5]); pk.w = pk2(o[q][6] * wt[6], o[q][7] * wt[7]);
                *(LAS v4u*)(lds + SA_XT + img_off(pp, lb8)) = pk;
                bf16* xd = (bf16*)(a.ws + SSD_XDT) + ((size_t)unit * 256 + pp) * 128 + 16 * (lb8 >> 1) + 4 * (lb8 & 1);
                u32x2 d0, d1; d0.x = pk2(o[q][0] * dtl[0], o[q][1] * dtl[1]); d0.y = pk2(o[q][2] * dtl[2], o[q][3] * dtl[3]); d1.x = pk2(o[q][4] * dtl[4], o[q][5] * dtl[5]); d1.y = pk2(o[q][6] * dtl[6], o[q][7] * dtl[7]);
                *(GAS u32x2*)xd = d0; *(GAS u32x2*)(xd + 8) = d1; }
            if (TYPE == 1) { const int n = cbl * 8 + e;
                v4u pk; pk.x = pk2(o[q][0], o[q][1]); pk.y = pk2(o[q][2], o[q][3]); pk.z = pk2(o[q][4], o[q][5]); pk.w = pk2(o[q][6], o[q][7]);
                *(LAS v4u*)(lds + SA_BT + img_off(n, lb8)) = pk; }
        }
#pragma unroll
        for (int li = 0; li < 8; ++li) nat[li][ep] = pk2(o[0][li], o[1][li]);
    }
    bf16* dst = TYPE == 0 ? (bf16*)(a.ws + SSD_XN) + ((size_t)unit * 128 + l0) * 256 + cbl * 8 : (bf16*)(a.ws + (TYPE == 1 ? SSD_BN : SSD_CN)) + ((size_t)unit * 128 + l0) * 128 + cbl * 8;
    const int pitch = TYPE == 0 ? 256 : 128;
#pragma unroll
    for (int li = 0; li < 8; ++li) *(GAS v4u*)(dst + li * pitch) = nat[li];
}
__device__ __forceinline__ void ssd_state_unit(const Args& a, LAS unsigned char* lds, int unit, int tid, int wave, int lane) {
    const int c = unit & 15, g = (unit >> 4) & 1, b = unit >> 5, t0 = b * SEQ + c * 128;
    const float* DT = (const float*)(a.ws + WS_DT);
    if (wave < 4) {
        const int h = 4 * g + wave; const float av = -expf(a.a_log[h]);
        const float d0 = DT[(size_t)(t0 + 2 * lane) * 8 + h], d1 = DT[(size_t)(t0 + 2 * lane + 1) * 8 + h];
        const float v0 = av * d0, v1 = av * d1; float sc = v0 + v1;
#pragma unroll
        for (int o = 1; o < 64; o <<= 1) { const float t = __shfl_up(sc, o); if (lane >= o) sc += t; }
        const float A0 = sc - v1, A1 = sc, tot = __shfl(sc, 63);
        LAS float* ac = (LAS float*)(lds + SA_ACUM) + wave * 128 + 2 * lane; LAS float* wt = (LAS float*)(lds + SA_WTS) + wave * 128 + 2 * lane; LAS float* dd = (LAS float*)(lds + SA_DTS) + wave * 128 + 2 * lane;
        ac[0] = A0; ac[1] = A1; wt[0] = d0 * expf(tot - A0); wt[1] = d1 * expf(tot - A1); dd[0] = d0; dd[1] = d1;
        float* ag = (float*)(a.ws + SSD_ACUM) + ((size_t)unit * 4 + wave) * 128 + 2 * lane; ag[0] = A0; ag[1] = A1;
        if (lane == 0) ((float*)(a.ws + SSD_CD))[unit * 4 + wave] = expf(tot);
    }
    __syncthreads();
    ssd_conv_patch<0>(a, lds, unit, g, c, t0, lane & 31, 2 * wave + (lane >> 5));
    if (wave < 4) ssd_conv_patch<1>(a, lds, unit, g, c, t0, lane & 15, 4 * wave + (lane >> 4));
    else ssd_conv_patch<2>(a, lds, unit, g, c, t0, lane & 15, 4 * (wave - 4) + (lane >> 4));
    __syncthreads();
    const int r32 = lane & 31, hi = lane >> 5, pp = 32 * wave + r32;
    bf16x8 bx[8];
#pragma unroll
    for (int ks = 0; ks < 8; ++ks) bx[ks] = *(const LAS bf16x8*)(lds + SA_XT + img_off(pp, 2 * ks + hi));
    bf16* st = (bf16*)(a.ws + SSD_ST) + ((size_t)unit * 256 + pp) * 128;
#pragma unroll
    for (int nb = 0; nb < 4; ++nb) {
        f32x16 acc = {};
#pragma unroll
        for (int ks = 0; ks < 8; ++ks) { const bf16x8 af = *(const LAS bf16x8*)(lds + SA_BT + img_off(32 * nb + r32, 2 * ks + hi)); acc = __builtin_amdgcn_mfma_f32_32x32x16_bf16(af, bx[ks], acc, 0, 0, 0); }
#pragma unroll
        for (int rg = 0; rg < 4; ++rg) { u32x2 w; w.x = pk2(acc[4 * rg], acc[4 * rg + 1]); w.y = pk2(acc[4 * rg + 2], acc[4 * rg + 3]); *(GAS u32x2*)(st + (rg & 1) * 64 + (2 * nb + (rg >> 1)) * 8 + 4 * hi) = w; }
    }
    __syncthreads();
}

constexpr int SB_BN = 0, SB_CN = 34816, SB_ACUM = 69632, SB_SSQ = 71680, SB_RSTD = 75776;
__device__ __forceinline__ void ssd_out_unit(const Args& a, LAS unsigned char* lds, int unit, int tid, int wave, int lane) {
    const int c = unit & 15, g = (unit >> 4) & 1, b = unit >> 5, t0 = b * SEQ + c * 128;
    const int r32 = lane & 31, hi = lane >> 5, hl = wave >> 1, pp = 32 * wave + r32;
    for (int i = tid; i < 4096; i += NWAVES * 64) { const int im = i >> 11, idx = i & 2047, row = idx >> 4, ch = idx & 15;
        const v4u v = *(const GAS v4u*)((const bf16*)(a.ws + (im ? SSD_CN : SSD_BN)) + ((size_t)unit * 128 + row) * 128 + ch * 8);
        *(LAS v4u*)(lds + (im ? SB_CN : SB_BN) + img_off(row, ch)) = v; }
    ((LAS float*)(lds + SB_ACUM))[tid] = ((const float*)(a.ws + SSD_ACUM))[(size_t)unit * 512 + tid];
    bf16x8 pf[8];
    {
        float pv[8][8];
#pragma unroll
        for (int ks = 0; ks < 8; ++ks)
#pragma unroll
            for (int j = 0; j < 8; ++j) pv[ks][j] = 0.f;
        const float* cdp = (const float*)(a.ws + SSD_CD) + (unit - c) * 4 + hl; const bf16* sp0 = (const bf16*)(a.ws + SSD_ST) + ((size_t)(unit - c) * 256 + pp) * 128 + 64 * hi;
        float wgt = 1.f; int cc = c - 1;
        for (; cc >= 1; cc -= 2) {
            const bf16* spa = sp0 + (size_t)cc * 256 * 128; const bf16* spb = spa - 256 * 128;
            v4u sa[8], sb[8];
#pragma unroll
            for (int ks = 0; ks < 8; ++ks) { sa[ks] = *(const GAS v4u*)(spa + 8 * ks); sb[ks] = *(const GAS v4u*)(spb + 8 * ks); }
            const float wa = wgt, wb = wgt * cdp[cc * 4]; wgt = wb * cdp[(cc - 1) * 4];
#pragma unroll
            for (int ks = 0; ks < 8; ++ks)
#pragma unroll
                for (int j = 0; j < 4; ++j) { pv[ks][2 * j] += wa * __uint_as_float(sa[ks][j] << 16) + wb * __uint_as_float(sb[ks][j] << 16); pv[ks][2 * j + 1] += wa * __uint_as_float(sa[ks][j] & 0xffff0000u) + wb * __uint_as_float(sb[ks][j] & 0xffff0000u); }
        }
        if (cc == 0) {
#pragma unroll
            for (int ks = 0; ks < 8; ++ks) { const v4u s = *(const GAS v4u*)(sp0 + 8 * ks);
#pragma unroll
                for (int j = 0; j < 4; ++j) { pv[ks][2 * j] += wgt * __uint_as_float(s[j] << 16); pv[ks][2 * j + 1] += wgt * __uint_as_float(s[j] & 0xffff0000u); } }
        }
#pragma unroll
        for (int ks = 0; ks < 8; ++ks) { v4u w; w.x = pk2(pv[ks][0], pv[ks][1]); w.y = pk2(pv[ks][2], pv[ks][3]); w.z = pk2(pv[ks][4], pv[ks][5]); w.w = pk2(pv[ks][6], pv[ks][7]); pf[ks] = __builtin_bit_cast(bf16x8, w); }
    }
    const bf16* xp = (const bf16*)(a.ws + SSD_XDT) + ((size_t)unit * 256 + pp) * 128 + 8 * hi;
    __syncthreads();
    const LAS float* acum = (const LAS float*)(lds + SB_ACUM) + hl * 128;
    f32x16 y[4];
#pragma unroll
    for (int lb = 0; lb < 4; ++lb) {
        f32x16 ao = {};
#pragma unroll
        for (int ks = 0; ks < 8; ++ks) { const bf16x8 bfr = *(const LAS bf16x8*)(lds + SB_CN + img_off(32 * lb + r32, 2 * ks + hi)); ao = __builtin_amdgcn_mfma_f32_32x32x16_bf16(pf[ks], bfr, ao, 0, 0, 0); }
        const float eL = __builtin_amdgcn_exp2f(1.4426950408889634f * acum[32 * lb + r32]);
#pragma unroll
        for (int r = 0; r < 16; ++r) y[lb][r] = eL * ao[r];
        __builtin_amdgcn_sched_barrier(0);
    }
#pragma unroll
    for (int lb = 0; lb < 4; ++lb) {
        const float AcL = acum[32 * lb + r32];
        f32x16 ay = y[lb];
#pragma unroll
        for (int sb = 0; sb < 4; ++sb) if (sb <= lb) {
            f32x16 cbt = {};
#pragma unroll
            for (int ks = 0; ks < 8; ++ks) { const bf16x8 af = *(const LAS bf16x8*)(lds + SB_BN + img_off(32 * sb + r32, 2 * ks + hi)); const bf16x8 bfr = *(const LAS bf16x8*)(lds + SB_CN + img_off(32 * lb + r32, 2 * ks + hi));
                cbt = __builtin_amdgcn_mfma_f32_32x32x16_bf16(af, bfr, cbt, 0, 0, 0); }
            float m[16];
#pragma unroll
            for (int rg = 0; rg < 4; ++rg) { const f32x4 as = *(const LAS f32x4*)(acum + 32 * sb + 8 * rg + 4 * hi);
#pragma unroll
                for (int q = 0; q < 4; ++q) { const int r = 4 * rg + q; float v = cbt[r] * __builtin_amdgcn_exp2f(1.4426950408889634f * (AcL - as[q]));
                    if (sb == lb) v = (8 * rg + 4 * hi + q <= r32) ? v : 0.f;
                    m[r] = v; } }
            v4u w0, w1; w0.x = pk2(m[0], m[1]); w0.y = pk2(m[2], m[3]); w0.z = pk2(m[4], m[5]); w0.w = pk2(m[6], m[7]); w1.x = pk2(m[8], m[9]); w1.y = pk2(m[10], m[11]); w1.z = pk2(m[12], m[13]); w1.w = pk2(m[14], m[15]);
            const bf16x8 xa0 = *(const GAS bf16x8*)(xp + 32 * sb), xa1 = *(const GAS bf16x8*)(xp + 32 * sb + 16);
            ay = __builtin_amdgcn_mfma_f32_32x32x16_bf16(xa0, __builtin_bit_cast(bf16x8, w0), ay, 0, 0, 0);
            ay = __builtin_amdgcn_mfma_f32_32x32x16_bf16(xa1, __builtin_bit_cast(bf16x8, w1), ay, 0, 0, 0);
            __builtin_amdgcn_sched_barrier(0);
        }
        y[lb] = ay;
        __builtin_amdgcn_sched_barrier(0);
    }
    const float dsk = a.d_skip[4 * g + hl];
    const bf16* PJ = (const bf16*)(a.ws + WS_PJ); const bf16* XN = (const bf16*)(a.ws + SSD_XN) + (size_t)unit * 128 * 256;
    LAS float* ssq = (LAS float*)(lds + SB_SSQ);
#pragma unroll
    for (int lb = 0; lb < 4; ++lb) { const int l = 32 * lb + r32; float s = 0.f;
#pragma unroll
        for (int rg = 0; rg < 4; ++rg) { const int p0 = 32 * wave + 8 * rg + 4 * hi;
            const u32x2 xw = *(const GAS u32x2*)(XN + (size_t)l * 256 + p0); const u32x2 zw = *(const GAS u32x2*)(PJ + (size_t)(t0 + l) * NPJ + g * 256 + p0);
            const float xv[4] = {__uint_as_float(xw.x << 16), __uint_as_float(xw.x & 0xffff0000u), __uint_as_float(xw.y << 16), __uint_as_float(xw.y & 0xffff0000u)};
            const float zv[4] = {__uint_as_float(zw.x << 16), __uint_as_float(zw.x & 0xffff0000u), __uint_as_float(zw.y << 16), __uint_as_float(zw.y & 0xffff0000u)};
#pragma unroll
            for (int q = 0; q < 4; ++q) { const float v = (y[lb][4 * rg + q] + dsk * xv[q]) * silu_fast(zv[q]); y[lb][4 * rg + q] = v; s += v * v; } }
        s += __shfl_xor(s, 32);
        if (hi == 0) ssq[wave * 128 + l] = s;
        __builtin_amdgcn_sched_barrier(0); }
    __syncthreads();
    if (tid < 128) { float s = 0.f;
#pragma unroll
        for (int w = 0; w < 8; ++w) s += ssq[w * 128 + tid];
        ((LAS float*)(lds + SB_RSTD))[tid] = 1.f / sqrtf(s * (1.f / 256.f) + 1e-5f); }
    __syncthreads();
    bf16* YC = (bf16*)(a.ws + WS_YC);
#pragma unroll
    for (int lb = 0; lb < 4; ++lb) { const int l = 32 * lb + r32; const float rs = ((const LAS float*)(lds + SB_RSTD))[l];
#pragma unroll
        for (int rg = 0; rg < 4; ++rg) { const int p0 = 32 * wave + 8 * rg + 4 * hi; const f32x4 nw = *(const GAS f32x4*)(a.ssd_norm_w + g * 256 + p0);
            u32x2 w; w.x = pk2(y[lb][4 * rg] * rs * nw.x, y[lb][4 * rg + 1] * rs * nw.y); w.y = pk2(y[lb][4 * rg + 2] * rs * nw.z, y[lb][4 * rg + 3] * rs * nw.w);
            *(GAS u32x2*)(YC + (size_t)(t0 + l) * 1024 + g * 256 + p0) = w; } }
    __syncthreads();
}
__device__ __forceinline__ void attn_post(const Args& a, int vcu, int G, int wave, int lane) {
    bf16* YC = (bf16*)(a.ws + WS_YC); const bf16* O = (const bf16*)(a.ws + WS_O);
    const int gw = vcu * NWAVES + wave, NGW = G * NWAVES;
    const float lam = expf(wave_sum(a.lq1[lane] * a.lk1[lane])) - expf(wave_sum(a.lq2[lane] * a.lk2[lane])) + LAM_INIT;
    const int h = lane >> 4, sidx = lane & 15, e0 = ((sidx >> 2) & 1) * 64 + (sidx & 3) * 16;
    f32x4 sw[4];
#pragma unroll
    for (int q = 0; q < 4; ++q) sw[q] = *(const GAS f32x4*)(a.subln_w + (e0 & 127) + 4 * q);
#pragma unroll 2
    for (int t = gw; t < T; t += NGW) {
        const v4u w0 = *(const GAS v4u*)(O + (size_t)t * 1024 + lane * 16), w1 = *(const GAS v4u*)(O + (size_t)t * 1024 + lane * 16 + 8);
        float v[16]; float ss = 0.f;
#pragma unroll
        for (int q = 0; q < 8; ++q) { const unsigned mine = q < 4 ? w0[q] : w1[q - 4]; const unsigned oth = __shfl_xor(mine, 8);
            v[2 * q] = __uint_as_float(mine << 16) - lam * __uint_as_float(oth << 16); v[2 * q + 1] = __uint_as_float(mine & 0xffff0000u) - lam * __uint_as_float(oth & 0xffff0000u);
            ss += v[2 * q] * v[2 * q] + v[2 * q + 1] * v[2 * q + 1]; }
        ss += __shfl_xor(ss, 1); ss += __shfl_xor(ss, 2); ss += __shfl_xor(ss, 4);
        const float r = (1.f - LAM_INIT) / sqrtf(ss * (1.f / 128.f) + 1e-5f);
        if (sidx < 8) { v4u o0, o1;
            o0.x = pk2(v[0] * r * sw[0].x, v[1] * r * sw[0].y); o0.y = pk2(v[2] * r * sw[0].z, v[3] * r * sw[0].w); o0.z = pk2(v[4] * r * sw[1].x, v[5] * r * sw[1].y); o0.w = pk2(v[6] * r * sw[1].z, v[7] * r * sw[1].w);
            o1.x = pk2(v[8] * r * sw[2].x, v[9] * r * sw[2].y); o1.y = pk2(v[10] * r * sw[2].z, v[11] * r * sw[2].w); o1.z = pk2(v[12] * r * sw[3].x, v[13] * r * sw[3].y); o1.w = pk2(v[14] * r * sw[3].z, v[15] * r * sw[3].w);
            bf16* dst = YC + (size_t)t * 1024 + 512 + h * 128 + e0; *(GAS v4u*)dst = o0; *(GAS v4u*)(dst + 8) = o1; }
    }
}

constexpr int NPHASE = 11;
__global__ void __launch_bounds__(NWAVES * 64, 2) mk_fwd(Args a) {
    extern __shared__ __attribute__((aligned(16))) unsigned char lds_raw[];
    LAS unsigned char* lds = (LAS unsigned char*)lds_raw;
    const int tid0 = threadIdx.x;
    const int G = gridDim.x; const int bx = blockIdx.x; const int vcu = (G % 8 == 0) ? (bx % 8) * (G / 8) + bx / 8 : bx;
    unsigned char* ws = a.ws; gu32* ctl = (gu32*)(ws + WS_CTL);
    for (int u = tid0; u < (LDS_BYTES - LDSCTL_OFF) / 4; u += NWAVES * 64) ((LAS unsigned*)(lds + LDSCTL_OFF))[u] = 0u;
    __syncthreads();
    volatile LAS unsigned* MISC = (volatile LAS unsigned*)(lds + MISC_OFF);
    XcdBarrier bar; bar.bar = (unsigned*)(ctl + CW_BAR); bar.x = 0; bar.st = nullptr;
    if (a.bar_li >= 0) bar = xcd_barrier_post((unsigned*)(ctl + CW_BAR) + a.bar_li * XCD_BAR_WORDS, MISC + 8);
    const int lo = a.ph_lo, hi = a.ph_hi;
#define IN(k) (lo <= (k) && (k) < hi)
#define IDS() int tid = threadIdx.x; asm volatile("" : "+v"(tid)); const int lane = tid & 63, wave = __builtin_amdgcn_readfirstlane(tid >> 6); (void)lane; (void)wave
#define SEAM(k) do { if (IN(k) && IN((k) + 1)) xcd_barrier(bar); } while (0)
    const LAS unsigned* gtab = (const LAS unsigned*)(lds + GTAB_OFF);
    bf16* H = (bf16*)(ws + WS_H); bf16* PJ = (bf16*)(ws + WS_PJ);

    if (IN(0)) { IDS(); p0_prologue(a, lds, vcu, G, wave, lane, tid); SEAM(0); }
    if (IN(1)) {
        { pg8::DenseOrder S; S.init(H, ws + WS_WIN, T, NPJ, D, G, bx); pg8::EpiBf16S E{PJ, NPJ, 6, 8, attn_body::C2};
          pg8::gemm_phase<pg8::EpiBf16S, pg8::DenseOrder, false, true, true>(lds + RING_OFF, D, S, E, gtab); }
        { pg8::DenseOrder S; S.init(ws + WS_P16, ws + WS_WP, T, D, PLE, G, bx); pg8::EpiBf16S E{(bf16*)(ws + WS_PP), D, 0, 0, 1.f};
          pg8::gemm_phase<pg8::EpiBf16S, pg8::DenseOrder, false, true, true>(lds + RING_OFF, PLE, S, E, gtab); }
        SEAM(1);
    }
    if (IN(2)) {
        IDS();
        for (int unit = vcu; unit < 256; unit += G) ssd_state_unit(a, lds, unit, tid, wave, lane);
        const attn_body::AttnTensors AT{(const attn_body::bf16*)PJ, (attn_body::bf16*)(ws + WS_O)};
        const attn_body::StaticOrder S(vcu);
        attn_body::attn_phase<attn_body::StaticOrder>((char*)lds_raw + RING_OFF, AT, S);
        SEAM(2);
    }
    if (IN(3)) {
        IDS();
        if (!(a.dry & 4)) for (int unit = vcu; unit < 256; unit += G) ssd_out_unit(a, lds, unit, tid, wave, lane);
        if (!(a.dry & 2)) attn_post(a, vcu, G, wave, lane);
        else for (int unit = vcu; unit < 256; unit += G) {}
        SEAM(3);
    }
    if (IN(4)) {
        pg8::DenseOrder S; S.init(ws + WS_YC, ws + WS_WOUT, T, D, D, G, bx); pg8::EpiResF32 E{a.x, (float*)(ws + WS_X1), D};
        pg8::gemm_phase<pg8::EpiResF32, pg8::DenseOrder, false, false, true>(lds + RING_OFF, D, S, E, gtab);
        SEAM(4);
    }
    if (IN(5)) { IDS(); p5_router(a, lds, vcu, G, wave, lane, tid); SEAM(5); }
    if (IN(6)) {
        IDS(); moe_setup(a, lds, tid);
        const LAS int* mts = (const LAS int*)(lds + MTS_OFF); const int NN = FF2 / 256, U = __builtin_amdgcn_readfirstlane(mts[NE]) * NN;
        const int u0 = (int)((long)vcu * U / G), u1 = (int)((long)(vcu + 1) * U / G);
        moe_gtab(a, lds, tid, u0, u1, NN);
        pg8::MoeOrder S{mts, (const char*)(ws + WS_H8), (const char*)(ws + WS_WUP), (size_t)256 * D, (size_t)FF2 * D, NN, u0, u1, 1};
        pg8::EpiMoeUp8 E{ws + WS_ACT, a.b_up};
        pg8::gemm_phase<pg8::EpiMoeUp8, pg8::MoeOrder, true, true, true, true>(lds + RING_OFF, D, S, E, gtab);
        SEAM(6);
    }
    if (IN(7)) {
        IDS(); moe_setup(a, lds, tid);
        const LAS int* mts = (const LAS int*)(lds + MTS_OFF); const int NN = D / 256, U = __builtin_amdgcn_readfirstlane(mts[NE]) * NN;
        const int u0 = (int)((long)vcu * U / G), u1 = (int)((long)(vcu + 1) * U / G);
        { LAS unsigned* gt = (LAS unsigned*)(lds + GTAB_OFF);
          for (int i = 0; i < u1 - u0 && i < GTAB_UNITS; ++i) { const int mt = (u0 + i) / NN; if (tid < 256) gt[i * 256 + tid] = (unsigned)(mt * 256 + tid) * (unsigned)D; }
          __syncthreads(); }
        pg8::MoeOrder S{mts, (const char*)(ws + WS_ACT), (const char*)(ws + WS_WDN), (size_t)256 * D, (size_t)D * D, NN, u0, u1, 1};
        pg8::EpiMoeDown8 E{(bf16*)(ws + WS_YS), a.b_down, (const float*)(ws + WS_ROWGATE)};
        pg8::gemm_phase<pg8::EpiMoeDown8, pg8::MoeOrder, true, true, true, true>(lds + RING_OFF, D, S, E, gtab);
        SEAM(7);
    }
    if (IN(8)) { IDS(); moe_setup(a, lds, tid); p8_combine(a, lds, vcu, G, wave, lane); SEAM(8); }
    if (IN(9)) {
        pg8::DenseOrder S; S.init(H, ws + WS_WG, T, D, D, G, bx); pg8::EpiPle E{(const float*)(ws + WS_X2), (const bf16*)(ws + WS_PP), (float*)(ws + WS_X1), D};
        pg8::gemm_phase<pg8::EpiPle, pg8::DenseOrder, false, false, true>(lds + RING_OFF, D, S, E, gtab);
        SEAM(9);
    }
    if (IN(10)) { IDS(); p10_final(a, vcu, G, wave, lane); }
#undef IN
#undef IDS
#undef SEAM
}

extern "C" void kernel_launch(void* const* d_in, const int* in_sizes, int n_in, void* d_out, int out_size, void* d_ws, size_t ws_size, hipStream_t stream) {
    static int grid = 0;
    if (grid == 0) {
        int dev = 0, cus = 0, per_cu = 0;
        if (n_in != 27 || out_size != T * D || ws_size < WS_END) { fprintf(stderr, "kernel_launch: unexpected shapes (n_in %d out %d ws %zu)\n", n_in, out_size, ws_size); grid = -1; return; }
        if (hipGetDevice(&dev) != hipSuccess || hipDeviceGetAttribute(&cus, hipDeviceAttributeMultiprocessorCount, dev) != hipSuccess) { grid = -1; return; }
        if (hipFuncSetAttribute((const void*)mk_fwd, hipFuncAttributeMaxDynamicSharedMemorySize, LDS_BYTES) != hipSuccess) { fprintf(stderr, "kernel_launch: hipFuncSetAttribute failed\n"); grid = -1; return; }
        if (hipOccupancyMaxActiveBlocksPerMultiprocessor(&per_cu, (const void*)mk_fwd, NWAVES * 64, LDS_BYTES) != hipSuccess || per_cu < 1) { fprintf(stderr, "kernel_launch: occupancy query says %d blocks per CU\n", per_cu); (void)hipGetLastError(); grid = -1; return; }
        grid = cus;
    }
    if (grid < 0) return;
    if (hipMemsetAsync((char*)d_ws + WS_CTL, 0, CTL_ZERO_BYTES, stream) != hipSuccess) return;
    Args a{};
    const float** ap = (const float**)&a;
    for (int i = 0; i < 27; ++i) ap[i] = (const float*)d_in[i];
    a.out = (float*)d_out; a.ws = (unsigned char*)d_ws; a.bar_li = -1; a.dry = 0;
#ifndef PROBE_PHASE
#define PROBE_PHASE -1
#endif
#ifndef PROBE_DRY
#define PROBE_DRY 0
#endif
    if (PROBE_PHASE < 0) { a.bar_li = 0; a.ph_lo = 0; a.ph_hi = NPHASE; hipLaunchKernelGGL(mk_fwd, dim3(grid), dim3(NWAVES * 64), LDS_BYTES, stream, a); }
    else {
        const int P = PROBE_PHASE;
        a.bar_li = 0; a.ph_lo = 0; a.ph_hi = (P == 5) ? 5 : P + 1; hipLaunchKernelGGL(mk_fwd, dim3(grid), dim3(NWAVES * 64), LDS_BYTES, stream, a);
        a.bar_li = 1; a.ph_lo = P; a.ph_hi = P + 1; a.dry = (P == 5) ? 1 : PROBE_DRY; hipLaunchKernelGGL(mk_fwd, dim3(grid), dim3(NWAVES * 64), LDS_BYTES, stream, a);
        a.bar_li = 2; a.ph_lo = (P == 5) ? 5 : P + 1; a.ph_hi = NPHASE; a.dry = 0; if (a.ph_lo < NPHASE) hipLaunchKernelGGL(mk_fwd, dim3(grid), dim3(NWAVES * 64), LDS_BYTES, stream, a);
    }
}
```

```cpp
#include <hip/hip_runtime.h>
#include <cstdio>
#include <cstdint>
namespace pg8 {
#define PG8_LAS __attribute__((address_space(3)))
typedef unsigned short bf16_t;
typedef short bf16x8 __attribute__((ext_vector_type(8)));
typedef float f32x4 __attribute__((ext_vector_type(4)));
typedef unsigned u32x4 __attribute__((ext_vector_type(4)));
constexpr int BM = 256, BK = 64, HALF = 128, HTB = HALF * BK * 2  , STAGE_BYTES = 8 * HTB, NXCD = 8, WGM = 8;

__host__ __device__ __forceinline__ int lds_byte(int r, int c) { const int st = (r >> 4) * 2 + (c >> 5), rr = r & 15, cc = c & 31, ob = rr * 64 + cc * 2; return st * 1024 + (ob ^ (((ob >> 9) & 1) << 5)); }
__host__ __device__ __forceinline__ void stage_rc(int b, int& R, int& C) { const int st = b / 1024, sb = b % 1024, swz = sb ^ (((sb >> 9) & 1) << 5); R = (st >> 1) * 16 + swz / 64; C = (st & 1) * 32 + (swz % 64) / 2; }
__host__ __device__ __forceinline__ int perm32(int rho) { const int n = rho >> 4, i = rho & 15; return 8 * (i >> 2) + 4 * n + (i & 3); }


struct Unit { int pm, pn, e, r0; };
__device__ __forceinline__ unsigned cvt_pk_bf16(float lo, float hi) { unsigned r; asm volatile("v_cvt_pk_bf16_f32 %0, %1, %2" : "=v"(r) : "v"(lo), "v"(hi)); return r; }

struct DenseOrder {
    const char* A; const char* Bt; size_t tstep; int nM, nN, nwg, G, c;
    __device__ __forceinline__ void init(const void* A_, const void* Bt_, int M, int N, int K, int G_, int c_) { A = (const char*)A_; Bt = (const char*)Bt_; tstep = (size_t)BM * K * 2; nM = M / BM; nN = N / BM; nwg = nM * nN; G = G_; c = c_; }
    __device__ __forceinline__ bool next(int i, Unit& u) const {
        const long L = (long)i * G + c; if (L >= nwg) return false;
        int wgid = (int)L; { const int q = nwg / NXCD, r = nwg % NXCD, xcd = wgid % NXCD, off = wgid / NXCD; wgid = (xcd < r ? xcd * (q + 1) : r * (q + 1) + (xcd - r) * q) + off; }
        const int nig = WGM * nN, gid = wgid / nig, fm = gid * WGM, gsz = (nM - fm) < WGM ? (nM - fm) : WGM;
        u.pm = __builtin_amdgcn_readfirstlane(fm + ((wgid % nig) % gsz)); u.pn = __builtin_amdgcn_readfirstlane((wgid % nig) / gsz); u.e = 0; u.r0 = 0; return true;
    }
    __device__ __forceinline__ const char* a_ptr(const Unit& u) const { return A + (size_t)u.pm * tstep; }
    __device__ __forceinline__ const char* b_ptr(const Unit& u) const { return Bt + (size_t)u.pn * tstep; }
    __device__ __forceinline__ void a_ready(const Unit&) const {}
    __device__ __forceinline__ void done(const Unit&) const {}
};
struct MoeOrder {
    const PG8_LAS int* mts; const char* A; const char* Bt; size_t tstep, bexp; int NN, u0, u1, gather;
    __device__ __forceinline__ bool next(int i, Unit& u) const {
        const int idx = u0 + i; if (idx >= u1) return false;
        const int mt = __builtin_amdgcn_readfirstlane(idx / NN); u.pn = idx - mt * NN; u.pm = mt;
        int e = 0;
        for (int k = 1; k < 32; ++k) e += (__builtin_amdgcn_readfirstlane(mts[k]) <= mt) ? 1 : 0;
        u.e = e; u.r0 = (mt - __builtin_amdgcn_readfirstlane(mts[e])) * BM; return true;
    }
    __device__ __forceinline__ const char* a_ptr(const Unit& u) const { return gather ? A : A + (size_t)u.pm * tstep; }
    __device__ __forceinline__ const char* b_ptr(const Unit& u) const { return Bt + (size_t)u.e * bexp + (size_t)u.pn * tstep; }
    __device__ __forceinline__ void a_ready(const Unit&) const {}
    __device__ __forceinline__ void done(const Unit&) const {}
};

struct EpiBf16S {
    static constexpr bool PERM = true, AFTER_DRAIN = false;
    bf16_t* O; int ldc; int st0, st1; float scale;
    __device__ __forceinline__ void operator()(const f32x4 (&acc)[2][2][4][2], const Unit& u, int wr, int wc, int fr, int fq) const {
        const int row0 = u.pm * BM + wr * 64 + fr, col0 = u.pn * BM + wc * 32 + 8 * fq;
        const float sc = (u.pn >= st0 && u.pn < st1) ? scale : 1.f;
#pragma unroll
        for (int ai = 0; ai < 2; ++ai)
#pragma unroll
            for (int m = 0; m < 4; ++m) { bf16_t* rowp = O + (size_t)(row0 + ai * HALF + m * 16) * ldc + col0;
#pragma unroll
                for (int bj = 0; bj < 2; ++bj) { const f32x4 v0 = acc[ai][bj][m][0] * sc, v1 = acc[ai][bj][m][1] * sc;
                    u32x4 w; w.x = cvt_pk_bf16(v0[0], v0[1]); w.y = cvt_pk_bf16(v0[2], v0[3]); w.z = cvt_pk_bf16(v1[0], v1[1]); w.w = cvt_pk_bf16(v1[2], v1[3]);
                    *(u32x4*)(rowp + bj * HALF) = w; } }
    }
};
struct EpiResF32 {
    static constexpr bool PERM = false, AFTER_DRAIN = false;
    const float* base; float* out; int ldc;
    __device__ __forceinline__ void operator()(const f32x4 (&acc)[2][2][4][2], const Unit& u, int wr, int wc, int fr, int fq) const {
        const int row0 = u.pm * BM + wr * 64 + fr, col0 = u.pn * BM + wc * 32 + 4 * fq;
#pragma unroll
        for (int ai = 0; ai < 2; ++ai)
#pragma unroll
            for (int m = 0; m < 4; ++m) { const size_t off = (size_t)(row0 + ai * HALF + m * 16) * ldc + col0;
#pragma unroll
                for (int bj = 0; bj < 2; ++bj)
#pragma unroll
                    for (int n = 0; n < 2; ++n) { const f32x4 b = *(const f32x4*)(base + off + bj * HALF + n * 16); *(f32x4*)(out + off + bj * HALF + n * 16) = b + acc[ai][bj][m][n]; } }
    }
};
__device__ __forceinline__ float sigm_fast(float v) { return __builtin_amdgcn_rcpf(1.f + __builtin_amdgcn_exp2f(-1.4426950408889634f * v)); }
struct EpiPle {
    static constexpr bool PERM = false, AFTER_DRAIN = false;
    const float* base; const bf16_t* pp; float* out; int ldc;
    __device__ __forceinline__ void operator()(const f32x4 (&acc)[2][2][4][2], const Unit& u, int wr, int wc, int fr, int fq) const {
        typedef unsigned u32x2 __attribute__((ext_vector_type(2)));
        const int row0 = u.pm * BM + wr * 64 + fr, col0 = u.pn * BM + wc * 32 + 4 * fq;
#pragma unroll
        for (int ai = 0; ai < 2; ++ai)
#pragma unroll
            for (int m = 0; m < 4; ++m) { const size_t off = (size_t)(row0 + ai * HALF + m * 16) * ldc + col0;
#pragma unroll
                for (int bj = 0; bj < 2; ++bj)
#pragma unroll
                    for (int n = 0; n < 2; ++n) { const size_t o2 = off + bj * HALF + n * 16; const f32x4 b = *(const f32x4*)(base + o2); const u32x2 pw = *(const u32x2*)(pp + o2); const f32x4 a = acc[ai][bj][m][n];
                        f32x4 r; r[0] = b[0] + __uint_as_float(pw.x << 16) * sigm_fast(a[0]); r[1] = b[1] + __uint_as_float(pw.x & 0xffff0000u) * sigm_fast(a[1]);
                        r[2] = b[2] + __uint_as_float(pw.y << 16) * sigm_fast(a[2]); r[3] = b[3] + __uint_as_float(pw.y & 0xffff0000u) * sigm_fast(a[3]);
                        *(f32x4*)(out + o2) = r; } }
    }
};
struct EpiMoeUp {
    static constexpr bool PERM = true, AFTER_DRAIN = false;
    bf16_t* act; const float* bias;
    __device__ __forceinline__ void operator()(const f32x4 (&acc)[2][2][4][2], const Unit& u, int wr, int wc, int fr, int fq) const {
        typedef unsigned u32x2 __attribute__((ext_vector_type(2)));
        const int row0 = u.pm * BM + wr * 64 + fr, col0 = u.pn * BM + wc * 32 + 8 * fq;
        const float* bp = bias + (size_t)u.e * 2048 + col0;
        f32x4 bv[2][2];
#pragma unroll
        for (int bj = 0; bj < 2; ++bj)
#pragma unroll
            for (int n = 0; n < 2; ++n) bv[bj][n] = *(const f32x4*)(bp + bj * HALF + 4 * n);
#pragma unroll
        for (int ai = 0; ai < 2; ++ai)
#pragma unroll
            for (int m = 0; m < 4; ++m) { bf16_t* rowp = act + (size_t)(row0 + ai * HALF + m * 16) * 1024 + (col0 >> 1);
#pragma unroll
                for (int bj = 0; bj < 2; ++bj) { const f32x4 v0 = acc[ai][bj][m][0] + bv[bj][0], v1 = acc[ai][bj][m][1] + bv[bj][1];
                    float o[4];
#pragma unroll
                    for (int q = 0; q < 4; ++q) { const float g = fminf(q < 2 ? v0[2 * q] : v1[2 * q - 4], 7.f); const float up = fminf(fmaxf(q < 2 ? v0[2 * q + 1] : v1[2 * q - 3], -7.f), 7.f);
                        o[q] = (up + 1.f) * g * sigm_fast(1.702f * g); }
                    u32x2 w; w.x = cvt_pk_bf16(o[0], o[1]); w.y = cvt_pk_bf16(o[2], o[3]);
                    *(u32x2*)(rowp + bj * (HALF / 2)) = w; } }
    }
};
struct EpiMoeDown {
    static constexpr bool PERM = true, AFTER_DRAIN = false;
    bf16_t* ys; const float* bias; const float* row_gate;
    __device__ __forceinline__ void operator()(const f32x4 (&acc)[2][2][4][2], const Unit& u, int wr, int wc, int fr, int fq) const {
        const int lrow0 = wr * 64 + fr, col0 = u.pn * BM + wc * 32 + 8 * fq;
        const float* bp = bias + (size_t)u.e * 1024 + col0; const float* gp = row_gate + (size_t)u.e * 16384 + u.r0;
        f32x4 bv[2][2];
#pragma unroll
        for (int bj = 0; bj < 2; ++bj)
#pragma unroll
            for (int n = 0; n < 2; ++n) bv[bj][n] = *(const f32x4*)(bp + bj * HALF + 4 * n);
#pragma unroll
        for (int ai = 0; ai < 2; ++ai)
#pragma unroll
            for (int m = 0; m < 4; ++m) { const int lr = lrow0 + ai * HALF + m * 16; const float g = gp[lr]; bf16_t* rowp = ys + (size_t)(u.pm * BM + lr) * 1024 + col0;
#pragma unroll
                for (int bj = 0; bj < 2; ++bj) { const f32x4 v0 = (acc[ai][bj][m][0] + bv[bj][0]) * g, v1 = (acc[ai][bj][m][1] + bv[bj][1]) * g;
                    u32x4 w; w.x = cvt_pk_bf16(v0[0], v0[1]); w.y = cvt_pk_bf16(v0[2], v0[3]); w.z = cvt_pk_bf16(v1[0], v1[1]); w.w = cvt_pk_bf16(v1[2], v1[3]);
                    *(u32x4*)(rowp + bj * HALF) = w; } }
    }
};

__device__ __forceinline__ unsigned pk4_fp8(float a, float b, float c, float d) { unsigned u = __builtin_amdgcn_cvt_pk_fp8_f32(a, b, 0u, false); return __builtin_amdgcn_cvt_pk_fp8_f32(c, d, u, true); }
constexpr float W8_SCALE = 64.f, W8_INV = 1.f / 64.f;
struct EpiMoeUp8 {
    static constexpr bool PERM = true, AFTER_DRAIN = false;
    unsigned char* act; const float* bias;
    __device__ __forceinline__ void operator()(const f32x4 (&acc)[2][2][4][2], const Unit& u, int wr, int wc, int fr, int fq) const {
        const int row0 = u.pm * BM + wr * 64 + fr, col0 = u.pn * BM + wc * 32 + 8 * fq;
        const float* bp = bias + (size_t)u.e * 2048 + col0;
        f32x4 bv[2][2];
#pragma unroll
        for (int bj = 0; bj < 2; ++bj)
#pragma unroll
            for (int n = 0; n < 2; ++n) bv[bj][n] = *(const f32x4*)(bp + bj * HALF + 4 * n);
#pragma unroll
        for (int ai = 0; ai < 2; ++ai)
#pragma unroll
            for (int m = 0; m < 4; ++m) { unsigned char* rowp = act + (size_t)(row0 + ai * HALF + m * 16) * 1024 + (col0 >> 1);
#pragma unroll
                for (int bj = 0; bj < 2; ++bj) { const f32x4 v0 = acc[ai][bj][m][0] * W8_INV + bv[bj][0], v1 = acc[ai][bj][m][1] * W8_INV + bv[bj][1];
                    float o[4];
#pragma unroll
                    for (int q = 0; q < 4; ++q) { const float g = fminf(q < 2 ? v0[2 * q] : v1[2 * q - 4], 7.f); const float up = fminf(fmaxf(q < 2 ? v0[2 * q + 1] : v1[2 * q - 3], -7.f), 7.f);
                        o[q] = (up + 1.f) * g * sigm_fast(1.702f * g); }
                    *(unsigned*)(rowp + bj * (HALF / 2)) = pk4_fp8(o[0], o[1], o[2], o[3]); } }
    }
};
struct EpiMoeDown8 {
    static constexpr bool PERM = true, AFTER_DRAIN = false;
    bf16_t* ys; const float* bias; const float* row_gate;
    __device__ __forceinline__ void operator()(const f32x4 (&acc)[2][2][4][2], const Unit& u, int wr, int wc, int fr, int fq) const {
        int lrow0 = wr * 64 + fr; asm volatile("" : "+v"(lrow0));
        const int col0 = u.pn * BM + wc * 32 + 8 * fq;
        const float* bp = bias + (size_t)u.e * 1024 + col0; const float* gp = row_gate + (size_t)u.e * 16384 + u.r0;
#pragma unroll
        for (int bj = 0; bj < 2; ++bj) {
            const f32x4 b0 = *(const f32x4*)(bp + bj * HALF), b1 = *(const f32x4*)(bp + bj * HALF + 4);
#pragma unroll
            for (int ai = 0; ai < 2; ++ai)
#pragma unroll
                for (int m = 0; m < 4; ++m) { const int lr = lrow0 + ai * HALF + m * 16; const float g = gp[lr], g64 = g * W8_INV; bf16_t* rowp = ys + (size_t)(u.pm * BM + lr) * 1024 + col0 + bj * HALF;
                    const f32x4 v0 = acc[ai][bj][m][0] * g64 + b0 * g, v1 = acc[ai][bj][m][1] * g64 + b1 * g;
                    u32x4 w; w.x = cvt_pk_bf16(v0[0], v0[1]); w.y = cvt_pk_bf16(v0[2], v0[3]); w.z = cvt_pk_bf16(v1[0], v1[1]); w.w = cvt_pk_bf16(v1[2], v1[3]);
                    *(u32x4*)rowp = w; }
            asm volatile("" ::: "memory");
        }
    }
};

typedef int i32x4 __attribute__((ext_vector_type(4))); typedef int i32x8 __attribute__((ext_vector_type(8)));
__device__ __forceinline__ i32x8 cat8(bf16x8 a, bf16x8 b) { const i32x4 x = __builtin_bit_cast(i32x4, a), y = __builtin_bit_cast(i32x4, b); return __builtin_shufflevector(x, y, 0, 1, 2, 3, 4, 5, 6, 7); }
template <class Epi, class Sched, bool GATHER = false, bool ALIGN_EPI = false, bool SP2 = false, bool F8 = false>
__device__ __forceinline__ void gemm_phase(PG8_LAS unsigned char* lds, const int K, const Sched& S, const Epi& E, const PG8_LAS unsigned* gtab) {
    const int tid = threadIdx.x, wid = __builtin_amdgcn_readfirstlane(tid >> 6), lane = tid & 63, wr = wid >> 2, wc = wid & 3, fr = lane & 15, fq = lane >> 4;
    const int nt = F8 ? K / (2 * BK) : K / BK;
    unsigned voffA[2][2], voffB[2];
#pragma unroll
    for (int i = 0; i < 2; ++i) { int R, C; stage_rc(tid * 16 + i * 8192, R, C); const int Rb = Epi::PERM ? ((R & ~31) + perm32(R & 31)) : R;
        const unsigned pb = F8 ? (unsigned)K : 2u * (unsigned)K;
        voffA[0][i] = (unsigned)R * pb + (unsigned)C * 2u; voffA[1][i] = voffA[0][i]; voffB[i] = (unsigned)Rb * pb + (unsigned)C * 2u; }
#define PG8_GLOAD(UI) do { _Pragma("unroll") for (int _i = 0; _i < 2; ++_i) { int R_, C_; stage_rc(tid * 16 + _i * 8192, R_, C_); \
        voffA[0][_i] = gtab[(UI) * 256 + R_] + (unsigned)C_ * 2u; voffA[1][_i] = gtab[(UI) * 256 + HALF + R_] + (unsigned)C_ * 2u; } } while (0)
    const size_t kstep = (size_t)(BK * 2);
    const size_t hstep = (size_t)HALF * K * (F8 ? 1 : 2);
    const size_t hstA = GATHER ? (size_t)0 : hstep;
    const size_t tstep = 2 * hstep;
    const unsigned ldsw = (unsigned)wid * 1024u;
    const int aoff = lds_byte(wr * 64 + fr, fq * 8), boff = lds_byte(wc * 32 + fr, fq * 8);
#define PG8_SA(b, h) (((b) * 2 + (h)) * HTB)
#define PG8_SB(b, h) ((4 + (b) * 2 + (h)) * HTB)
#define PG8_STAGE(bufoff, gbase, voff) do { _Pragma("unroll") for (int _i = 0; _i < 2; ++_i) \
        __builtin_amdgcn_global_load_lds((const unsigned*)((const char*)(gbase) + (voff)[_i]), (PG8_LAS unsigned*)(lds + (bufoff) + ldsw + _i * 8192), 16, 0, 0); } while (0)
#define PG8_LDA(dst, b, h) do { _Pragma("unroll") for (int m = 0; m < 4; ++m) dst[m] = cat8(*(const PG8_LAS bf16x8*)(lds + PG8_SA(b, h) + aoff + m * 2048), *(const PG8_LAS bf16x8*)(lds + PG8_SA(b, h) + aoff + m * 2048 + 1024)); } while (0)
#define PG8_LDB(dst, b, h) do { _Pragma("unroll") for (int n = 0; n < 2; ++n) dst[n] = cat8(*(const PG8_LAS bf16x8*)(lds + PG8_SB(b, h) + boff + n * 2048), *(const PG8_LAS bf16x8*)(lds + PG8_SB(b, h) + boff + n * 2048 + 1024)); } while (0)
#define PG8_LO(v) __builtin_bit_cast(bf16x8, __builtin_shufflevector(v, v, 0, 1, 2, 3))
#define PG8_HI(v) __builtin_bit_cast(bf16x8, __builtin_shufflevector(v, v, 4, 5, 6, 7))
#define PG8_MMA(ai, bj, At, Bt) do { __builtin_amdgcn_s_setprio(1); _Pragma("unroll") for (int m = 0; m < 4; ++m) _Pragma("unroll") for (int n = 0; n < 2; ++n) { \
        if constexpr (F8) { acc[ai][bj][m][n] = __builtin_amdgcn_mfma_scale_f32_16x16x128_f8f6f4(Bt[n], At[m], acc[ai][bj][m][n], 0, 0, 0, 0x7F7F7F7F, 0, 0x7F7F7F7F); } \
        else { acc[ai][bj][m][n] = __builtin_amdgcn_mfma_f32_16x16x32_bf16(PG8_LO(Bt[n]), PG8_LO(At[m]), acc[ai][bj][m][n], 0, 0, 0); \
               acc[ai][bj][m][n] = __builtin_amdgcn_mfma_f32_16x16x32_bf16(PG8_HI(Bt[n]), PG8_HI(At[m]), acc[ai][bj][m][n], 0, 0, 0); } } __builtin_amdgcn_s_setprio(0); } while (0)
#define PG8_WAIT_V(n) asm volatile("s_waitcnt vmcnt(" #n ")" ::: "memory")
#define PG8_WAIT_L(n) asm volatile("s_waitcnt lgkmcnt(" #n ")" ::: "memory")
#define PG8_BAR __builtin_amdgcn_s_barrier()
#define PG8_SCHED __builtin_amdgcn_sched_barrier(0)
    Unit cur, nxt; int ui = 0;
    if (!S.next(0, cur)) return;
    f32x4 acc[2][2][4][2];
#pragma unroll
    for (int a = 0; a < 2; ++a)
#pragma unroll
        for (int b = 0; b < 2; ++b)
#pragma unroll
            for (int m = 0; m < 4; ++m)
#pragma unroll
                for (int n = 0; n < 2; ++n) acc[a][b][m][n] = (f32x4){0.f, 0.f, 0.f, 0.f};
    i32x8 At[4], B0[2], B1[2];
    const char* cA = S.a_ptr(cur); const char* cB = S.b_ptr(cur);
    if constexpr (GATHER) PG8_GLOAD(0);
    S.a_ready(cur);
    if constexpr (SP2) {
        PG8_STAGE(PG8_SB(0, 0), cB, voffB); PG8_STAGE(PG8_SB(0, 1), cB + hstep, voffB); PG8_STAGE(PG8_SA(0, 0), cA, voffA[0]); PG8_STAGE(PG8_SA(0, 1), cA + hstA, voffA[1]);
        if (wr == 1) PG8_BAR;
        PG8_WAIT_V(2); PG8_BAR;
        PG8_STAGE(PG8_SB(1, 0), cB + kstep, voffB); PG8_STAGE(PG8_SA(1, 0), cA + kstep, voffA[0]); PG8_STAGE(PG8_SB(1, 1), cB + hstep + kstep, voffB);
        PG8_WAIT_V(6); PG8_BAR;
    } else {
        PG8_STAGE(PG8_SB(0, 0), cB, voffB); PG8_STAGE(PG8_SA(0, 0), cA, voffA[0]); PG8_STAGE(PG8_SB(0, 1), cB + hstep, voffB); PG8_STAGE(PG8_SA(0, 1), cA + hstA, voffA[1]);
        if (wr == 1) PG8_BAR;
        PG8_WAIT_V(4); PG8_BAR;
        PG8_STAGE(PG8_SB(1, 0), cB + kstep, voffB); PG8_STAGE(PG8_SA(1, 0), cA + kstep, voffA[0]); PG8_STAGE(PG8_SB(1, 1), cB + hstep + kstep, voffB);
        PG8_WAIT_V(6); PG8_BAR;
    }
    for (;;) {
        const bool has_next = S.next(ui + 1, nxt);
        const char* nA = has_next ? S.a_ptr(nxt) : cA; const char* nB = has_next ? S.b_ptr(nxt) : cB;
#pragma unroll 1
        for (int t = 0; t < nt; t += 2) {
            const bool last = (t == nt - 2);
            const char* a1 = cA + (size_t)(t + 1) * kstep;
            const char* a2 = last ? nA : cA + (size_t)(t + 2) * kstep; const char* b2 = last ? nB : cB + (size_t)(t + 2) * kstep;
            const char* a3 = a2 + kstep; const char* b3 = b2 + kstep;
            if (last && has_next) S.a_ready(nxt);
            if constexpr (SP2) {
            PG8_LDB(B0, 0, 0); PG8_LDB(B1, 0, 1); PG8_SCHED; PG8_LDA(At, 0, 0); PG8_STAGE(PG8_SA(1, 1), a1 + hstA, voffA[1]); if constexpr (GATHER) { if (last && has_next) PG8_GLOAD(ui + 1); }
            PG8_WAIT_V(8); PG8_WAIT_L(0); PG8_BAR; PG8_MMA(0, 0, At, B0); PG8_MMA(0, 1, At, B1); PG8_BAR; PG8_SCHED;
            PG8_LDA(At, 0, 1); PG8_STAGE(PG8_SB(0, 0), b2, voffB); PG8_STAGE(PG8_SB(0, 1), b2 + hstep, voffB); PG8_STAGE(PG8_SA(0, 0), a2, voffA[0]);
            PG8_WAIT_V(8); PG8_WAIT_L(0); PG8_BAR; PG8_MMA(1, 0, At, B0); PG8_MMA(1, 1, At, B1); PG8_BAR; PG8_SCHED;
            PG8_LDB(B0, 1, 0); PG8_LDB(B1, 1, 1); PG8_SCHED; PG8_LDA(At, 1, 0); PG8_STAGE(PG8_SA(0, 1), a2 + hstA, voffA[1]);
            PG8_WAIT_V(8); PG8_WAIT_L(0); PG8_BAR; PG8_MMA(0, 0, At, B0); PG8_MMA(0, 1, At, B1); PG8_BAR; PG8_SCHED;
            PG8_LDA(At, 1, 1); PG8_STAGE(PG8_SB(1, 0), b3, voffB); PG8_STAGE(PG8_SB(1, 1), b3 + hstep, voffB); PG8_STAGE(PG8_SA(1, 0), a3, voffA[0]);
            PG8_WAIT_V(8); PG8_WAIT_L(0); PG8_BAR; PG8_MMA(1, 0, At, B0); PG8_MMA(1, 1, At, B1); PG8_BAR; PG8_SCHED;
            } else {
            PG8_LDB(B0, 0, 0); PG8_SCHED; PG8_LDA(At, 0, 0); PG8_STAGE(PG8_SA(1, 1), a1 + hstA, voffA[1]); if constexpr (GATHER) { if (last && has_next) PG8_GLOAD(ui + 1); }
            PG8_WAIT_L(8); PG8_BAR; PG8_WAIT_L(0); PG8_MMA(0, 0, At, B0); PG8_BAR; PG8_SCHED;
            PG8_LDB(B1, 0, 1); PG8_STAGE(PG8_SB(0, 0), b2, voffB);
            PG8_BAR; PG8_WAIT_L(0); PG8_MMA(0, 1, At, B1); PG8_BAR;
            PG8_LDA(At, 0, 1); PG8_STAGE(PG8_SA(0, 0), a2, voffA[0]);
            PG8_BAR; PG8_WAIT_L(0); PG8_MMA(1, 0, At, B0); PG8_BAR; PG8_SCHED;
            PG8_STAGE(PG8_SB(0, 1), b2 + hstep, voffB);
            PG8_WAIT_V(6); PG8_BAR; PG8_MMA(1, 1, At, B1); PG8_BAR;
            PG8_LDB(B0, 1, 0); PG8_SCHED; PG8_LDA(At, 1, 0); PG8_STAGE(PG8_SA(0, 1), a2 + hstA, voffA[1]);
            PG8_WAIT_L(8); PG8_BAR; PG8_WAIT_L(0); PG8_MMA(0, 0, At, B0); PG8_BAR; PG8_SCHED;
            PG8_LDB(B1, 1, 1); PG8_STAGE(PG8_SB(1, 0), b3, voffB);
            PG8_BAR; PG8_WAIT_L(0); PG8_MMA(0, 1, At, B1); PG8_BAR;
            PG8_LDA(At, 1, 1); PG8_STAGE(PG8_SA(1, 0), a3, voffA[0]);
            PG8_BAR; PG8_WAIT_L(0); PG8_MMA(1, 0, At, B0); PG8_BAR; PG8_SCHED;
            PG8_STAGE(PG8_SB(1, 1), b3 + hstep, voffB);
            PG8_WAIT_V(6); PG8_BAR; PG8_MMA(1, 1, At, B1); PG8_BAR;
            }
        }
        if constexpr (ALIGN_EPI) { if (wr == 0) PG8_BAR; }
        if constexpr (!Epi::AFTER_DRAIN) { E(acc, cur, wr, wc, fr, fq); S.done(cur); }
        if (!has_next) break;
#pragma unroll
        for (int a = 0; a < 2; ++a)
#pragma unroll
            for (int b = 0; b < 2; ++b)
#pragma unroll
                for (int m = 0; m < 4; ++m)
#pragma unroll
                    for (int n = 0; n < 2; ++n) acc[a][b][m][n] = (f32x4){0.f, 0.f, 0.f, 0.f};
        cur = nxt; cA = nA; cB = nB; ++ui;
        if constexpr (ALIGN_EPI) { if (wr == 1) PG8_BAR; }
    }
    PG8_WAIT_V(0);
    if constexpr (!ALIGN_EPI) { if (wr == 0) PG8_BAR; }
    PG8_BAR;
    if constexpr (Epi::AFTER_DRAIN) { E.fused(acc, cur, wr, wc, fr, fq, lds, wid, lane); S.done(cur); }
#undef PG8_SA
#undef PG8_SB
#undef PG8_STAGE
#undef PG8_LDA
#undef PG8_LDB
#undef PG8_LO
#undef PG8_HI
#undef PG8_MMA
#undef PG8_WAIT_V
#undef PG8_WAIT_L
#undef PG8_BAR
#undef PG8_SCHED
#undef PG8_GLOAD
}
}
#include <hip/hip_bf16.h>
#include <cmath>
namespace attn_body {
using bf16=__hip_bfloat16;
using bf16x8=__attribute__((ext_vector_type(8)))short;
using s16x4=__attribute__((ext_vector_type(4)))short;
using f32x16=__attribute__((ext_vector_type(16)))float;
using u32x4=__attribute__((ext_vector_type(4)))unsigned;
constexpr int BATCH=8,NHEAD=16,SEQ=2048,D=64,DMI=3072,DMO=1024;
constexpr int NW=8,QBLK=32,QB=QBLK*NW,KVBLK=64,NQB=SEQ/QB;
constexpr int ATTN_UNIT_ROWS=QB;
__device__ __forceinline__ int crow(int r,int hi){return (r&3)+8*(r>>2)+4*hi;}
#define SBAR() __builtin_amdgcn_sched_barrier(0)
__device__ __forceinline__ void cmask(f32x16&p0,f32x16&p1,int jb,int qrel,int hi){
  const float NEG=-INFINITY; int kb=64*jb+4*hi;
  #pragma unroll
  for(int r=0;r<16;++r){int kv=kb+(r&3)+8*(r>>2); if(kv>qrel)p0[r]=NEG; if(kv+32>qrel)p1[r]=NEG;}
}

constexpr int NSLOT=3, SLOTB=8192;
constexpr int LDS_K=0, LDS_V=NSLOT*SLOTB, LDS_WS=2*NSLOT*SLOTB, LDS_OST=LDS_WS+NW*64*4, LDS_BYTES=LDS_OST+NW*4096;
constexpr float C2=0.125f*1.4426950408889634f;
__device__ __forceinline__ void glds16(const void*gsrc,unsigned lds_dst){unsigned keep;
  asm volatile("s_mov_b32 %0, m0\n\ts_mov_b32 m0, %2\n\ts_nop 0\n\tglobal_load_lds_dwordx4 %1, off\n\ts_mov_b32 m0, %0":"=&s"(keep):"v"(gsrc),"s"(lds_dst):"memory");}
__device__ __forceinline__ float max3f(float a,float b,float c){float r;asm("v_max3_f32 %0, %1, %2, %3":"=v"(r):"v"(a),"v"(b),"v"(c));return r;}
__device__ __forceinline__ float max2f(float a,float b){float r;asm("v_max_f32_e32 %0, %1, %2":"=v"(r):"v"(a),"v"(b));return r;}
__device__ __forceinline__ float fadd_s(float a,float b){float r;asm("v_add_f32_e32 %0, %1, %2":"=v"(r):"v"(a),"v"(b));return r;}
__device__ __forceinline__ float fsub_s(float a,float b){float r;asm("v_sub_f32_e32 %0, %1, %2":"=v"(r):"v"(a),"v"(b));return r;}
typedef float f32x2_t __attribute__((ext_vector_type(2))); typedef __bf16 bf16x2_t __attribute__((ext_vector_type(2)));
__device__ __forceinline__ unsigned cvtpk_s(float lo,float hi){f32x2_t v={lo,hi};bf16x2_t b=__builtin_convertvector(v,bf16x2_t);return __builtin_bit_cast(unsigned,b);}
#define WAIT_BAR(N) asm volatile("s_waitcnt vmcnt(" #N ") lgkmcnt(0)\n\ts_barrier":::"memory")

__device__ __forceinline__ void qkt(f32x16&p0,f32x16&p1,const char*Kslot,const bf16x8*qr,const f32x16&negm,int r32,int hi){
  const char*kb=Kslot+hi*1024+r32*16;
  #pragma unroll
  for(int d0=0;d0<4;++d0){
    const bf16x8 b0=*reinterpret_cast<const bf16x8*>(kb+d0*2048);
    const bf16x8 b1=*reinterpret_cast<const bf16x8*>(kb+d0*2048+512);
    if(d0==0){p0=__builtin_amdgcn_mfma_f32_32x32x16_bf16(b0,qr[0],negm,0,0,0);p1=__builtin_amdgcn_mfma_f32_32x32x16_bf16(b1,qr[0],negm,0,0,0);}
    else{p0=__builtin_amdgcn_mfma_f32_32x32x16_bf16(b0,qr[d0],p0,0,0,0);p1=__builtin_amdgcn_mfma_f32_32x32x16_bf16(b1,qr[d0],p1,0,0,0);}}
}
typedef __attribute__((address_space(3))) const char* lds_cptr;
typedef short v4i16_t __attribute__((ext_vector_type(4)));
__device__ __forceinline__ void kload8(bf16x8*kf,lds_cptr kp){
  kf[0]=*(const __attribute__((address_space(3))) bf16x8*)(kp);      kf[1]=*(const __attribute__((address_space(3))) bf16x8*)(kp+512);
  kf[2]=*(const __attribute__((address_space(3))) bf16x8*)(kp+2048); kf[3]=*(const __attribute__((address_space(3))) bf16x8*)(kp+2560);
  kf[4]=*(const __attribute__((address_space(3))) bf16x8*)(kp+4096); kf[5]=*(const __attribute__((address_space(3))) bf16x8*)(kp+4608);
  kf[6]=*(const __attribute__((address_space(3))) bf16x8*)(kp+6144); kf[7]=*(const __attribute__((address_space(3))) bf16x8*)(kp+6656);
}
__device__ __forceinline__ void kload2(bf16x8*kf,lds_cptr kp,int j){ kf[2*j]=*(const __attribute__((address_space(3))) bf16x8*)(kp+j*2048); kf[2*j+1]=*(const __attribute__((address_space(3))) bf16x8*)(kp+j*2048+512); }
__device__ __forceinline__ s16x4 vtr(lds_cptr p){ return __builtin_bit_cast(s16x4,__builtin_amdgcn_ds_read_tr16_b64_v4i16((__attribute__((address_space(3))) v4i16_t*)p)); }
__device__ __forceinline__ float rowmax(const f32x16&p0,const f32x16&p1){
  float a=max3f(p0[0],p0[1],p1[0]),b=max3f(p0[2],p0[3],p1[1]);a=max3f(a,p1[2],p1[3]);
  #pragma unroll
  for(int r=4;r<16;r+=4){a=max3f(a,p0[r],p0[r+1]);b=max3f(b,p0[r+2],p0[r+3]);a=max3f(a,p1[r],p1[r+1]);b=max3f(b,p1[r+2],p1[r+3]);}
  const float m=max2f(a,b);
  auto rr=__builtin_amdgcn_permlane32_swap(__float_as_uint(m),__float_as_uint(m),false,false);
  return max2f(__uint_as_float(rr[0]),__uint_as_float(rr[1]));
}
__device__ __forceinline__ void pv(f32x16*o,int vb,bf16x8 pa0,bf16x8 pa1,bf16x8 pa2,bf16x8 pa3){
  #pragma unroll
  for(int d0=0;d0<2;++d0){s16x4 lo[4],hi[4];
    #pragma unroll
    for(int ks=0;ks<4;++ks){
      asm volatile("ds_read_b64_tr_b16 %0,%1 offset:%c2":"=&v"(lo[ks]):"v"(vb),"i"(d0*4096+ks*1024):"memory");
      asm volatile("ds_read_b64_tr_b16 %0,%1 offset:%c2":"=&v"(hi[ks]):"v"(vb),"i"(d0*4096+ks*1024+512):"memory");}
    asm volatile("s_waitcnt lgkmcnt(0)":::"memory");SBAR();
    #define PK(k) (bf16x8){lo[k][0],lo[k][1],lo[k][2],lo[k][3],hi[k][0],hi[k][1],hi[k][2],hi[k][3]}
    o[d0]=__builtin_amdgcn_mfma_f32_32x32x16_bf16(pa0,PK(0),o[d0],0,0,0);
    o[d0]=__builtin_amdgcn_mfma_f32_32x32x16_bf16(pa1,PK(1),o[d0],0,0,0);
    o[d0]=__builtin_amdgcn_mfma_f32_32x32x16_bf16(pa2,PK(2),o[d0],0,0,0);
    o[d0]=__builtin_amdgcn_mfma_f32_32x32x16_bf16(pa3,PK(3),o[d0],0,0,0);
    #undef PK
  }
}

#ifndef ATTN_STORE16
#define ATTN_STORE16(p,v) (*(u32x4*)(p)=(v))
#endif
template<int THRL> __device__ __forceinline__ void attn_unit(int b,int qb,const bf16*Q,const bf16*__restrict__ K,const bf16*__restrict__ V,bf16*O,char*shm){
  const int tid=threadIdx.x,lane=tid&63,r32=lane&31,hi=lane>>5; const int wid=__builtin_amdgcn_readfirstlane(tid>>6);
  const long rowbase=(long)b*SEQ; const int q0=qb*QB;
  const bf16*Qw=Q+(rowbase+q0+wid*QBLK)*DMI;
  const bf16*Kh=K+rowbase*DMI,*Vh=V+rowbase*DMI;
  const unsigned lds0=(unsigned)(uintptr_t)shm;
  float*wsf=(float*)(shm+LDS_WS)+wid*64;
  const bf16*ksrc=Kh+(long)lane*DMI+wid*8;
  const bf16*vsrc=Vh+(long)(16*(wid&3)+(lane>>2))*DMI+(wid>>2)*32+(lane&3)*8;
  const unsigned kdst=lds0+LDS_K+wid*1024, vdst=lds0+LDS_V+wid*1024;
  #define DMA_K(t,slot) glds16(ksrc+(long)(t)*KVBLK*DMI,(unsigned)__builtin_amdgcn_readfirstlane(kdst+(slot)))
  #define DMA_V(t,slot) glds16(vsrc+(long)(t)*KVBLK*DMI,(unsigned)__builtin_amdgcn_readfirstlane(vdst+(slot)))
  const int vb0=(int)(lds0+LDS_V)+((lane>>4)&1)*32+(lane&3)*8+(4*hi+((lane&15)>>2))*64;
  const char*Kbase=shm+LDS_K; bf16x8 kf[8];
  const lds_cptr shm3=(lds_cptr)shm; const lds_cptr kp0=shm3+LDS_K+hi*1024+r32*16; const lds_cptr vp0=shm3+LDS_V+((lane>>4)&1)*32+(lane&3)*8+(4*hi+((lane&15)>>2))*64;
  const int NT=(q0+QB)/KVBLK;
  DMA_K(0,0);DMA_V(0,0);DMA_K(1,SLOTB);
  bf16x8 qr[4];
  #pragma unroll
  for(int d0=0;d0<4;++d0)qr[d0]=*reinterpret_cast<const bf16x8*>(&Qw[(long)r32*DMI+d0*16+hi*8]);
  float mhat=0.f,l_reg=0.f;f32x16 o[2];o[0]=f32x16{};o[1]=f32x16{};f32x16 negm=f32x16{};asm volatile("":"+v"(negm));
  const int qrel=wid*QBLK+r32;
  #define CMASK(P0,P1,t) do{int jb_=(t)-(NT-4); if(jb_>=0)cmask(P0,P1,jb_,qrel,hi);}while(0)
  bool resc=false;
  #define START(P0,P1) do{ const float rm=rowmax(P0,P1); resc=false; \
    { const float dl=rm; mhat=fadd_s(mhat,dl); \
      _Pragma("unroll") for(int r=0;r<16;++r){P0[r]=fsub_s(P0[r],dl);P1[r]=fsub_s(P1[r],dl);} \
      _Pragma("unroll") for(int r=0;r<16;++r)negm[r]=-mhat; asm volatile("":"+v"(negm)); } \
    _Pragma("unroll") for(int r=0;r<16;++r)P0[r]=__builtin_amdgcn_exp2f(P0[r]); }while(0)
  #define RESC() do{ if(resc){ asm volatile("s_waitcnt lgkmcnt(0)":::"memory"); \
      _Pragma("unroll") for(int d_=0;d_<2;++d_) _Pragma("unroll") for(int r=0;r<16;++r)o[d_][r]*=wsf[crow(r,hi)]; } }while(0)
  f32x16 pA0,pA1,pB0,pB1;
  int sl_prev=0,sl_cur=0,sl_next=SLOTB;
  #define ROT() do{sl_prev=sl_cur;sl_cur=sl_next;sl_next=(sl_next==(NSLOT-1)*SLOTB)?0:sl_next+SLOTB;}while(0)
  DMA_K(2,2*SLOTB);
  WAIT_BAR(3);
  qkt(pA0,pA1,Kbase,qr,negm,r32,hi);asm volatile("s_nop 15\n\ts_nop 7":"+v"(pA0),"+v"(pA1));CMASK(pA0,pA1,0);
  START(pA0,pA1);
  _Pragma("unroll") for(int r=0;r<16;++r)pA1[r]=__builtin_amdgcn_exp2f(pA1[r]);
  WAIT_BAR(0);
  DMA_K(3,0);DMA_V(1,SLOTB);
  ROT();
  kload8(kf,kp0+sl_cur);
  WAIT_BAR(2);
  s16x4 vlo[8],vhi[8]; u32x4 pw0,pw1,pw2,pw3;
  #define PKW(P,B) cvtpk_s(P[B],P[B+1])
  #define PAF(k) __builtin_bit_cast(bf16x8,pw##k)
  #define VFR(i) (bf16x8){vlo[i][0],vlo[i][1],vlo[i][2],vlo[i][3],vhi[i][0],vhi[i][1],vhi[i][2],vhi[i][3]}
  #define PIN(x) asm volatile("":"+v"(x))
  #define MX3(a,b,c) __builtin_fmaxf(__builtin_fmaxf((a),(b)),(c))
  #define GAPA(MF,A0,A1,A2,A3,W0,W1,PW) do{ MF; sacc+=A0; sacc+=A1; sacc+=A2; sacc+=A3; PIN(sacc); W0; W1; PIN(PW); SBAR(); }while(0)
  #define EX(v) __builtin_amdgcn_exp2f(v)
  #define GAPB(MF,X,B) do{ MF; X[B]=EX(X[B]); X[B+1]=EX(X[B+1]); X[B+2]=EX(X[B+2]); X[B+3]=EX(X[B+3]); PIN(X); SBAR(); }while(0)
  #define VRD(i) do{ vlo[i]=vtr(vp_+(((i)>>2)*4096+((i)&3)*1024)); vhi[i]=vtr(vp_+(((i)>>2)*4096+((i)&3)*1024+512)); }while(0)
  #define KRD(G,j) do{ if(G){ kload2(kf,kp0+sl_next,j); SBAR(); } }while(0)
  #define STEP(C0,C1,P0,P1,t,GK,GV,GL) do{ SBAR(); \
    const lds_cptr vp_=vp0+sl_prev; \
    VRD(0); SBAR(); float sacc=(P0[0]+P0[1]); \
    GAPA(C0=__builtin_amdgcn_mfma_f32_32x32x16_bf16(kf[0],qr[0],negm,0,0,0), P0[2],P0[3],P0[4],P0[5],     pw0[0]=PKW(P0,0), pw0[1]=PKW(P0,2), pw0); \
    VRD(4); SBAR(); GAPA(C1=__builtin_amdgcn_mfma_f32_32x32x16_bf16(kf[1],qr[0],negm,0,0,0), P0[6],P0[7],P0[8],P0[9],     pw0[2]=PKW(P0,4), pw0[3]=PKW(P0,6), pw0); \
    VRD(1); SBAR(); GAPA(C0=__builtin_amdgcn_mfma_f32_32x32x16_bf16(kf[2],qr[1],C0,0,0,0),   P0[10],P0[11],P0[12],P0[13], pw1[0]=PKW(P0,8), pw1[1]=PKW(P0,10), pw1); \
    VRD(5); SBAR(); GAPA(C1=__builtin_amdgcn_mfma_f32_32x32x16_bf16(kf[3],qr[1],C1,0,0,0),   P0[14],P0[15],P1[0],P1[1],   pw1[2]=PKW(P0,12),pw1[3]=PKW(P0,14), pw1); \
    VRD(2); SBAR(); GAPA(C0=__builtin_amdgcn_mfma_f32_32x32x16_bf16(kf[4],qr[2],C0,0,0,0),   P1[2],P1[3],P1[4],P1[5],     pw2[0]=PKW(P1,0), pw2[1]=PKW(P1,2), pw2); \
    VRD(6); SBAR(); GAPA(C1=__builtin_amdgcn_mfma_f32_32x32x16_bf16(kf[5],qr[2],C1,0,0,0),   P1[6],P1[7],P1[8],P1[9],     pw2[2]=PKW(P1,4), pw2[3]=PKW(P1,6), pw2); \
    VRD(3); SBAR(); GAPA(C0=__builtin_amdgcn_mfma_f32_32x32x16_bf16(kf[6],qr[3],C0,0,0,0),   P1[10],P1[11],P1[12],P1[13], pw3[0]=PKW(P1,8), pw3[1]=PKW(P1,10), pw3); \
    VRD(7); SBAR(); GAPA(C1=__builtin_amdgcn_mfma_f32_32x32x16_bf16(kf[7],qr[3],C1,0,0,0),   P1[14],P1[15],0.f,0.f,       pw3[2]=PKW(P1,12),pw3[3]=PKW(P1,14), pw3); \
    l_reg+=sacc; \
    if(GK){DMA_K((t)+3,sl_cur);} if(GV){DMA_V((t)+1,sl_next);} \
    CMASK(C0,C1,t); \
    { float a=MX3(C0[0],C0[1],C1[0]),b=MX3(C0[2],C0[3],C1[1]); a=MX3(a,C1[2],C1[3]); \
      _Pragma("unroll") for(int r=4;r<16;r+=4){a=MX3(a,C0[r],C0[r+1]);b=MX3(b,C0[r+2],C0[r+3]);a=MX3(a,C1[r],C1[r+1]);b=MX3(b,C1[r+2],C1[r+3]);} \
      float rm=__builtin_fmaxf(a,b); { auto rr=__builtin_amdgcn_permlane32_swap(__float_as_uint(rm),__float_as_uint(rm),false,false); rm=__builtin_fmaxf(__uint_as_float(rr[0]),__uint_as_float(rr[1])); } \
      resc=false; \
      if(__builtin_expect(__any(rm>(float)THRL),0)){ const float dl=__builtin_fmaxf(rm,0.f); mhat+=dl; \
        _Pragma("unroll") for(int r=0;r<16;++r){C0[r]-=dl;C1[r]-=dl;} \
        _Pragma("unroll") for(int r=0;r<16;++r)negm[r]=-mhat; asm volatile("":"+v"(negm)); \
        const float f=__builtin_amdgcn_exp2f(-dl); l_reg*=f; if(hi==0)wsf[r32]=f; resc=true; } } \
    SBAR(); \
    GAPB(o[0]=__builtin_amdgcn_mfma_f32_32x32x16_bf16(PAF(0),VFR(0),o[0],0,0,0), C0,0); \
    GAPB(o[1]=__builtin_amdgcn_mfma_f32_32x32x16_bf16(PAF(0),VFR(4),o[1],0,0,0), C0,4); \
    KRD(GL,0); GAPB(o[0]=__builtin_amdgcn_mfma_f32_32x32x16_bf16(PAF(1),VFR(1),o[0],0,0,0), C0,8); \
    KRD(GL,1); GAPB(o[1]=__builtin_amdgcn_mfma_f32_32x32x16_bf16(PAF(1),VFR(5),o[1],0,0,0), C0,12); \
    KRD(GL,2); GAPB(o[0]=__builtin_amdgcn_mfma_f32_32x32x16_bf16(PAF(2),VFR(2),o[0],0,0,0), C1,0); \
    KRD(GL,3); GAPB(o[1]=__builtin_amdgcn_mfma_f32_32x32x16_bf16(PAF(2),VFR(6),o[1],0,0,0), C1,4); \
    GAPB(o[0]=__builtin_amdgcn_mfma_f32_32x32x16_bf16(PAF(3),VFR(3),o[0],0,0,0), C1,8); \
    GAPB(o[1]=__builtin_amdgcn_mfma_f32_32x32x16_bf16(PAF(3),VFR(7),o[1],0,0,0), C1,12); \
    }while(0)
  int t=1;
  #undef CMASK
  #define CMASK(P0,P1,t) do{}while(0)
  for(;t+5<NT;t+=2){
    STEP(pB0,pB1,pA0,pA1,t,true,true,true);     WAIT_BAR(2); RESC(); ROT();
    STEP(pA0,pA1,pB0,pB1,t+1,true,true,true);   WAIT_BAR(2); RESC(); ROT();
  }
  #undef CMASK
  #define CMASK(P0,P1,t) do{int jb_=(t)-(NT-4); if(jb_>=0)cmask(P0,P1,jb_,qrel,hi);}while(0)
  #define ENDW(tt) do{ if((tt)+3<NT){WAIT_BAR(2);} else if((tt)+2<NT){WAIT_BAR(1);} else {WAIT_BAR(0);} }while(0)
  for(;t+1<NT;t+=2){
    STEP(pB0,pB1,pA0,pA1,t,(t+3<NT),(t+1<NT),(t+1<NT));       ENDW(t);   RESC(); ROT();
    STEP(pA0,pA1,pB0,pB1,t+1,(t+4<NT),(t+2<NT),(t+2<NT));     ENDW(t+1); RESC(); ROT();
  }
  STEP(pB0,pB1,pA0,pA1,NT-1,false,false,false); RESC();
  { float sacc=pB0[0]+pB0[1]; _Pragma("unroll") for(int r=2;r<16;++r)sacc+=pB0[r]; _Pragma("unroll") for(int r=0;r<16;++r)sacc+=pB1[r]; l_reg+=sacc;
    pw0=(u32x4){PKW(pB0,0),PKW(pB0,2),PKW(pB0,4),PKW(pB0,6)};pw1=(u32x4){PKW(pB0,8),PKW(pB0,10),PKW(pB0,12),PKW(pB0,14)};pw2=(u32x4){PKW(pB1,0),PKW(pB1,2),PKW(pB1,4),PKW(pB1,6)};pw3=(u32x4){PKW(pB1,8),PKW(pB1,10),PKW(pB1,12),PKW(pB1,14)};
    SBAR(); pv(o,vb0+sl_cur,PAF(0),PAF(1),PAF(2),PAF(3)); }
  #undef PKW
  #undef PAF
  #undef VFR
  #undef PIN
  #undef MX3
  #undef GAPA
  #undef GAPB
  #undef EX
  #undef VRD
  #undef KRD
  #undef STEP
  #undef ENDW
  {auto rr=__builtin_amdgcn_permlane32_swap(__float_as_uint(l_reg),__float_as_uint(l_reg),false,false);l_reg=__uint_as_float(rr[0])+__uint_as_float(rr[1]);}
  if(hi==0)wsf[32+r32]=l_reg;asm volatile("s_waitcnt lgkmcnt(0)":::"memory");
  float rli[16];
  #pragma unroll
  for(int r=0;r<16;++r)rli[r]=__builtin_amdgcn_rcpf(wsf[32+crow(r,hi)]);
  bf16*Ow=O+(rowbase+q0+wid*QBLK)*DMO;
  { bf16*stg=(bf16*)(shm+LDS_OST)+wid*2048;
    #pragma unroll
    for(int r=0;r<16;++r){const int orow=crow(r,hi);
      #pragma unroll
      for(int d0=0;d0<2;++d0)stg[orow*64+d0*32+r32]=__float2bfloat16(o[d0][r]*rli[r]);}
    asm volatile("s_waitcnt lgkmcnt(0)":::"memory");
    #pragma unroll
    for(int i=0;i<4;++i){const int row=i*8+(lane>>3),ch=lane&7; const u32x4 v=*(const u32x4*)(stg+row*64+ch*8); ATTN_STORE16(Ow+(long)row*DMO+ch*8,v);} }
  asm volatile("s_waitcnt lgkmcnt(0)\n\ts_barrier":::"memory");
  #undef DMA_K
  #undef DMA_V
  #undef CMASK
  #undef START
  #undef RESC
  #undef ROT
}
constexpr int ATTN_LDS_BYTES=LDS_BYTES;
struct AttnTensors { const bf16* PJ; bf16* O; };
struct AttnUnit { int bh; int qb; };
constexpr int QCOL=1536, KCOL=2048, VCOL=2560;
struct StaticOrder {
  int vcu;
  __device__ __forceinline__ explicit StaticOrder(int v):vcu(v){}
  __device__ __forceinline__ bool next(int i,AttnUnit&u)const{ if(i>=4||vcu>=256)return false; const int s=2*(vcu&1)+(i>>1); u.bh=vcu>>1; u.qb=(i&1)?7-s:s; return true; }
  __device__ __forceinline__ void a_ready(const AttnUnit&)const{}
  __device__ __forceinline__ void done(const AttnUnit&)const{}
};
template<class Sched,int THRL=8> __device__ __forceinline__ void attn_phase(char*lds,const AttnTensors&T,const Sched&S){
  AttnUnit u;
  for(int i=0;S.next(i,u);++i){ S.a_ready(u);
    const int b=u.bh>>4, vh=u.bh&15, hd=vh>>2, j=(vh>>1)&1, half=vh&1;
    attn_unit<THRL>(b,u.qb,T.PJ+QCOL+hd*128+j*64,T.PJ+KCOL+hd*128+j*64,T.PJ+VCOL+hd*128+half*64,T.O+vh*64,lds); S.done(u); }
}
#undef SBAR
#undef WAIT_BAR
}
#define GAS __attribute__((address_space(1)))
#define LAS __attribute__((address_space(3)))
typedef unsigned short bf16;
typedef unsigned v4u __attribute__((ext_vector_type(4)));
typedef float f32x4 __attribute__((ext_vector_type(4)));
typedef short bf16x8 __attribute__((ext_vector_type(8)));
typedef GAS unsigned gu32;
typedef GAS unsigned long long gu64;
#define RLX_AGENT __ATOMIC_RELAXED, __HIP_MEMORY_SCOPE_AGENT
#define LDS_WAIT() asm volatile("s_waitcnt lgkmcnt(0)" ::: "memory")
#define VM_WAIT() asm volatile("s_waitcnt vmcnt(0)" ::: "memory")
__device__ __forceinline__ unsigned long long rt() { return __builtin_amdgcn_s_memrealtime(); }
__device__ __forceinline__ unsigned f2bf(float f) { unsigned u = __builtin_bit_cast(unsigned, f); return (u + 0x7fffu + ((u >> 16) & 1u)) >> 16; }
__device__ __forceinline__ unsigned pk2(float lo, float hi) { return f2bf(lo) | (f2bf(hi) << 16); }

#define XB_TMO      128
#define XB_XCNT(j)  (256  + 64 * (j))
#define XB_XSUB(j)  (1280 + 64 * (j))
#define XB_XGEN(j)  (2304 + 64 * (j))
#define XB_TOP      3328
#define XB_TOPGEN   3392
#define XCD_BAR_WORDS 3456
#define XB_SPIN_CAP (1u << 18)

__device__ __forceinline__ unsigned xb_ld(unsigned* p)              { return __hip_atomic_load(p, __ATOMIC_RELAXED, __HIP_MEMORY_SCOPE_AGENT); }
__device__ __forceinline__ unsigned xb_add(unsigned* p, unsigned v) { return __hip_atomic_fetch_add(p, v, __ATOMIC_RELAXED, __HIP_MEMORY_SCOPE_AGENT); }
__device__ __forceinline__ unsigned xb_xcc_id() { return (unsigned)__builtin_amdgcn_s_getreg((3 << 11) | 20) & 0xFu; }
#define XB_SPIN(cond, bar) do { unsigned _sp = 0; while (cond) { __builtin_amdgcn_s_sleep(1); \
    if ((++_sp & 255u) == 0u) { if (xb_ld(&(bar)[XB_TMO])) break; if (_sp > XB_SPIN_CAP) { atomicAdd(&(bar)[XB_TMO], 1u); break; } } } } while (0)

struct XcdBarrier {
    unsigned* bar; unsigned x;
    volatile LAS unsigned* st;
};

__device__ __forceinline__ XcdBarrier xcd_barrier_post(unsigned* bar, volatile LAS unsigned* st) {
    XcdBarrier b; b.bar = bar; b.x = xb_xcc_id(); b.st = st;
    if (threadIdx.x == 0) (void)xb_add(&bar[XB_XCNT(b.x)], 1u);
    return b;
}
__device__ __forceinline__ void xcd_barrier_complete(unsigned* bar, unsigned x, unsigned& nloc, unsigned& nx) {
    const unsigned G = gridDim.x * gridDim.y * gridDim.z;
    unsigned sum, cnt, mine, sp = 0u;
    for (;;) {
        sum = 0u; cnt = 0u; mine = 0u;
#pragma unroll
        for (unsigned j = 0; j < 16; ++j) { const unsigned c = xb_ld(&bar[XB_XCNT(j)]); sum += c; cnt += (c > 0u) ? 1u : 0u; mine = (j == x) ? c : mine; }
        if (sum == G) break;
        __builtin_amdgcn_s_sleep(1);
        if ((++sp & 255u) == 0u) { if (xb_ld(&bar[XB_TMO])) break; if (sp > XB_SPIN_CAP) { atomicAdd(&bar[XB_TMO], 1u); break; } }
    }
    nloc = mine > 0u ? mine : 1u; nx = cnt > 0u ? cnt : 1u;
}

__device__ __forceinline__ void xcd_barrier(const XcdBarrier& b) {
    asm volatile("s_waitcnt vmcnt(0)" ::: "memory");
    __syncthreads();
    if (threadIdx.x == 0) {
        unsigned* bar = b.bar;
        __builtin_amdgcn_s_waitcnt(0);
        unsigned nloc = b.st[0], nx = b.st[1];
        if (nloc == 0u) { xcd_barrier_complete(bar, b.x, nloc, nx); b.st[0] = nloc; b.st[1] = nx; }
        const unsigned old = xb_add(&bar[XB_XSUB(b.x)], 1u);
        const unsigned gen = old / nloc;
        if (old + 1u == (gen + 1u) * nloc) {
            __builtin_amdgcn_fence(__ATOMIC_RELEASE, "agent");
            asm volatile("s_waitcnt vmcnt(0)" ::: "memory");
            const unsigned og = xb_add(&bar[XB_TOP], 1u);
            const unsigned tg = og / nx;
            if (og + 1u == (tg + 1u) * nx) xb_add(&bar[XB_TOPGEN], 1u);
            else XB_SPIN(xb_ld(&bar[XB_TOPGEN]) == tg, bar);
            __builtin_amdgcn_fence(__ATOMIC_ACQUIRE, "agent");
            xb_add(&bar[XB_XGEN(b.x)], 1u);
            asm volatile("s_waitcnt vmcnt(0)" ::: "memory");
        } else {
            XB_SPIN(xb_ld(&bar[XB_XGEN(b.x)]) == gen, bar);
            __builtin_amdgcn_fence(__ATOMIC_ACQUIRE, "agent");
            asm volatile("s_waitcnt vmcnt(0)" ::: "memory");
        }
    }
    __syncthreads();
}
constexpr int NWAVES = 8;
constexpr int Bsz = 8, SEQ = 2048, D = 1024, T = Bsz * SEQ;
constexpr int INP = 3080, NPJ = 3072, OFF_DT = 1536, OFF_Q2 = 1544;
constexpr int NE = 32, CAP = T, PLE = 256, FF2 = 2048;
constexpr int PADROWS = 4 * T + NE * 256;
constexpr float LAM_INIT = 0.2f, EPS = 1e-6f;
constexpr size_t MiB = 1u << 20;
constexpr size_t WS_CTL = 0, CTL_ZERO_BYTES = 1 * MiB;
constexpr size_t WS_ROWTOK = 1 * MiB, WS_ROWGATE = 3 * MiB, WS_SLOT = 5 * MiB, WS_DT = 6 * MiB, WS_WR = 7 * MiB;
constexpr size_t WS_WIN = 8 * MiB, WS_WOUT = 14 * MiB, WS_WG = 16 * MiB, WS_WP = 18 * MiB, WS_WUP = 20 * MiB, WS_WDN = 148 * MiB;
constexpr size_t WS_H = 212 * MiB, WS_PJ = 244 * MiB, WS_O = 340 * MiB, WS_YC = 372 * MiB, WS_X1 = 404 * MiB, WS_X2 = 468 * MiB, WS_PP = 532 * MiB, WS_P16 = 564 * MiB;
constexpr size_t WS_ACT = 572 * MiB, WS_YS = 716 * MiB, WS_TMP = 860 * MiB, WS_H8 = 960 * MiB, WS_END = 976 * MiB;
static_assert(WS_ACT + (size_t)PADROWS * 1024 * 2 <= WS_YS && WS_YS + (size_t)PADROWS * 1024 * 2 <= WS_TMP, "d_ws map");
constexpr int CW_TMO = 0, CW_CODE = 1, CW_CNT = 64  , CW_BAR = 4096;
constexpr int RING_OFF = 0, RING_BYTES = 131072, LDSCTL_OFF = RING_BYTES, MISC_OFF = LDSCTL_OFF + 320, MTS_OFF = LDSCTL_OFF + 512, GTAB_OFF = LDSCTL_OFF + 1024, GTAB_UNITS = 10;
constexpr int LDS_BYTES = 147456;
static_assert(GTAB_OFF + GTAB_UNITS * 1024 <= LDS_BYTES, "LDS map");
__device__ __forceinline__ float wave_sum(float v) {
#pragma unroll
    for (int o = 1; o < 64; o <<= 1) v += __shfl_xor(v, o);
    return v;
}
__device__ __forceinline__ float bf2f(bf16 u) { return __uint_as_float((unsigned)u << 16); }
typedef unsigned u32x2 __attribute__((ext_vector_type(2)));

struct Args {
    const float *x, *p, *g_mix, *w_in, *conv_w, *conv_b, *dt_bias, *a_log, *d_skip, *ssd_norm_w, *lq1, *lk1, *lq2, *lk2, *subln_w, *w_out, *g_ffn, *w_router, *b_router,
                *w_up, *b_up, *w_down, *b_down, *g_ple, *w_ple_gate, *w_ple_proj, *g_final;
    float* out; unsigned char* ws; int ph_lo, ph_hi, bar_li, dry;
};

__device__ __forceinline__ void tr_item(const float* W, int ldw, int K, bf16* WT, int n0, int k0, int nrow0, LAS unsigned* scr, int lane) {
    const int n4 = (lane & 15) * 4, kr = lane >> 4;
    const float* src = W + (size_t)(k0 + kr * 2) * ldw + n0 + n4;
#pragma unroll
    for (int it = 0; it < 8; ++it) {
        const f32x4 a = *(const GAS f32x4*)(src + (size_t)(it * 8) * ldw);
        const f32x4 b = *(const GAS f32x4*)(src + (size_t)(it * 8 + 1) * ldw);
        const int kp = it * 4 + kr;
        scr[(n4 + 0) * 33 + kp] = pk2(a.x, b.x); scr[(n4 + 1) * 33 + kp] = pk2(a.y, b.y); scr[(n4 + 2) * 33 + kp] = pk2(a.z, b.z); scr[(n4 + 3) * 33 + kp] = pk2(a.w, b.w);
    }
    LDS_WAIT(); asm volatile("" ::: "memory");
    const int c = lane & 7;
#pragma unroll
    for (int it = 0; it < 8; ++it) { const int n = (lane >> 3) + 8 * it; const LAS unsigned* s = scr + n * 33 + c * 4;
        v4u o; o.x = s[0]; o.y = s[1]; o.z = s[2]; o.w = s[3];
        *(GAS v4u*)(WT + (size_t)(nrow0 + n) * K + k0 + 8 * c) = o; }
    LDS_WAIT(); asm volatile("" ::: "memory");
}
__device__ __forceinline__ void tr_item8(const float* W, int ldw, int K, unsigned char* WT, int n0, int k0, int nrow0, float scale, LAS unsigned* scr, int lane) {
    const int n4 = (lane & 15) * 4, kq = lane >> 4;
    const float* src = W + (size_t)(k0 + kq * 4) * ldw + n0 + n4;
#pragma unroll
    for (int it = 0; it < 4; ++it) {
        const f32x4 r0 = __builtin_nontemporal_load((const GAS f32x4*)(src + (size_t)(it * 16) * ldw)) * scale, r1 = __builtin_nontemporal_load((const GAS f32x4*)(src + (size_t)(it * 16 + 1) * ldw)) * scale;
        const f32x4 r2 = __builtin_nontemporal_load((const GAS f32x4*)(src + (size_t)(it * 16 + 2) * ldw)) * scale, r3 = __builtin_nontemporal_load((const GAS f32x4*)(src + (size_t)(it * 16 + 3) * ldw)) * scale;
        const int kp = it * 4 + kq;
        scr[(n4 + 0) * 17 + kp] = pg8::pk4_fp8(r0.x, r1.x, r2.x, r3.x); scr[(n4 + 1) * 17 + kp] = pg8::pk4_fp8(r0.y, r1.y, r2.y, r3.y);
        scr[(n4 + 2) * 17 + kp] = pg8::pk4_fp8(r0.z, r1.z, r2.z, r3.z); scr[(n4 + 3) * 17 + kp] = pg8::pk4_fp8(r0.w, r1.w, r2.w, r3.w);
    }
    LDS_WAIT(); asm volatile("" ::: "memory");
    const int c = lane & 3;
#pragma unroll
    for (int it = 0; it < 4; ++it) { const int n = (lane >> 2) + 16 * it; const LAS unsigned* s = scr + n * 17 + c * 4;
        v4u o; o.x = s[0]; o.y = s[1]; o.z = s[2]; o.w = s[3];
        *(GAS v4u*)(WT + (size_t)(nrow0 + n) * K + k0 + 16 * c) = o; }
    LDS_WAIT(); asm volatile("" ::: "memory");
}
__device__ __forceinline__ void p0_prologue(const Args& a, LAS unsigned char* lds, int vcu, int G, int wave, int lane, int tid) {
    unsigned char* ws = a.ws;
    bf16* Win_t = (bf16*)(ws + WS_WIN); bf16* Wout_t = (bf16*)(ws + WS_WOUT); bf16* Wg_t = (bf16*)(ws + WS_WG); bf16* Wp_t = (bf16*)(ws + WS_WP); unsigned char* Wup8 = ws + WS_WUP; unsigned char* Wdn8 = ws + WS_WDN;
    LAS unsigned* scr = (LAS unsigned*)(lds + RING_OFF + wave * 8704);
    const int gw = vcu * NWAVES + wave, NGW = G * NWAVES;
    constexpr int I_IN = 16 * 24, I_SQ = 16 * 16, I_PP = 4 * 16, I_UP = 32 * 16 * 32, I_DN = 32 * 16 * 16;
    constexpr int NITEMS = 2 * I_IN + 2 * I_SQ + I_PP + I_UP + I_DN;
    for (int it = (a.dry & 8) ? NITEMS : gw; it < NITEMS; it += NGW) {
        int r = it;
        if (r < I_UP) { const int e = r >> 9, q = r & 511; tr_item8(a.w_up + (size_t)e * D * FF2, FF2, D, Wup8 + (size_t)e * FF2 * D, (q & 31) * 64, (q >> 5) * 64, (q & 31) * 64, pg8::W8_SCALE, scr, lane); continue; } r -= I_UP;
        if (r < I_DN) { const int e = r >> 8, q = r & 255; tr_item8(a.w_down + (size_t)e * D * D, D, D, Wdn8 + (size_t)e * D * D, (q & 15) * 64, (q >> 4) * 64, (q & 15) * 64, pg8::W8_SCALE, scr, lane); continue; } r -= I_DN;
        if (r < I_IN) { tr_item(a.w_in, INP, D, Win_t, (r % 24) * 64, (r / 24) * 64, (r % 24) * 64, scr, lane); continue; } r -= I_IN;
        if (r < I_IN) { tr_item(a.w_in + OFF_Q2, INP, D, Win_t, (r % 24) * 64, (r / 24) * 64, 1536 + (r % 24) * 64, scr, lane); continue; } r -= I_IN;
        if (r < I_SQ) { tr_item(a.w_out, D, D, Wout_t, (r & 15) * 64, (r >> 4) * 64, (r & 15) * 64, scr, lane); continue; } r -= I_SQ;
        if (r < I_SQ) { tr_item(a.w_ple_gate, D, D, Wg_t, (r & 15) * 64, (r >> 4) * 64, (r & 15) * 64, scr, lane); continue; } r -= I_SQ;
        tr_item(a.w_ple_proj, D, PLE, Wp_t, (r & 15) * 64, (r >> 4) * 64, (r & 15) * 64, scr, lane);
    }
    { bf16* Wr_t = (bf16*)(ws + WS_WR); const int gt = vcu * (NWAVES * 64) + tid, NT_ = G * NWAVES * 64;
      for (int i = gt; i < NE * D; i += NT_) { const int n = i >> 10, k = i & 1023; Wr_t[i] = (bf16)f2bf(a.w_router[k * NE + n]); } }
    bf16* H = (bf16*)(ws + WS_H); float* DT = (float*)(ws + WS_DT);
    LAS float* wdt = (LAS float*)(lds + RING_OFF + 69632);
    __syncthreads();
    for (int i = tid; i < 2048; i += NWAVES * 64) { const int k = i >> 1, hf = i & 1; *(LAS f32x4*)(wdt + ((k & 3) * 256 + (k >> 2)) * 8 + hf * 4) = *(const GAS f32x4*)(a.w_in + (size_t)k * INP + OFF_DT + hf * 4); }
    __syncthreads();
    for (int m = (a.dry & 16) ? T : gw; m < T; m += NGW) {
        const GAS f32x4* xr = (const GAS f32x4*)(a.x + (size_t)m * D) + lane;
        f32x4 v[4]; float s = 0.f;
#pragma unroll
        for (int j = 0; j < 4; ++j) { v[j] = xr[64 * j]; s += (v[j].x * v[j].x + v[j].y * v[j].y) + (v[j].z * v[j].z + v[j].w * v[j].w); }
        const float rs = 1.f / sqrtf(wave_sum(s) * (1.f / D) + EPS);
        GAS u32x2* o8 = (GAS u32x2*)(H + (size_t)m * D) + lane;
        float d[8];
#pragma unroll
        for (int h = 0; h < 8; ++h) d[h] = 0.f;
#pragma unroll
        for (int j = 0; j < 4; ++j) { const f32x4 gg = ((const GAS f32x4*)a.g_mix)[lane + 64 * j]; v[j] = v[j] * rs * gg;
            u32x2 w; w.x = pk2(v[j].x, v[j].y); w.y = pk2(v[j].z, v[j].w); o8[64 * j] = w;
#pragma unroll
            for (int i = 0; i < 4; ++i) { const LAS float* wr = wdt + (i * 256 + 64 * j + lane) * 8; const f32x4 w0 = *(const LAS f32x4*)wr, w1 = *(const LAS f32x4*)(wr + 4); const float hv = v[j][i];
                d[0] += hv * w0.x; d[1] += hv * w0.y; d[2] += hv * w0.z; d[3] += hv * w0.w; d[4] += hv * w1.x; d[5] += hv * w1.y; d[6] += hv * w1.z; d[7] += hv * w1.w; } }
        float e4[4], e2[2], e1;
        { const bool up = (lane & 32) != 0;
#pragma unroll
          for (int i = 0; i < 4; ++i) { const float snd = up ? d[i] : d[i + 4]; const float rcv = __shfl_xor(snd, 32); e4[i] = (up ? d[i + 4] : d[i]) + rcv; } }
        { const bool up = (lane & 16) != 0;
#pragma unroll
          for (int i = 0; i < 2; ++i) { const float snd = up ? e4[i] : e4[i + 2]; const float rcv = __shfl_xor(snd, 16); e2[i] = (up ? e4[i + 2] : e4[i]) + rcv; } }
        { const bool up = (lane & 8) != 0; const float snd = up ? e2[0] : e2[1]; const float rcv = __shfl_xor(snd, 8); e1 = (up ? e2[1] : e2[0]) + rcv; }
        e1 += __shfl_xor(e1, 4); e1 += __shfl_xor(e1, 2); e1 += __shfl_xor(e1, 1);
        if ((lane & 7) == 0) { const int h = lane >> 3; const float raw = e1 + a.dt_bias[h]; DT[(size_t)m * 8 + h] = raw > 20.f ? raw : log1pf(expf(raw)); }
    }
    { bf16* P16 = (bf16*)(ws + WS_P16); const int gt = vcu * (NWAVES * 64) + tid, NT_ = G * NWAVES * 64;
      for (int i = gt; i < T * PLE / 8; i += NT_) { const f32x4 v0 = ((const GAS f32x4*)a.p)[2 * i], v1 = ((const GAS f32x4*)a.p)[2 * i + 1];
          v4u o; o.x = pk2(v0.x, v0.y); o.y = pk2(v0.z, v0.w); o.z = pk2(v1.x, v1.y); o.w = pk2(v1.z, v1.w); ((GAS v4u*)P16)[i] = o; } }
}

__device__ __forceinline__ void p5_router(const Args& a, LAS unsigned char* lds, int vcu, int G, int wave, int lane, int tid) {
    const int cnt_off = (a.dry & 1) ? 32 : 0;
    typedef float f32x16 __attribute__((ext_vector_type(16)));
    unsigned char* ws = a.ws;
    const float* X1 = (const float*)(ws + WS_X1); unsigned char* H8 = ws + WS_H8; const bf16* Wr_t = (const bf16*)(ws + WS_WR);
    int* cnt = (int*)(ws + WS_CTL) + CW_CNT + cnt_off; int* row_tok = (int*)(ws + WS_ROWTOK); float* row_gate = (float*)(ws + WS_ROWGATE); int* slot = (int*)(ws + WS_SLOT);
    for (int tile = vcu; tile < T / 64; tile += G) {
        for (int tt = 0; tt < 8; ++tt) {
            const int lr = wave * 8 + tt, m = tile * 64 + lr;
            const GAS f32x4* xr = (const GAS f32x4*)(X1 + (size_t)m * D) + lane;
            f32x4 v[4]; float s = 0.f;
#pragma unroll
            for (int j = 0; j < 4; ++j) { v[j] = xr[64 * j]; s += (v[j].x * v[j].x + v[j].y * v[j].y) + (v[j].z * v[j].z + v[j].w * v[j].w); }
            const float rs = 1.f / sqrtf(wave_sum(s) * (1.f / D) + EPS);
            GAS unsigned* o4 = (GAS unsigned*)(H8 + (size_t)m * D) + lane;
#pragma unroll
            for (int j = 0; j < 4; ++j) { const f32x4 gg = ((const GAS f32x4*)a.g_ffn)[lane + 64 * j]; const f32x4 hv = v[j] * rs * gg;
                u32x2 w; w.x = pk2(hv.x, hv.y); w.y = pk2(hv.z, hv.w); o4[64 * j] = pg8::pk4_fp8(hv.x, hv.y, hv.z, hv.w);
                const int chunk = (lane >> 1) + 32 * j;
                *(LAS u32x2*)(lds + lr * 2048 + ((chunk ^ (lr & 7)) << 4) + (lane & 1) * 8) = w; }
        }
        __syncthreads();
        const int r32 = lane & 31, hi = lane >> 5, mh = wave & 1, kq = wave >> 1;
        f32x16 acc = {};
#pragma unroll 4
        for (int st = 0; st < 16; ++st) { const int row = 32 * mh + r32, chunk = 2 * (kq * 16 + st) + hi;
            const bf16x8 af = *(const LAS bf16x8*)(lds + row * 2048 + ((chunk ^ (row & 7)) << 4));
            const bf16x8 bfr = *(const GAS bf16x8*)(Wr_t + (size_t)r32 * D + chunk * 8);
            acc = __builtin_amdgcn_mfma_f32_32x32x16_bf16(af, bfr, acc, 0, 0, 0); }
        __syncthreads();
        LAS float* part = (LAS float*)lds;
#pragma unroll
        for (int r = 0; r < 16; ++r) { const int row = (r & 3) + 8 * (r >> 2) + 4 * hi; part[(wave * 32 + row) * 33 + r32] = acc[r]; }
        if (tid < 32) ((LAS int*)(lds + 40960))[tid] = 0;
        __syncthreads();
        LAS int* lcnt = (LAS int*)(lds + 40960); LAS int* lbase = (LAS int*)(lds + 41088); LAS int* tok_e = (LAS int*)(lds + 41216); LAS int* tok_lp = (LAS int*)(lds + 42240); LAS float* tok_g = (LAS float*)(lds + 43264);
        for (int rd = 0; rd < 4; ++rd) {
            const int lt = rd * 16 + (tid >> 5), e = tid & 31, mh2 = lt >> 5, lrow = lt & 31;
            float v = a.b_router[e];
#pragma unroll
            for (int q = 0; q < 4; ++q) v += part[((q * 2 + mh2) * 32 + lrow) * 33 + e];
            float tv[4]; int ti[4];
#pragma unroll
            for (int r = 0; r < 4; ++r) { float bv = v; int bi = e;
#pragma unroll
                for (int o = 16; o > 0; o >>= 1) { const float ov = __shfl_xor(bv, o); const int oi = __shfl_xor(bi, o); if (ov > bv || (ov == bv && oi < bi)) { bv = ov; bi = oi; } }
                tv[r] = bv; ti[r] = bi; if (e == bi) v = -INFINITY; }
            if (e == 0) { float ex[4], sm = 0.f;
#pragma unroll
                for (int r = 0; r < 4; ++r) { ex[r] = expf(tv[r] - tv[0]); sm += ex[r]; }
#pragma unroll
                for (int r = 0; r < 4; ++r) { tok_e[lt * 4 + r] = ti[r]; tok_lp[lt * 4 + r] = __hip_atomic_fetch_add(lcnt + ti[r], 1, __ATOMIC_RELAXED, __HIP_MEMORY_SCOPE_WORKGROUP); tok_g[lt * 4 + r] = ex[r] / sm; } }
        }
        __syncthreads();
        if (tid < 32) { const int n = lcnt[tid]; lbase[tid] = n ? atomicAdd(&cnt[tid * 64], n) : 0; }
        __syncthreads();
        if (tid < 256) { const int lt = tid >> 2, r = tid & 3, m = tile * 64 + lt, e = tok_e[tid], pos = lbase[e] + tok_lp[tid];
            row_tok[e * CAP + pos] = m; row_gate[e * CAP + pos] = tok_g[tid]; slot[(m * 4 + r) * 2] = e; slot[(m * 4 + r) * 2 + 1] = pos; }
        __syncthreads();
    }
}

__device__ __forceinline__ void moe_setup(const Args& a, LAS unsigned char* lds, int tid) {
    LAS int* mts = (LAS int*)(lds + MTS_OFF); const int* cnt = (const int*)(a.ws + WS_CTL) + CW_CNT;
    if (tid == 0) { int s = 0; for (int e = 0; e < NE; ++e) { mts[e] = s; s += (cnt[e * 64] + 255) >> 8; } mts[NE] = s; }
    __syncthreads();
}
__device__ __forceinline__ void moe_gtab(const Args& a, LAS unsigned char* lds, int tid, int u0, int u1, int NN) {
    LAS int* mts = (LAS int*)(lds + MTS_OFF); LAS unsigned* gtab = (LAS unsigned*)(lds + GTAB_OFF);
    const int* cnt = (const int*)(a.ws + WS_CTL) + CW_CNT; const int* row_tok = (const int*)(a.ws + WS_ROWTOK);
    for (int i = 0; i < u1 - u0 && i < GTAB_UNITS; ++i) {
        const int mt = (u0 + i) / NN; int e = 0;
        for (int k = 1; k < 32; ++k) e += (mts[k] <= mt) ? 1 : 0;
        const int r0 = (mt - mts[e]) * 256, c = cnt[e * 64];
        if (tid < 256) { const int r = r0 + tid; const int tok = (r < c) ? row_tok[e * CAP + r] : 0; gtab[i * 256 + tid] = (unsigned)tok * (unsigned)D; }
    }
    __syncthreads();
}

__device__ __forceinline__ void p8_combine(const Args& a, LAS unsigned char* lds, int vcu, int G, int wave, int lane) {
    unsigned char* ws = a.ws; LAS int* mts = (LAS int*)(lds + MTS_OFF);
    const float* X1 = (const float*)(ws + WS_X1); float* X2 = (float*)(ws + WS_X2); bf16* H = (bf16*)(ws + WS_H); const bf16* YS = (const bf16*)(ws + WS_YS); const int* slot = (const int*)(ws + WS_SLOT);
    const int gw = vcu * NWAVES + wave, NGW = G * NWAVES;
    for (int m = gw; m < T; m += NGW) {
        const GAS f32x4* xr = (const GAS f32x4*)(X1 + (size_t)m * D) + lane;
        f32x4 v[4];
#pragma unroll
        for (int j = 0; j < 4; ++j) v[j] = xr[64 * j];
#pragma unroll
        for (int r = 0; r < 4; ++r) { const int e = slot[(m * 4 + r) * 2], pos = slot[(m * 4 + r) * 2 + 1]; const size_t prow = (size_t)mts[e] * 256 + pos;
            const GAS u32x2* yr = (const GAS u32x2*)(YS + prow * D) + lane;
#pragma unroll
            for (int j = 0; j < 4; ++j) { const u32x2 w = yr[64 * j]; v[j].x += __uint_as_float(w.x << 16); v[j].y += __uint_as_float(w.x & 0xffff0000u); v[j].z += __uint_as_float(w.y << 16); v[j].w += __uint_as_float(w.y & 0xffff0000u); } }
        float s = 0.f;
        GAS f32x4* xo = (GAS f32x4*)(X2 + (size_t)m * D) + lane;
#pragma unroll
        for (int j = 0; j < 4; ++j) { xo[64 * j] = v[j]; s += (v[j].x * v[j].x + v[j].y * v[j].y) + (v[j].z * v[j].z + v[j].w * v[j].w); }
        const float rs = 1.f / sqrtf(wave_sum(s) * (1.f / D) + EPS);
        GAS u32x2* o8 = (GAS u32x2*)(H + (size_t)m * D) + lane;
#pragma unroll
        for (int j = 0; j < 4; ++j) { const f32x4 gg = ((const GAS f32x4*)a.g_ple)[lane + 64 * j]; const f32x4 hv = v[j] * rs * gg; u32x2 w; w.x = pk2(hv.x, hv.y); w.y = pk2(hv.z, hv.w); o8[64 * j] = w; }
    }
}
__device__ __forceinline__ void p10_final(const Args& a, int vcu, int G, int wave, int lane) {
    const float* X3 = (const float*)(a.ws + WS_X1);
    const int gw = vcu * NWAVES + wave, NGW = G * NWAVES;
    for (int m = gw; m < T; m += NGW) {
        const GAS f32x4* xr = (const GAS f32x4*)(X3 + (size_t)m * D) + lane;
        f32x4 v[4]; float s = 0.f;
#pragma unroll
        for (int j = 0; j < 4; ++j) { v[j] = xr[64 * j]; s += (v[j].x * v[j].x + v[j].y * v[j].y) + (v[j].z * v[j].z + v[j].w * v[j].w); }
        const float rs = 1.f / sqrtf(wave_sum(s) * (1.f / D) + EPS);
        GAS f32x4* o = (GAS f32x4*)(a.out + (size_t)m * D) + lane;
#pragma unroll
        for (int j = 0; j < 4; ++j) { const f32x4 gg = ((const GAS f32x4*)a.g_final)[lane + 64 * j]; o[64 * j] = v[j] * rs * gg; }
    }
}


constexpr size_t SSD_XN = WS_TMP, SSD_XDT = WS_TMP + 16 * MiB, SSD_BN = WS_TMP + 32 * MiB, SSD_CN = WS_TMP + 40 * MiB, SSD_ST = WS_TMP + 48 * MiB, SSD_ACUM = WS_TMP + 64 * MiB, SSD_CD = WS_TMP + 65 * MiB;
static_assert(SSD_CD + 4096 <= WS_END, "ssd scratch");
typedef float f32x16 __attribute__((ext_vector_type(16)));
__device__ __forceinline__ int img_off(int row, int chunk) { return row * 272 + (chunk << 4); }
__device__ __forceinline__ float silu_fast(float v) { return v * __builtin_amdgcn_rcpf(1.f + __builtin_amdgcn_exp2f(-1.4426950408889634f * v)); }
__device__ __forceinline__ int crow16(int r, int hi) { return (r & 3) + 8 * (r >> 2) + 4 * hi; }

constexpr int SA_XT = 0, SA_BT = 69632, SA_ACUM = 104448, SA_WTS = 106496, SA_DTS = 108544;
template <int TYPE  > __device__ __forceinline__ void ssd_conv_patch(const Args& a, LAS unsigned char* lds, int unit, int g, int c, int t0, int cbl, int lb8) {
    const bf16* PJ = (const bf16*)(a.ws + WS_PJ);
    const int ch = (TYPE == 0 ? g * 256 : TYPE == 1 ? 512 + g * 128 : 768 + g * 128) + cbl * 8;
    const int l0 = lb8 * 8;
    v4u in[11];
#pragma unroll
    for (int i = 0; i < 11; ++i) { const int r = l0 - 3 + i; const bool ok = (c > 0) || (r >= 0);
        in[i] = ok ? *(const GAS v4u*)(PJ + (size_t)(t0 + r) * NPJ + 512 + ch) : (v4u){0u, 0u, 0u, 0u}; }
    f32x4 w[4][2], bia[2];
#pragma unroll
    for (int j = 0; j < 4; ++j) { w[j][0] = *(const GAS f32x4*)(a.conv_w + j * 1024 + ch); w[j][1] = *(const GAS f32x4*)(a.conv_w + j * 1024 + ch + 4); }
    bia[0] = *(const GAS f32x4*)(a.conv_b + ch); bia[1] = *(const GAS f32x4*)(a.conv_b + ch + 4);
    float wt[8], dtl[8];
    const int hl = cbl >> 3;
    if (TYPE == 0) {
#pragma unroll
        for (int li = 0; li < 8; ++li) { wt[li] = ((const LAS float*)(lds + SA_WTS))[hl * 128 + l0 + li]; dtl[li] = ((const LAS float*)(lds + SA_DTS))[hl * 128 + l0 + li]; } }
    v4u nat[8];
#pragma unroll
    for (int ep = 0; ep < 4; ++ep) {
        float o[2][8];
#pragma unroll
        for (int q = 0; q < 2; ++q) { const int e = 2 * ep + q;
            float xin[11];
#pragma unroll
            for (int i = 0; i < 11; ++i) { const unsigned wd = in[i][ep]; xin[i] = __uint_as_float(q ? (wd & 0xffff0000u) : (wd << 16)); }
            const float be = bia[e >> 2][e & 3];
#pragma unroll
            for (int li = 0; li < 8; ++li) { float acc = be;
#pragma unroll
                for (int j = 0; j < 4; ++j) acc += w[j][e >> 2][e & 3] * xin[li + j];
                o[q][li] = silu_fast(acc); }
            if (TYPE == 0) { const int pp = cbl * 8 + e;
                v4u pk; pk.x = pk2(o[q][0] * wt[0], o[q][1] * wt[1]); pk.y = pk2(o[q][2] * wt[2], o[q][3] * wt[3]); pk.z = pk2(o[q][4] * wt[4], o[q][5] * wt[5]); pk.w = pk2(o[q][6] * wt[6], o[q][7] * wt[7]);
                *(LAS v4u*)(lds + SA_XT + img_off(pp, lb8)) = pk;
                bf16* xd = (bf16*)(a.ws + SSD_XDT) + ((size_t)unit * 256 + pp) * 128 + 16 * (lb8 >> 1) + 4 * (lb8 & 1);
                u32x2 d0, d1; d0.x = pk2(o[q][0] * dtl[0], o[q][1] * dtl[1]); d0.y = pk2(o[q][2] * dtl[2], o[q][3] * dtl[3]); d1.x = pk2(o[q][4] * dtl[4], o[q][5] * dtl[5]); d1.y = pk2(o[q][6] * dtl[6], o[q][7] * dtl[7]);
                *(GAS u32x2*)xd = d0; *(GAS u32x2*)(xd + 8) = d1; }
            if (TYPE == 1) { const int n = cbl * 8 + e;
                v4u pk; pk.x = pk2(o[q][0], o[q][1]); pk.y = pk2(o[q][2], o[q][3]); pk.z = pk2(o[q][4], o[q][5]); pk.w = pk2(o[q][6], o[q][7]);
                *(LAS v4u*)(lds + SA_BT + img_off(n, lb8)) = pk; }
        }
#pragma unroll
        for (int li = 0; li < 8; ++li) nat[li][ep] = pk2(o[0][li], o[1][li]);
    }
    bf16* dst = TYPE == 0 ? (bf16*)(a.ws + SSD_XN) + ((size_t)unit * 128 + l0) * 256 + cbl * 8 : (bf16*)(a.ws + (TYPE == 1 ? SSD_BN : SSD_CN)) + ((size_t)unit * 128 + l0) * 128 + cbl * 8;
    const int pitch = TYPE == 0 ? 256 : 128;
#pragma unroll
    for (int li = 0; li < 8; ++li) *(GAS v4u*)(dst + li * pitch) = nat[li];
}
__device__ __forceinline__ void ssd_state_unit(const Args& a, LAS unsigned char* lds, int unit, int tid, int wave, int lane) {
    const int c = unit & 15, g = (unit >> 4) & 1, b = unit >> 5, t0 = b * SEQ + c * 128;
    const float* DT = (const float*)(a.ws + WS_DT);
    if (wave < 4) {
        const int h = 4 * g + wave; const float av = -expf(a.a_log[h]);
        const float d0 = DT[(size_t)(t0 + 2 * lane) * 8 + h], d1 = DT[(size_t)(t0 + 2 * lane + 1) * 8 + h];
        const float v0 = av * d0, v1 = av * d1; float sc = v0 + v1;
#pragma unroll
        for (int o = 1; o < 64; o <<= 1) { const float t = __shfl_up(sc, o); if (lane >= o) sc += t; }
        const float A0 = sc - v1, A1 = sc, tot = __shfl(sc, 63);
        LAS float* ac = (LAS float*)(lds + SA_ACUM) + wave * 128 + 2 * lane; LAS float* wt = (LAS float*)(lds + SA_WTS) + wave * 128 + 2 * lane; LAS float* dd = (LAS float*)(lds + SA_DTS) + wave * 128 + 2 * lane;
        ac[0] = A0; ac[1] = A1; wt[0] = d0 * expf(tot - A0); wt[1] = d1 * expf(tot - A1); dd[0] = d0; dd[1] = d1;
        float* ag = (float*)(a.ws + SSD_ACUM) + ((size_t)unit * 4 + wave) * 128 + 2 * lane; ag[0] = A0; ag[1] = A1;
        if (lane == 0) ((float*)(a.ws + SSD_CD))[unit * 4 + wave] = expf(tot);
    }
    __syncthreads();
    ssd_conv_patch<0>(a, lds, unit, g, c, t0, lane & 31, 2 * wave + (lane >> 5));
    if (wave < 4) ssd_conv_patch<1>(a, lds, unit, g, c, t0, lane & 15, 4 * wave + (lane >> 4));
    else ssd_conv_patch<2>(a, lds, unit, g, c, t0, lane & 15, 4 * (wave - 4) + (lane >> 4));
    __syncthreads();
    const int r32 = lane & 31, hi = lane >> 5, pp = 32 * wave + r32;
    bf16x8 bx[8];
#pragma unroll
    for (int ks = 0; ks < 8; ++ks) bx[ks] = *(const LAS bf16x8*)(lds + SA_XT + img_off(pp, 2 * ks + hi));
    bf16* st = (bf16*)(a.ws + SSD_ST) + ((size_t)unit * 256 + pp) * 128;
#pragma unroll
    for (int nb = 0; nb < 4; ++nb) {
        f32x16 acc = {};
#pragma unroll
        for (int ks = 0; ks < 8; ++ks) { const bf16x8 af = *(const LAS bf16x8*)(lds + SA_BT + img_off(32 * nb + r32, 2 * ks + hi)); acc = __builtin_amdgcn_mfma_f32_32x32x16_bf16(af, bx[ks], acc, 0, 0, 0); }
#pragma unroll
        for (int rg = 0; rg < 4; ++rg) { u32x2 w; w.x = pk2(acc[4 * rg], acc[4 * rg + 1]); w.y = pk2(acc[4 * rg + 2], acc[4 * rg + 3]); *(GAS u32x2*)(st + (rg & 1) * 64 + (2 * nb + (rg >> 1)) * 8 + 4 * hi) = w; }
    }
    __syncthreads();
}

constexpr int SB_BN = 0, SB_CN = 34816, SB_ACUM = 69632, SB_SSQ = 71680, SB_RSTD = 75776;
__device__ __forceinline__ void ssd_out_unit(const Args& a, LAS unsigned char* lds, int unit, int tid, int wave, int lane) {
    const int c = unit & 15, g = (unit >> 4) & 1, b = unit >> 5, t0 = b * SEQ + c * 128;
    const int r32 = lane & 31, hi = lane >> 5, hl = wave >> 1, pp = 32 * wave + r32;
    for (int i = tid; i < 4096; i += NWAVES * 64) { const int im = i >> 11, idx = i & 2047, row = idx >> 4, ch = idx & 15;
        const v4u v = *(const GAS v4u*)((const bf16*)(a.ws + (im ? SSD_CN : SSD_BN)) + ((size_t)unit * 128 + row) * 128 + ch * 8);
        *(LAS v4u*)(lds + (im ? SB_CN : SB_BN) + img_off(row, ch)) = v; }
    ((LAS float*)(lds + SB_ACUM))[tid] = ((const float*)(a.ws + SSD_ACUM))[(size_t)unit * 512 + tid];
    bf16x8 pf[8];
    {
        float pv[8][8];
#pragma unroll
        for (int ks = 0; ks < 8; ++ks)
#pragma unroll
            for (int j = 0; j < 8; ++j) pv[ks][j] = 0.f;
        const float* cdp = (const float*)(a.ws + SSD_CD) + (unit - c) * 4 + hl; const bf16* sp0 = (const bf16*)(a.ws + SSD_ST) + ((size_t)(unit - c) * 256 + pp) * 128 + 64 * hi;
        float wgt = 1.f; int cc = c - 1;
        for (; cc >= 1; cc -= 2) {
            const bf16* spa = sp0 + (size_t)cc * 256 * 128; const bf16* spb = spa - 256 * 128;
            v4u sa[8], sb[8];
#pragma unroll
            for (int ks = 0; ks < 8; ++ks) { sa[ks] = *(const GAS v4u*)(spa + 8 * ks); sb[ks] = *(const GAS v4u*)(spb + 8 * ks); }
            const float wa = wgt, wb = wgt * cdp[cc * 4]; wgt = wb * cdp[(cc - 1) * 4];
#pragma unroll
            for (int ks = 0; ks < 8; ++ks)
#pragma unroll
                for (int j = 0; j < 4; ++j) { pv[ks][2 * j] += wa * __uint_as_float(sa[ks][j] << 16) + wb * __uint_as_float(sb[ks][j] << 16); pv[ks][2 * j + 1] += wa * __uint_as_float(sa[ks][j] & 0xffff0000u) + wb * __uint_as_float(sb[ks][j] & 0xffff0000u); }
        }
        if (cc == 0) {
#pragma unroll
            for (int ks = 0; ks < 8; ++ks) { const v4u s = *(const GAS v4u*)(sp0 + 8 * ks);
#pragma unroll
                for (int j = 0; j < 4; ++j) { pv[ks][2 * j] += wgt * __uint_as_float(s[j] << 16); pv[ks][2 * j + 1] += wgt * __uint_as_float(s[j] & 0xffff0000u); } }
        }
#pragma unroll
        for (int ks = 0; ks < 8; ++ks) { v4u w; w.x = pk2(pv[ks][0], pv[ks][1]); w.y = pk2(pv[ks][2], pv[ks][3]); w.z = pk2(pv[ks][4], pv[ks][5]); w.w = pk2(pv[ks][6], pv[ks][7]); pf[ks] = __builtin_bit_cast(bf16x8, w); }
    }
    const bf16* xp = (const bf16*)(a.ws + SSD_XDT) + ((size_t)unit * 256 + pp) * 128 + 8 * hi;
    __syncthreads();
    const LAS float* acum = (const LAS float*)(lds + SB_ACUM) + hl * 128;
    f32x16 y[4];
#pragma unroll
    for (int lb = 0; lb < 4; ++lb) {
        f32x16 ao = {};
#pragma unroll
        for (int ks = 0; ks < 8; ++ks) { const bf16x8 bfr = *(const LAS bf16x8*)(lds + SB_CN + img_off(32 * lb + r32, 2 * ks + hi)); ao = __builtin_amdgcn_mfma_f32_32x32x16_bf16(pf[ks], bfr, ao, 0, 0, 0); }
        const float eL = __builtin_amdgcn_exp2f(1.4426950408889634f * acum[32 * lb + r32]);
#pragma unroll
        for (int r = 0; r < 16; ++r) y[lb][r] = eL * ao[r];
        __builtin_amdgcn_sched_barrier(0);
    }
#pragma unroll
    for (int lb = 0; lb < 4; ++lb) {
        const float AcL = acum[32 * lb + r32];
        f32x16 ay = y[lb];
#pragma unroll
        for (int sb = 0; sb < 4; ++sb) if (sb <= lb) {
            f32x16 cbt = {};
#pragma unroll
            for (int ks = 0; ks < 8; ++ks) { const bf16x8 af = *(const LAS bf16x8*)(lds + SB_BN + img_off(32 * sb + r32, 2 * ks + hi)); const bf16x8 bfr = *(const LAS bf16x8*)(lds + SB_CN + img_off(32 * lb + r32, 2 * ks + hi));
                cbt = __builtin_amdgcn_mfma_f32_32x32x16_bf16(af, bfr, cbt, 0, 0, 0); }
            float m[16];
#pragma unroll
            for (int rg = 0; rg < 4; ++rg) { const f32x4 as = *(const LAS f32x4*)(acum + 32 * sb + 8 * rg + 4 * hi);
#pragma unroll
                for (int q = 0; q < 4; ++q) { const int r = 4 * rg + q; float v = cbt[r] * __builtin_amdgcn_exp2f(1.4426950408889634f * (AcL - as[q]));
                    if (sb == lb) v = (8 * rg + 4 * hi + q <= r32) ? v : 0.f;
                    m[r] = v; } }
            v4u w0, w1; w0.x = pk2(m[0], m[1]); w0.y = pk2(m[2], m[3]); w0.z = pk2(m[4], m[5]); w0.w = pk2(m[6], m[7]); w1.x = pk2(m[8], m[9]); w1.y = pk2(m[10], m[11]); w1.z = pk2(m[12], m[13]); w1.w = pk2(m[14], m[15]);
            const bf16x8 xa0 = *(const GAS bf16x8*)(xp + 32 * sb), xa1 = *(const GAS bf16x8*)(xp + 32 * sb + 16);
            ay = __builtin_amdgcn_mfma_f32_32x32x16_bf16(xa0, __builtin_bit_cast(bf16x8, w0), ay, 0, 0, 0);
            ay = __builtin_amdgcn_mfma_f32_32x32x16_bf16(xa1, __builtin_bit_cast(bf16x8, w1), ay, 0, 0, 0);
            __builtin_amdgcn_sched_barrier(0);
        }
        y[lb] = ay;
        __builtin_amdgcn_sched_barrier(0);
    }
    const float dsk = a.d_skip[4 * g + hl];
    const bf16* PJ = (const bf16*)(a.ws + WS_PJ); const bf16* XN = (const bf16*)(a.ws + SSD_XN) + (size_t)unit * 128 * 256;
    LAS float* ssq = (LAS float*)(lds + SB_SSQ);
#pragma unroll
    for (int lb = 0; lb < 4; ++lb) { const int l = 32 * lb + r32; float s = 0.f;
#pragma unroll
        for (int rg = 0; rg < 4; ++rg) { const int p0 = 32 * wave + 8 * rg + 4 * hi;
            const u32x2 xw = *(const GAS u32x2*)(XN + (size_t)l * 256 + p0); const u32x2 zw = *(const GAS u32x2*)(PJ + (size_t)(t0 + l) * NPJ + g * 256 + p0);
            const float xv[4] = {__uint_as_float(xw.x << 16), __uint_as_float(xw.x & 0xffff0000u), __uint_as_float(xw.y << 16), __uint_as_float(xw.y & 0xffff0000u)};
            const float zv[4] = {__uint_as_float(zw.x << 16), __uint_as_float(zw.x & 0xffff0000u), __uint_as_float(zw.y << 16), __uint_as_float(zw.y & 0xffff0000u)};
#pragma unroll
            for (int q = 0; q < 4; ++q) { const float v = (y[lb][4 * rg + q] + dsk * xv[q]) * silu_fast(zv[q]); y[lb][4 * rg + q] = v; s += v * v; } }
        s += __shfl_xor(s, 32);
        if (hi == 0) ssq[wave * 128 + l] = s;
        __builtin_amdgcn_sched_barrier(0); }
    __syncthreads();
    if (tid < 128) { float s = 0.f;
#pragma unroll
        for (int w = 0; w < 8; ++w) s += ssq[w * 128 + tid];
        ((LAS float*)(lds + SB_RSTD))[tid] = 1.f / sqrtf(s * (1.f / 256.f) + 1e-5f); }
    __syncthreads();
    bf16* YC = (bf16*)(a.ws + WS_YC);
#pragma unroll
    for (int lb = 0; lb < 4; ++lb) { const int l = 32 * lb + r32; const float rs = ((const LAS float*)(lds + SB_RSTD))[l];
#pragma unroll
        for (int rg = 0; rg < 4; ++rg) { const int p0 = 32 * wave + 8 * rg + 4 * hi; const f32x4 nw = *(const GAS f32x4*)(a.ssd_norm_w + g * 256 + p0);
            u32x2 w; w.x = pk2(y[lb][4 * rg] * rs * nw.x, y[lb][4 * rg + 1] * rs * nw.y); w.y = pk2(y[lb][4 * rg + 2] * rs * nw.z, y[lb][4 * rg + 3] * rs * nw.w);
            *(GAS u32x2*)(YC + (size_t)(t0 + l) * 1024 + g * 256 + p0) = w; } }
    __syncthreads();
}
__device__ __forceinline__ void attn_post(const Args& a, int vcu, int G, int wave, int lane) {
    bf16* YC = (bf16*)(a.ws + WS_YC); const bf16* O = (const bf16*)(a.ws + WS_O);
    const int gw = vcu * NWAVES + wave, NGW = G * NWAVES;
    const float lam = expf(wave_sum(a.lq1[lane] * a.lk1[lane])) - expf(wave_sum(a.lq2[lane] * a.lk2[lane])) + LAM_INIT;
    const int h = lane >> 4, sidx = lane & 15, e0 = ((sidx >> 2) & 1) * 64 + (sidx & 3) * 16;
    f32x4 sw[4];
#pragma unroll
    for (int q = 0; q < 4; ++q) sw[q] = *(const GAS f32x4*)(a.subln_w + (e0 & 127) + 4 * q);
#pragma unroll 2
    for (int t = gw; t < T; t += NGW) {
        const v4u w0 = *(const GAS v4u*)(O + (size_t)t * 1024 + lane * 16), w1 = *(const GAS v4u*)(O + (size_t)t * 1024 + lane * 16 + 8);
        float v[16]; float ss = 0.f;
#pragma unroll
        for (int q = 0; q < 8; ++q) { const unsigned mine = q < 4 ? w0[q] : w1[q - 4]; const unsigned oth = __shfl_xor(mine, 8);
            v[2 * q] = __uint_as_float(mine << 16) - lam * __uint_as_float(oth << 16); v[2 * q + 1] = __uint_as_float(mine & 0xffff0000u) - lam * __uint_as_float(oth & 0xffff0000u);
            ss += v[2 * q] * v[2 * q] + v[2 * q + 1] * v[2 * q + 1]; }
        ss += __shfl_xor(ss, 1); ss += __shfl_xor(ss, 2); ss += __shfl_xor(ss, 4);
        const float r = (1.f - LAM_INIT) / sqrtf(ss * (1.f / 128.f) + 1e-5f);
        if (sidx < 8) { v4u o0, o1;
            o0.x = pk2(v[0] * r * sw[0].x, v[1] * r * sw[0].y); o0.y = pk2(v[2] * r * sw[0].z, v[3] * r * sw[0].w); o0.z = pk2(v[4] * r * sw[1].x, v[5] * r * sw[1].y); o0.w = pk2(v[6] * r * sw[1].z, v[7] * r * sw[1].w);
            o1.x = pk2(v[8] * r * sw[2].x, v[9] * r * sw[2].y); o1.y = pk2(v[10] * r * sw[2].z, v[11] * r * sw[2].w); o1.z = pk2(v[12] * r * sw[3].x, v[13] * r * sw[3].y); o1.w = pk2(v[14] * r * sw[3].z, v[15] * r * sw[3].w);
            bf16* dst = YC + (size_t)t * 1024 + 512 + h * 128 + e0; *(GAS v4u*)dst = o0; *(GAS v4u*)(dst + 8) = o1; }
    }
}

constexpr int NPHASE = 11;
__global__ void __launch_bounds__(NWAVES * 64, 2) mk_fwd(Args a) {
    extern __shared__ __attribute__((aligned(16))) unsigned char lds_raw[];
    LAS unsigned char* lds = (LAS unsigned char*)lds_raw;
    const int tid0 = threadIdx.x;
    const int G = gridDim.x; const int bx = blockIdx.x; const int vcu = (G % 8 == 0) ? (bx % 8) * (G / 8) + bx / 8 : bx;
    unsigned char* ws = a.ws; gu32* ctl = (gu32*)(ws + WS_CTL);
    for (int u = tid0; u < (LDS_BYTES - LDSCTL_OFF) / 4; u += NWAVES * 64) ((LAS unsigned*)(lds + LDSCTL_OFF))[u] = 0u;
    __syncthreads();
    volatile LAS unsigned* MISC = (volatile LAS unsigned*)(lds + MISC_OFF);
    XcdBarrier bar; bar.bar = (unsigned*)(ctl + CW_BAR); bar.x = 0; bar.st = nullptr;
    if (a.bar_li >= 0) bar = xcd_barrier_post((unsigned*)(ctl + CW_BAR) + a.bar_li * XCD_BAR_WORDS, MISC + 8);
    const int lo = a.ph_lo, hi = a.ph_hi;
#define IN(k) (lo <= (k) && (k) < hi)
#define IDS() int tid = threadIdx.x; asm volatile("" : "+v"(tid)); const int lane = tid & 63, wave = __builtin_amdgcn_readfirstlane(tid >> 6); (void)lane; (void)wave
#define SEAM(k) do { if (IN(k) && IN((k) + 1)) xcd_barrier(bar); } while (0)
    const LAS unsigned* gtab = (const LAS unsigned*)(lds + GTAB_OFF);
    bf16* H = (bf16*)(ws + WS_H); bf16* PJ = (bf16*)(ws + WS_PJ);

    if (IN(0)) { IDS(); p0_prologue(a, lds, vcu, G, wave, lane, tid); SEAM(0); }
    if (IN(1)) {
        { pg8::DenseOrder S; S.init(H, ws + WS_WIN, T, NPJ, D, G, bx); pg8::EpiBf16S E{PJ, NPJ, 6, 8, attn_body::C2};
          pg8::gemm_phase<pg8::EpiBf16S, pg8::DenseOrder, false, true, true>(lds + RING_OFF, D, S, E, gtab); }
        { pg8::DenseOrder S; S.init(ws + WS_P16, ws + WS_WP, T, D, PLE, G, bx); pg8::EpiBf16S E{(bf16*)(ws + WS_PP), D, 0, 0, 1.f};
          pg8::gemm_phase<pg8::EpiBf16S, pg8::DenseOrder, false, true, true>(lds + RING_OFF, PLE, S, E, gtab); }
        SEAM(1);
    }
    if (IN(2)) {
        IDS();
        for (int unit = vcu; unit < 256; unit += G) ssd_state_unit(a, lds, unit, tid, wave, lane);
        const attn_body::AttnTensors AT{(const attn_body::bf16*)PJ, (attn_body::bf16*)(ws + WS_O)};
        const attn_body::StaticOrder S(vcu);
        attn_body::attn_phase<attn_body::StaticOrder>((char*)lds_raw + RING_OFF, AT, S);
        SEAM(2);
    }
    if (IN(3)) {
        IDS();
        if (!(a.dry & 4)) for (int unit = vcu; unit < 256; unit += G) ssd_out_unit(a, lds, unit, tid, wave, lane);
        if (!(a.dry & 2)) attn_post(a, vcu, G, wave, lane);
        else for (int unit = vcu; unit < 256; unit += G) {}
        SEAM(3);
    }
    if (IN(4)) {
        pg8::DenseOrder S; S.init(ws + WS_YC, ws + WS_WOUT, T, D, D, G, bx); pg8::EpiResF32 E{a.x, (float*)(ws + WS_X1), D};
        pg8::gemm_phase<pg8::EpiResF32, pg8::DenseOrder, false, false, true>(lds + RING_OFF, D, S, E, gtab);
        SEAM(4);
    }
    if (IN(5)) { IDS(); p5_router(a, lds, vcu, G, wave, lane, tid); SEAM(5); }
    if (IN(6)) {
        IDS(); moe_setup(a, lds, tid);
        const LAS int* mts = (const LAS int*)(lds + MTS_OFF); const int NN = FF2 / 256, U = __builtin_amdgcn_readfirstlane(mts[NE]) * NN;
        const int u0 = (int)((long)vcu * U / G), u1 = (int)((long)(vcu + 1) * U / G);
        moe_gtab(a, lds, tid, u0, u1, NN);
        pg8::MoeOrder S{mts, (const char*)(ws + WS_H8), (const char*)(ws + WS_WUP), (size_t)256 * D, (size_t)FF2 * D, NN, u0, u1, 1};
        pg8::EpiMoeUp8 E{ws + WS_ACT, a.b_up};
        pg8::gemm_phase<pg8::EpiMoeUp8, pg8::MoeOrder, true, true, true, true>(lds + RING_OFF, D, S, E, gtab);
        SEAM(6);
    }
    if (IN(7)) {
        IDS(); moe_setup(a, lds, tid);
        const LAS int* mts = (const LAS int*)(lds + MTS_OFF); const int NN = D / 256, U = __builtin_amdgcn_readfirstlane(mts[NE]) * NN;
        const int u0 = (int)((long)vcu * U / G), u1 = (int)((long)(vcu + 1) * U / G);
        { LAS unsigned* gt = (LAS unsigned*)(lds + GTAB_OFF);
          for (int i = 0; i < u1 - u0 && i < GTAB_UNITS; ++i) { const int mt = (u0 + i) / NN; if (tid < 256) gt[i * 256 + tid] = (unsigned)(mt * 256 + tid) * (unsigned)D; }
          __syncthreads(); }
        pg8::MoeOrder S{mts, (const char*)(ws + WS_ACT), (const char*)(ws + WS_WDN), (size_t)256 * D, (size_t)D * D, NN, u0, u1, 1};
        pg8::EpiMoeDown8 E{(bf16*)(ws + WS_YS), a.b_down, (const float*)(ws + WS_ROWGATE)};
        pg8::gemm_phase<pg8::EpiMoeDown8, pg8::MoeOrder, true, true, true, true>(lds + RING_OFF, D, S, E, gtab);
        SEAM(7);
    }
    if (IN(8)) { IDS(); moe_setup(a, lds, tid); p8_combine(a, lds, vcu, G, wave, lane); SEAM(8); }
    if (IN(9)) {
        pg8::DenseOrder S; S.init(H, ws + WS_WG, T, D, D, G, bx); pg8::EpiPle E{(const float*)(ws + WS_X2), (const bf16*)(ws + WS_PP), (float*)(ws + WS_X1), D};
        pg8::gemm_phase<pg8::EpiPle, pg8::DenseOrder, false, false, true>(lds + RING_OFF, D, S, E, gtab);
        SEAM(9);
    }
    if (IN(10)) { IDS(); p10_final(a, vcu, G, wave, lane); }
#undef IN
#undef IDS
#undef SEAM
}

extern "C" void kernel_launch(void* const* d_in, const int* in_sizes, int n_in, void* d_out, int out_size, void* d_ws, size_t ws_size, hipStream_t stream) {
    static int grid = 0;
    if (grid == 0) {
        int dev = 0, cus = 0, per_cu = 0;
        if (n_in != 27 || out_size != T * D || ws_size < WS_END) { fprintf(stderr, "kernel_launch: unexpected shapes (n_in %d out %d ws %zu)\n", n_in, out_size, ws_size); grid = -1; return; }
        if (hipGetDevice(&dev) != hipSuccess || hipDeviceGetAttribute(&cus, hipDeviceAttributeMultiprocessorCount, dev) != hipSuccess) { grid = -1; return; }
        if (hipFuncSetAttribute((const void*)mk_fwd, hipFuncAttributeMaxDynamicSharedMemorySize, LDS_BYTES) != hipSuccess) { fprintf(stderr, "kernel_launch: hipFuncSetAttribute failed\n"); grid = -1; return; }
        if (hipOccupancyMaxActiveBlocksPerMultiprocessor(&per_cu, (const void*)mk_fwd, NWAVES * 64, LDS_BYTES) != hipSuccess || per_cu < 1) { fprintf(stderr, "kernel_launch: occupancy query says %d blocks per CU\n", per_cu); (void)hipGetLastError(); grid = -1; return; }
        grid = cus;
    }
    if (grid < 0) return;
    if (hipMemsetAsync((char*)d_ws + WS_CTL, 0, CTL_ZERO_BYTES, stream) != hipSuccess) return;
    Args a{};
    const float** ap = (const float**)&a;
    for (int i = 0; i < 27; ++i) ap[i] = (const float*)d_in[i];
    a.out = (float*)d_out; a.ws = (unsigned char*)d_ws; a.bar_li = -1; a.dry = 0;
#ifndef PROBE_PHASE
#define PROBE_PHASE -1
#endif
#ifndef PROBE_DRY
#define PROBE_DRY 0
#endif
    if (PROBE_PHASE < 0) { a.bar_li = 0; a.ph_lo = 0; a.ph_hi = NPHASE; hipLaunchKernelGGL(mk_fwd, dim3(grid), dim3(NWAVES * 64), LDS_BYTES, stream, a); }
    else {
        const int P = PROBE_PHASE;
        a.bar_li = 0; a.ph_lo = 0; a.ph_hi = (P == 5) ? 5 : P + 1; hipLaunchKernelGGL(mk_fwd, dim3(grid), dim3(NWAVES * 64), LDS_BYTES, stream, a);
        a.bar_li = 1; a.ph_lo = P; a.ph_hi = P + 1; a.dry = (P == 5) ? 1 : PROBE_DRY; hipLaunchKernelGGL(mk_fwd, dim3(grid), dim3(NWAVES * 64), LDS_BYTES, stream, a);
        a.bar_li = 2; a.ph_lo = (P == 5) ? 5 : P + 1; a.ph_hi = NPHASE; a.dry = 0; if (a.ph_lo < NPHASE) hipLaunchKernelGGL(mk_fwd, dim3(grid), dim3(NWAVES * 64), LDS_BYTES, stream, a);
    }
}
```
